# Optimizing an MI355X kernel written in HIP

```python
import math
import jax, jax.numpy as jnp
from jax import lax
import numpy as np

D_MODEL = 1024
BATCH = 4
SEQ = 8192
DEPTH = 1

N_META = 16
EPS = 1e-6
MLA_HEADS = 8
Q_LORA = 384
KV_LORA = 256
QK_NOPE = 64
QK_ROPE = 32
V_DIM = 64
ROPE_BASE = 10000.0
Q_BLOCK = 128
LRU_WIDTH = D_MODEL
LRU_BLOCKS = 8
LRU_BW = LRU_WIDTH // LRU_BLOCKS
CONV_WIDTH = 4
LRU_C = 8.0
N_EXPERTS = 32
TOP_K = 4
D_FF = D_MODEL
SWIGLU_ALPHA = 1.702
SWIGLU_LIMIT = 7.0
EXPERT_BLOCK = 128
OFF_CQ = 0
OFF_CKV = OFF_CQ + Q_LORA
OFF_KR = OFF_CKV + KV_LORA
OFF_RX = OFF_KR + QK_ROPE
OFF_RG = OFF_RX + LRU_WIDTH
OFF_GATE = OFF_RG + LRU_WIDTH
D_IN = OFF_GATE + 2 * D_MODEL

kernel_name = 'hybrid_mla_rglru_moe_meta'


def rms_norm(x, g):
    xf = x.astype(jnp.float32)
    var = jnp.mean(xf * xf, axis=-1, keepdims=True)
    return (xf * lax.rsqrt(var + EPS)).astype(x.dtype) * g


def rope_tables(T, dtype):
    inv = ROPE_BASE ** (-jnp.arange(0, QK_ROPE, 2, dtype=jnp.float32) / QK_ROPE)
    ang = jnp.arange(T, dtype=jnp.float32)[:, None] * inv[None, :]
    return jnp.cos(ang).astype(dtype), jnp.sin(ang).astype(dtype)


def apply_rope(x, cos, sin):
    x1, x2 = jnp.split(x, 2, axis=-1)
    return jnp.concatenate([x1 * cos - x2 * sin, x1 * sin + x2 * cos], axis=-1)


def causal_block_attention(q_nope, q_pe, k_nope, k_pe, v):
    B, T, H, _ = q_nope.shape
    n_blk = -(-T // Q_BLOCK)
    Tp = n_blk * Q_BLOCK
    pad = Tp - T

    def padt(a):
        return jnp.pad(a, [(0, 0), (0, pad)] + [(0, 0)] * (a.ndim - 2))

    q_nope, q_pe, k_nope, k_pe, v = padt(q_nope), padt(q_pe), padt(k_nope), padt(k_pe), padt(v)
    scale = (QK_NOPE + QK_ROPE) ** -0.5
    k_pos = jnp.arange(Tp)

    def one_block(i):
        s = i * Q_BLOCK
        qn = lax.dynamic_slice_in_dim(q_nope, s, Q_BLOCK, axis=1)
        qp = lax.dynamic_slice_in_dim(q_pe, s, Q_BLOCK, axis=1)
        scores = (jnp.einsum('bqhd,bkhd->bhqk', qn, k_nope, preferred_element_type=jnp.float32)
                  + jnp.einsum('bqhr,bkr->bhqk', qp, k_pe, preferred_element_type=jnp.float32))
        q_pos = s + jnp.arange(Q_BLOCK)
        mask = k_pos[None, :] <= q_pos[:, None]
        scores = jnp.where(mask, scores * scale, -jnp.inf)
        p = jax.nn.softmax(scores, axis=-1).astype(v.dtype)
        return jnp.einsum('bhqk,bkhd->bqhd', p, v)

    out = lax.map(one_block, jnp.arange(n_blk))
    out = jnp.moveaxis(out, 0, 1).reshape(B, Tp, H, V_DIM)
    return out[:, :T]


def mla_branch(p_cq, p_ckv, p_kr, q_norm_g, w_uq, kv_norm_g, w_ukv, w_ao, cos, sin):
    B, T, _ = p_cq.shape
    c_q = rms_norm(p_cq, q_norm_g)
    q = (c_q @ w_uq).reshape(B, T, MLA_HEADS, QK_NOPE + QK_ROPE)
    q_nope = q[..., :QK_NOPE]
    q_pe = apply_rope(q[..., QK_NOPE:], cos[:, None, :], sin[:, None, :])
    c_kv = rms_norm(p_ckv, kv_norm_g)
    kv = (c_kv @ w_ukv).reshape(B, T, MLA_HEADS, QK_NOPE + V_DIM)
    k_nope, v = kv[..., :QK_NOPE], kv[..., QK_NOPE:]
    k_pe = apply_rope(p_kr, cos, sin)
    o = causal_block_attention(q_nope, q_pe, k_nope, k_pe, v)
    return o.reshape(B, T, MLA_HEADS * V_DIM) @ w_ao


def rglru_branch(p_rx, p_rg, conv_w, conv_b, w_rg_a, b_rg_a, w_rg_x, b_rg_x, rg_lambda, w_ro):
    B, T, W = p_rx.shape
    xc = lax.conv_general_dilated(p_rx, conv_w[:, None, :], window_strides=(1,),
                                  padding=[(CONV_WIDTH - 1, 0)],
                                  dimension_numbers=('NWC', 'WIO', 'NWC'),
                                  feature_group_count=W) + conv_b
    xb = xc.reshape(B, T, LRU_BLOCKS, LRU_BW)
    r = jax.nn.sigmoid(jnp.einsum('btni,nij->btnj', xb, w_rg_a).reshape(B, T, W) + b_rg_a)
    ig = jax.nn.sigmoid(jnp.einsum('btni,nij->btnj', xb, w_rg_x).reshape(B, T, W) + b_rg_x)
    log_a = (-LRU_C * r.astype(jnp.float32)) * jax.nn.softplus(-rg_lambda.astype(jnp.float32))
    a = jnp.exp(log_a)
    b = jnp.sqrt(-jnp.expm1(2.0 * log_a)) * (ig * xc).astype(jnp.float32)

    def combine(left, right):
        a1, b1 = left
        a2, b2 = right
        return a1 * a2, a2 * b1 + b2

    _, h = lax.associative_scan(combine, (a, b), axis=1)
    y = h.astype(p_rx.dtype) * jax.nn.gelu(p_rg)
    return y @ w_ro


def moe_ffn(xn, w_router, b_router, w_up, b_up, w_down, b_down):
    B, T, D = xn.shape
    xt = xn.reshape(-1, D)
    N = xt.shape[0]
    logits = (xt @ w_router + b_router).astype(jnp.float32)
    top_val, top_idx = lax.top_k(logits, TOP_K)
    gates = jax.nn.softmax(top_val, axis=-1).astype(xn.dtype)
    NK = N * TOP_K
    e_flat = top_idx.reshape(-1)
    order = jnp.argsort(e_flat)
    e_sorted = e_flat[order]
    tok_sorted = order // TOP_K
    counts = jnp.bincount(e_flat, length=N_EXPERTS)
    padded = (counts + EXPERT_BLOCK - 1) // EXPERT_BLOCK * EXPERT_BLOCK
    start = jnp.cumsum(counts) - counts
    pend = jnp.cumsum(padded)
    pstart = pend - padded
    dest = pstart[e_sorted] + (jnp.arange(NK) - start[e_sorted])
    n_blocks = -(-NK // EXPERT_BLOCK) + N_EXPERTS
    P = n_blocks * EXPERT_BLOCK
    x_pad = jnp.zeros((P, D), xt.dtype).at[dest].set(xt[tok_sorted])
    block_e = jnp.minimum(jnp.searchsorted(pend, jnp.arange(n_blocks) * EXPERT_BLOCK, side='right'),
                          N_EXPERTS - 1)

    def expert_block(args):
        xb, e = args
        hdn = xb @ w_up[e] + b_up[e]
        x_glu = jnp.minimum(hdn[:, :D_FF], SWIGLU_LIMIT)
        x_lin = jnp.clip(hdn[:, D_FF:], -SWIGLU_LIMIT, SWIGLU_LIMIT)
        act = x_glu * jax.nn.sigmoid(SWIGLU_ALPHA * x_glu) * (x_lin + 1.0)
        return act @ w_down[e] + b_down[e]

    y_pad = lax.map(expert_block, (x_pad.reshape(n_blocks, EXPERT_BLOCK, D), block_e))
    y_sorted = y_pad.reshape(P, D)[dest]
    g_sorted = gates.reshape(-1)[order]
    y = jnp.zeros_like(xt).at[tok_sorted].add(y_sorted * g_sorted[:, None])
    return y.reshape(B, T, D)


def setup_inputs(seed: int = 0) -> dict:
    key = jax.random.key(seed)
    ks = jax.random.split(key, 32)
    f32 = jnp.float32

    def nrm(k, shape, scale):
        return jax.random.normal(k, shape, f32) * scale

    def gain(k, shape):
        return 1.0 + 0.01 * jax.random.normal(k, shape, f32)

    L = DEPTH
    a0 = jax.random.uniform(ks[13], (L, LRU_WIDTH), f32, 0.9, 0.999)
    return {
        'x': nrm(ks[0], (BATCH, SEQ, D_MODEL), 1.0),
        'meta_tokens': nrm(ks[1], (N_META, D_MODEL), 1.0),
        'norm_mix_g': gain(ks[2], (L, D_MODEL)),
        'w_in': nrm(ks[3], (L, D_MODEL, D_IN), D_MODEL ** -0.5),
        'b_gate': nrm(ks[4], (L, 2 * D_MODEL), 0.02),
        'q_norm_g': gain(ks[5], (L, Q_LORA)),
        'w_uq': nrm(ks[6], (L, Q_LORA, MLA_HEADS * (QK_NOPE + QK_ROPE)), Q_LORA ** -0.5),
        'kv_norm_g': gain(ks[7], (L, KV_LORA)),
        'w_ukv': nrm(ks[8], (L, KV_LORA, MLA_HEADS * (QK_NOPE + V_DIM)), KV_LORA ** -0.5),
        'w_ao': nrm(ks[9], (L, MLA_HEADS * V_DIM, D_MODEL), (MLA_HEADS * V_DIM) ** -0.5),
        'conv_w': nrm(ks[10], (L, CONV_WIDTH, LRU_WIDTH), CONV_WIDTH ** -0.5),
        'conv_b': nrm(ks[11], (L, LRU_WIDTH), 0.02),
        'w_rg_a': nrm(ks[12], (L, LRU_BLOCKS, LRU_BW, LRU_BW), LRU_BW ** -0.5),
        'b_rg_a': nrm(ks[14], (L, LRU_WIDTH), 0.02),
        'w_rg_x': nrm(ks[15], (L, LRU_BLOCKS, LRU_BW, LRU_BW), LRU_BW ** -0.5),
        'b_rg_x': nrm(ks[16], (L, LRU_WIDTH), 0.02),
        'rg_lambda': jnp.log(a0) - jnp.log1p(-a0),
        'w_ro': nrm(ks[17], (L, LRU_WIDTH, D_MODEL), LRU_WIDTH ** -0.5),
        'w_out': nrm(ks[18], (L, D_MODEL, D_MODEL), D_MODEL ** -0.5),
        'norm_ffn_g': gain(ks[19], (L, D_MODEL)),
        'w_router': nrm(ks[20], (L, D_MODEL, N_EXPERTS), D_MODEL ** -0.5),
        'b_router': nrm(ks[21], (L, N_EXPERTS), 0.01),
        'w_up': nrm(ks[22], (L, N_EXPERTS, D_MODEL, 2 * D_FF), D_MODEL ** -0.5),
        'b_up': nrm(ks[23], (L, N_EXPERTS, 2 * D_FF), 0.02),
        'w_down': nrm(ks[24], (L, N_EXPERTS, D_FF, D_MODEL), D_FF ** -0.5),
        'b_down': nrm(ks[25], (L, N_EXPERTS, D_MODEL), 0.02),
        'norm_final_g': gain(ks[26], (D_MODEL,)),
    }


def reference(x, meta_tokens, norm_mix_g, w_in, b_gate, q_norm_g, w_uq, kv_norm_g, w_ukv, w_ao,
              conv_w, conv_b, w_rg_a, b_rg_a, w_rg_x, b_rg_x, rg_lambda, w_ro, w_out,
              norm_ffn_g, w_router, b_router, w_up, b_up, w_down, b_down, norm_final_g):
    B = x.shape[0]
    meta = jnp.broadcast_to(meta_tokens[None].astype(x.dtype), (B, N_META, D_MODEL))
    h = jnp.concatenate([meta, x], axis=1)
    T = h.shape[1]
    cos, sin = rope_tables(T, h.dtype)
    for l in range(DEPTH):
        xn = rms_norm(h, norm_mix_g[l])
        proj = xn @ w_in[l]
        attn = mla_branch(proj[..., OFF_CQ:OFF_CKV], proj[..., OFF_CKV:OFF_KR], proj[..., OFF_KR:OFF_RX],
                          q_norm_g[l], w_uq[l], kv_norm_g[l], w_ukv[l], w_ao[l], cos, sin)
        rec = rglru_branch(proj[..., OFF_RX:OFF_RG], proj[..., OFF_RG:OFF_GATE], conv_w[l], conv_b[l],
                           w_rg_a[l], b_rg_a[l], w_rg_x[l], b_rg_x[l], rg_lambda[l], w_ro[l])
        g = jax.nn.sigmoid(proj[..., OFF_GATE:] + b_gate[l])
        merged = g[..., :D_MODEL] * attn + g[..., D_MODEL:] * rec
        h = h + merged @ w_out[l]
        h = h + moe_ffn(rms_norm(h, norm_ffn_g[l]), w_router[l], b_router[l],
                        w_up[l], b_up[l], w_down[l], b_down[l])
    h = rms_norm(h, norm_final_g)
    return h[:, N_META:]
```

```cpp
#include <hip/hip_runtime.h>
#include <hip/hip_bf16.h>
#include <cstdio>
#include <cstdint>
#include <cmath>

#ifndef REP_P0
#define REP_P0 1
#endif
#ifndef REP_P1
#define REP_P1 1
#endif
#ifndef REP_P5
#define REP_P5 1
#endif
#ifndef REP_P10
#define REP_P10 1
#endif
#ifndef REP_P11
#define REP_P11 1
#endif
#ifndef REP_P2
#define REP_P2 1
#endif
#ifndef REP_P3
#define REP_P3 1
#endif
#ifndef REP_P4
#define REP_P4 1
#endif
#ifndef REP_P6
#define REP_P6 1
#endif
#ifndef REP_P7
#define REP_P7 1
#endif
#ifndef REP_P8
#define REP_P8 1
#endif
#ifndef REP_P12
#define REP_P12 1
#endif
#ifndef MK_N_LAUNCHES
#define MK_N_LAUNCHES 1
#endif

#define LAS __attribute__((address_space(3)))
#define GAS __attribute__((address_space(1)))
typedef unsigned short bf16_t;
typedef short bf16x8 __attribute__((ext_vector_type(8)));
typedef short s16x4 __attribute__((ext_vector_type(4)));
typedef float f32x2 __attribute__((ext_vector_type(2)));
typedef float f32x4 __attribute__((ext_vector_type(4)));
typedef float f32x16 __attribute__((ext_vector_type(16)));
typedef unsigned u32x2 __attribute__((ext_vector_type(2)));
typedef unsigned u32x4 __attribute__((ext_vector_type(4)));
typedef int i32x4 __attribute__((ext_vector_type(4)));
typedef int i32x8 __attribute__((ext_vector_type(8)));
typedef _Float16 h16x2 __attribute__((ext_vector_type(2)));
typedef _Float16 h16x8 __attribute__((ext_vector_type(8)));

constexpr int BATCH = 4, SEQ = 8192, DM = 1024, NX = BATCH * SEQ;
constexpr int NMETA = 16, MBLK = 64;
constexpr int RROWS = NX + BATCH * MBLK;
constexpr int TP = MBLK + SEQ;
constexpr int TPOS = NMETA + SEQ;
constexpr int NPROJ = 4864;
constexpr int NEXP = 32, ECAP = 32768;
constexpr int PROWS = 544 * 256;
constexpr float EPS = 1e-6f;

__device__ __forceinline__ float bf_lo(unsigned w) { return __uint_as_float(w << 16); }
__device__ __forceinline__ float bf_hi(unsigned w) { return __uint_as_float(w & 0xffff0000u); }
typedef __bf16 bf16x2_t __attribute__((ext_vector_type(2)));
__device__ __forceinline__ unsigned cvt_pk_bf16(float lo, float hi) { f32x2 v = {lo, hi}; bf16x2_t b = __builtin_convertvector(v, bf16x2_t); return __builtin_bit_cast(unsigned, b); }
__device__ __forceinline__ unsigned pack_fp8x4(float a, float b, float c, float d) {
    a = fminf(fmaxf(a, -448.f), 448.f); b = fminf(fmaxf(b, -448.f), 448.f); c = fminf(fmaxf(c, -448.f), 448.f); d = fminf(fmaxf(d, -448.f), 448.f);
    int w = 0; w = __builtin_amdgcn_cvt_pk_fp8_f32(a, b, w, false); w = __builtin_amdgcn_cvt_pk_fp8_f32(c, d, w, true); return (unsigned)w;
}
constexpr float W8_SCALE = 64.f;
constexpr float A8_SCALE = 4.f;
constexpr float Y8_SCALE = 16.f;
__device__ __forceinline__ float sigm(float x) { return __builtin_amdgcn_rcpf(1.f + __builtin_amdgcn_exp2f(-1.4426950408889634f * x)); }
__device__ __forceinline__ float gelu_tanh(float v) { const float z = v + 0.044715f * v * v * v; return v * __builtin_amdgcn_rcpf(1.f + __builtin_amdgcn_exp2f(-2.3022082f * z)); }
__device__ __forceinline__ int kvrow_of(int m) { return m < NX ? (m >> 13) * TP + MBLK + (m & 8191) : ((m - NX) >> 6) * TP + ((m - NX) & 63); }
__device__ __forceinline__ int pos_of(int m) { return m < NX ? NMETA + (m & 8191) : ((m - NX) & 63); }
__device__ __forceinline__ int lane_id_v() { int l; asm volatile("v_mbcnt_lo_u32_b32 %0, -1, 0\n\tv_mbcnt_hi_u32_b32 %0, -1, %0" : "=v"(l)); return l; }
__device__ __forceinline__ float wave_sum(float v) {
#pragma unroll
    for (int o = 1; o < 64; o <<= 1) v += __shfl_xor(v, o);
    return v;
}

__device__ __forceinline__ void glds16_s(const void* sbase, unsigned voff, unsigned lds_dst) {
    unsigned keep;
    asm volatile("s_mov_b32 %0, m0\n\ts_mov_b32 m0, %3\n\ts_nop 0\n\tglobal_load_lds_dwordx4 %1, %2\n\ts_mov_b32 m0, %0" : "=&s"(keep) : "v"(voff), "s"(sbase), "s"(lds_dst) : "memory");
}
__device__ __forceinline__ void glds4_s(const void* sbase, unsigned voff, unsigned lds_dst) {
    unsigned keep;
    asm volatile("s_mov_b32 %0, m0\n\ts_mov_b32 m0, %3\n\ts_nop 0\n\tglobal_load_lds_dword %1, %2\n\ts_mov_b32 m0, %0" : "=&s"(keep) : "v"(voff), "s"(sbase), "s"(lds_dst) : "memory");
}
namespace g8 {
constexpr int BM = 256, BK = 64, HALF = 128, HTB = HALF * BK * 2, STAGE_BYTES = 8 * HTB, NXCD = 8, WGM = 8;
__host__ __device__ __forceinline__ int lds_byte(int r, int c) { const int st = (r >> 4) * 2 + (c >> 5), rr = r & 15, cc = c & 31, ob = rr * 64 + cc * 2; return st * 1024 + (ob ^ (((ob >> 9) & 1) << 5)); }
__host__ __device__ __forceinline__ void stage_rc(int b, int& R, int& C) { const int st = b / 1024, sb = b % 1024, swz = sb ^ (((sb >> 9) & 1) << 5); R = (st >> 1) * 16 + swz / 64; C = (st & 1) * 32 + (swz % 64) / 2; }
__host__ __device__ __forceinline__ int perm32(int rho) { const int n = rho >> 4, i = rho & 15; return 8 * (i >> 2) + 4 * n + (i & 3); }

struct Unit { int pm, pn, e, mt, rem; };

struct StaticOrder {
    int nM, nN, nwg, G, c;
    __device__ void init(int M, int N, int G_, int c_) { nM = M / BM; nN = N / BM; nwg = nM * nN; G = G_; c = c_; }
    __device__ bool next(int i, Unit& u) const {
        const long L = (long)i * G + c; if (L >= nwg) return false;
        int wgid = (int)L; { const int q = nwg / NXCD, r = nwg % NXCD, xcd = wgid % NXCD, off = wgid / NXCD; wgid = (xcd < r ? xcd * (q + 1) : r * (q + 1) + (xcd - r) * q) + off; }
        const int nig = WGM * nN, gid = wgid / nig, fm = gid * WGM, gsz = (nM - fm) < WGM ? (nM - fm) : WGM;
        u.pm = fm + ((wgid % nig) % gsz); u.pn = (wgid % nig) / gsz; u.e = 0; u.mt = 0; u.rem = 256; return true;
    }
};
struct MoeOrder {
    const volatile LAS int* ts; int npn, G, vcu;
    __device__ bool next(int i, Unit& u) const {
        const long L = (long)i * G + vcu; const int g = (int)(L / npn), pn = (int)(L % npn);
        const int el = lane_id_v() & 31;
        const volatile LAS int* tl = ts + el;
        const int lo = tl[0], hi = tl[1], cn = tl[40];
        if (g >= __builtin_amdgcn_readlane(hi, 31)) return false;
        const unsigned long long mk = __ballot(lo <= g && g < hi);
        const int e = mk ? (int)__builtin_ctzll(mk) : 0;
        u.pm = g; u.pn = pn; u.e = e; u.mt = g - __builtin_amdgcn_readlane(lo, e); u.rem = __builtin_amdgcn_readlane(cn, e) - u.mt * 256; return true;
    }
};

struct PPlain { static constexpr bool GATHER = false, FP8 = false, SIDE = false; const bf16_t* A; const bf16_t* Bt; unsigned lda2, ldb2; int nt;
    __device__ __forceinline__ const char* a_tile(const Unit& u) const { return (const char*)A + (size_t)u.pm * 256 * lda2; }
    __device__ __forceinline__ const char* b_tile(const Unit& u) const { return (const char*)Bt + (size_t)u.pn * 256 * ldb2; }
    __device__ __forceinline__ const int* a_row_ptr(const Unit&, int) const { return nullptr; } };
struct PGates { static constexpr bool GATHER = false, FP8 = false, SIDE = false; const bf16_t* A; const bf16_t* Bt; unsigned lda2, ldb2; int nt;
    __device__ __forceinline__ const char* a_tile(const Unit& u) const { return (const char*)A + (size_t)u.pm * 256 * lda2 + (size_t)(u.pn >> 1) * 512; }
    __device__ __forceinline__ const char* b_tile(const Unit& u) const { return (const char*)Bt + (size_t)u.pn * 256 * ldb2; }
    __device__ __forceinline__ const int* a_row_ptr(const Unit&, int) const { return nullptr; } };
struct PUp { static constexpr bool GATHER = true, FP8 = true, SIDE = true; const unsigned char* A; const unsigned char* Bt; const int* elist; unsigned lda2, ldb2; int nt; int s2; const float* rowv; const float* bias;
    __device__ __forceinline__ const char* a_tile(const Unit&) const { return (const char*)A; }
    __device__ __forceinline__ const char* b_tile(const Unit& u) const { return (const char*)Bt + ((size_t)u.e * 2048 + (size_t)u.pn * 256) * ldb2; }
    __device__ __forceinline__ const int* a_row_ptr(const Unit& u, int r) const { const int rc = r < u.rem ? r : u.rem - 1; return elist + u.e * ECAP + u.mt * 256 + rc; }
    __device__ __forceinline__ void side_dma(const Unit& u, unsigned lds_slot, int wid, int lane) const {
        if (wid < 4) { const int r = 64 * wid + lane; glds4_s(rowv, (unsigned)(u.e * ECAP + u.mt * 256 + (r < u.rem ? r : u.rem - 1)) * 4u, lds_slot + wid * 256); }
        else { const int i = 64 * (wid - 4) + lane; glds4_s(bias, (unsigned)(u.e * 2048 + (i < 128 ? u.pn * 128 + i : 1024 + u.pn * 128 + (i - 128))) * 4u, lds_slot + wid * 256); } } };
struct PDown { static constexpr bool GATHER = false, FP8 = true, SIDE = true; const unsigned char* A; const unsigned char* Bt; unsigned lda2, ldb2; int nt; int s2; const float* rowv; const float* bias;
    __device__ __forceinline__ const char* a_tile(const Unit& u) const { return (const char*)A + (size_t)u.pm * 256 * lda2; }
    __device__ __forceinline__ const char* b_tile(const Unit& u) const { return (const char*)Bt + ((size_t)u.e * 1024 + (size_t)u.pn * 256) * ldb2; }
    __device__ __forceinline__ const int* a_row_ptr(const Unit&, int) const { return nullptr; }
    __device__ __forceinline__ void side_dma(const Unit& u, unsigned lds_slot, int wid, int lane) const {
        if (wid < 4) { const int r = 64 * wid + lane; glds4_s(rowv, (unsigned)(u.e * ECAP + u.mt * 256 + (r < u.rem ? r : u.rem - 1)) * 4u, lds_slot + wid * 256); }
        else { const int i = 64 * (wid - 4) + lane; glds4_s(bias, (unsigned)(u.e * 1024 + u.pn * 256 + i) * 4u, lds_slot + wid * 256); } } };

template <class P, class Epi, class Sched>
__device__ __forceinline__ void gemm_phase(LAS unsigned char* lds, const int wid, const P g, const Sched& S, const Epi& E) {
    const int lane = lane_id_v(), tid = wid * 64 + lane, wr = wid >> 2, wc = wid & 3;
    const int nt = g.nt;
    int fp8_s = 127; if constexpr (P::FP8) fp8_s = g.s2;
    (void)fp8_s;
    unsigned voffA0, voffB0, CA2; int RA0;
    { int R, C; stage_rc(tid * 16, R, C); const int Rb = (R & ~31) + perm32(R & 31);
      voffA0 = (unsigned)R * g.lda2 + (unsigned)C * 2u; voffB0 = (unsigned)Rb * g.ldb2 + (unsigned)C * 2u; RA0 = R; CA2 = (unsigned)C * 2u; }
    const size_t pstepA = (size_t)64 * g.lda2, pstepB = (size_t)64 * g.ldb2;
    LAS unsigned char* idlds = lds + STAGE_BYTES + 4096 + wid * 256;
    const size_t kstep = (size_t)(BK * 2);
    const size_t hstepA = (size_t)HALF * g.lda2, hstepB = (size_t)HALF * g.ldb2;
    const unsigned ldsw = (unsigned)wid * 1024u;
    const unsigned ldsbase = (unsigned)(uintptr_t)lds + ldsw;
    const int aoff = lds_byte(wr * 64 + (lane & 15), (lane >> 4) * 8), boff = lds_byte(wc * 32 + (lane & 15), (lane >> 4) * 8);
#define G8_SA(b, h) (((b) * 2 + (h)) * HTB)
#define G8_SB(b, h) ((4 + (b) * 2 + (h)) * HTB)
#define G8_STB(bufoff, gbase) do { _Pragma("unroll") for (int _i = 0; _i < 2; ++_i) { \
        if constexpr (P::FP8) glds16_s((const char*)(gbase) + (size_t)_i * pstepB, voffB0, ldsbase + (unsigned)((bufoff) + _i * 8192)); \
        else __builtin_amdgcn_global_load_lds((const unsigned*)((const char*)(gbase) + (size_t)_i * pstepB + voffB0), (LAS unsigned*)(lds + (bufoff) + ldsw + _i * 8192), 16, 0, 0); } } while (0)
#define G8_STA(bufoff, kp, h, GO) do { _Pragma("unroll") for (int _i = 0; _i < 2; ++_i) { \
        if constexpr (P::FP8) { if constexpr (P::GATHER) glds16_s((const char*)(kp), GO[h][_i] * g.lda2 + CA2, ldsbase + (unsigned)((bufoff) + _i * 8192)); \
                                else glds16_s((const char*)(kp) + (size_t)(h) * hstepA + (size_t)_i * pstepA, voffA0, ldsbase + (unsigned)((bufoff) + _i * 8192)); } \
        else { const char* _p = P::GATHER ? ((const char*)(kp) + (GO[h][_i] * g.lda2 + CA2)) : ((const char*)(kp) + (size_t)(h) * hstepA + (size_t)_i * pstepA + voffA0); \
        __builtin_amdgcn_global_load_lds((const unsigned*)_p, (LAS unsigned*)(lds + (bufoff) + ldsw + _i * 8192), 16, 0, 0); } } } while (0)
#define G8_LDA(dst, b, h) do { _Pragma("unroll") for (int m = 0; m < 4; ++m) _Pragma("unroll") for (int k = 0; k < 2; ++k) dst[m][k] = *(const LAS bf16x8*)(lds + G8_SA(b, h) + aoff + m * 2048 + k * 1024); } while (0)
#define G8_LDB(dst, b, h) do { _Pragma("unroll") for (int n = 0; n < 2; ++n) _Pragma("unroll") for (int k = 0; k < 2; ++k) dst[n][k] = *(const LAS bf16x8*)(lds + G8_SB(b, h) + boff + n * 2048 + k * 1024); } while (0)
#define G8_MMA(ai, bj, At, Bt) do { __builtin_amdgcn_s_setprio(1); \
        if constexpr (P::FP8) { _Pragma("unroll") for (int m = 0; m < 4; ++m) _Pragma("unroll") for (int n = 0; n < 2; ++n) { \
            const i32x8 a8_ = __builtin_shufflevector(__builtin_bit_cast(i32x4, At[m][0]), __builtin_bit_cast(i32x4, At[m][1]), 0, 1, 2, 3, 4, 5, 6, 7); \
            const i32x8 b8_ = __builtin_shufflevector(__builtin_bit_cast(i32x4, Bt[n][0]), __builtin_bit_cast(i32x4, Bt[n][1]), 0, 1, 2, 3, 4, 5, 6, 7); \
            acc[ai][bj][m][n] = __builtin_amdgcn_mfma_scale_f32_16x16x128_f8f6f4(b8_, a8_, acc[ai][bj][m][n], 0, 0, 0, fp8_s, 0, fp8_s); } } \
        else { _Pragma("unroll") for (int m = 0; m < 4; ++m) _Pragma("unroll") for (int n = 0; n < 2; ++n) _Pragma("unroll") for (int k = 0; k < 2; ++k) \
            acc[ai][bj][m][n] = __builtin_amdgcn_mfma_f32_16x16x32_bf16(Bt[n][k], At[m][k], acc[ai][bj][m][n], 0, 0, 0); } \
        __builtin_amdgcn_s_setprio(0); } while (0)
#define G8_WAIT_V(n) asm volatile("s_waitcnt vmcnt(" #n ")" ::: "memory")
#define G8_WAIT_L(n) asm volatile("s_waitcnt lgkmcnt(" #n ")" ::: "memory")
#define G8_BAR __builtin_amdgcn_s_barrier()
#define G8_SCHED __builtin_amdgcn_sched_barrier(0)
    Unit cur, nxt; int ui = 0;
    if (!S.next(0, cur)) return;
    f32x4 acc[2][2][4][2];
#pragma unroll
    for (int a = 0; a < 2; ++a)
#pragma unroll
        for (int b = 0; b < 2; ++b)
#pragma unroll
            for (int m = 0; m < 4; ++m)
#pragma unroll
                for (int n = 0; n < 2; ++n) acc[a][b][m][n] = (f32x4){0.f, 0.f, 0.f, 0.f};
    if constexpr (Epi::PRELOAD) { const int l0 = lane_id_v(); E.preload(acc, cur, wr, wc, l0 & 15, l0 >> 4); }
    bf16x8 At[4][2], B0[2][2], B1[2][2];
    unsigned gc[2][2];
#pragma unroll
    for (int h = 0; h < 2; ++h)
#pragma unroll
        for (int i = 0; i < 2; ++i) gc[h][i] = P::GATHER ? (unsigned)*g.a_row_ptr(cur, h * 128 + i * 64 + RA0) : 0u;
    const unsigned sidebase = (unsigned)(uintptr_t)lds + (unsigned)STAGE_BYTES + 12288u;
    if constexpr (P::SIDE) g.side_dma(cur, sidebase, wid, lane_id_v());
    const char* cA = g.a_tile(cur); const char* cB = g.b_tile(cur);
    G8_STB(G8_SB(0, 0), cB); G8_STB(G8_SB(0, 1), cB + hstepB); G8_STA(G8_SA(0, 0), cA, 0, gc); G8_STA(G8_SA(0, 1), cA, 1, gc);
    if (wr == 1) G8_BAR;
    G8_WAIT_V(2); G8_BAR;
    G8_STB(G8_SB(1, 0), cB + kstep); G8_STA(G8_SA(1, 0), cA + kstep, 0, gc); G8_STB(G8_SB(1, 1), cB + hstepB + kstep);
    G8_WAIT_V(6); G8_BAR;
    for (;;) {
        const bool has_next = S.next(ui + 1, nxt);
        const char* nA = has_next ? g.a_tile(nxt) : cA; const char* nB = has_next ? g.b_tile(nxt) : cB;
        if constexpr (P::SIDE) { if (has_next) g.side_dma(nxt, sidebase + (unsigned)(((ui + 1) % 3) * 2048), wid, lane_id_v()); }
        if (P::GATHER && has_next) {
#pragma unroll
            for (int h = 0; h < 2; ++h)
#pragma unroll
                for (int i = 0; i < 2; ++i) __builtin_amdgcn_global_load_lds((const unsigned*)g.a_row_ptr(nxt, h * 128 + i * 64 + RA0), (LAS unsigned*)(idlds + (h * 2 + i) * 2048), 4, 0, 0);
        }
#define G8_KITER(a1, a2, b2, O2, G8_IDSWAP) do { \
            const char* a3 = (a2) + kstep; const char* b3 = (b2) + kstep; \
              \
            G8_LDB(B0, 0, 0); G8_LDB(B1, 0, 1); G8_SCHED; G8_LDA(At, 0, 0); G8_STA(G8_SA(1, 1), a1, 1, gc); G8_IDSWAP(); \
            G8_WAIT_V(8); G8_WAIT_L(0); G8_BAR; G8_MMA(0, 0, At, B0); G8_MMA(0, 1, At, B1); G8_BAR; G8_SCHED; \
              \
            G8_LDA(At, 0, 1); G8_STB(G8_SB(0, 0), b2); G8_STB(G8_SB(0, 1), (b2) + hstepB); G8_STA(G8_SA(0, 0), a2, 0, O2); \
            G8_WAIT_V(8); G8_WAIT_L(0); G8_BAR; G8_MMA(1, 0, At, B0); G8_MMA(1, 1, At, B1); G8_BAR; G8_SCHED; \
              \
            G8_LDB(B0, 1, 0); G8_LDB(B1, 1, 1); G8_SCHED; G8_LDA(At, 1, 0); G8_STA(G8_SA(0, 1), a2, 1, O2); \
            G8_WAIT_V(8); G8_WAIT_L(0); G8_BAR; G8_MMA(0, 0, At, B0); G8_MMA(0, 1, At, B1); G8_BAR; G8_SCHED; \
              \
            G8_LDA(At, 1, 1); G8_STB(G8_SB(1, 0), b3); G8_STB(G8_SB(1, 1), b3 + hstepB); G8_STA(G8_SA(1, 0), a3, 0, O2); \
            G8_WAIT_V(8); G8_WAIT_L(0); G8_BAR; G8_MMA(1, 0, At, B0); G8_MMA(1, 1, At, B1); G8_BAR; G8_SCHED; } while (0)
#define G8_SWAP_IDS() do { if (P::GATHER && last && has_next) { const unsigned ida = (unsigned)(uintptr_t)(idlds + lane_id_v() * 4); \
                asm volatile("ds_read_b32 %0, %4\n\tds_read_b32 %1, %4 offset:2048\n\tds_read_b32 %2, %4 offset:4096\n\tds_read_b32 %3, %4 offset:6144\n\ts_waitcnt lgkmcnt(0)" \
                             : "=&v"(gc[0][0]), "=&v"(gc[0][1]), "=&v"(gc[1][0]), "=&v"(gc[1][1]) : "v"(ida) : "memory"); } } while (0)
#pragma nounroll
        for (int t = 0; t < nt; t += 2) {
            const bool last = (t == nt - 2);
            const char* a1 = cA + (size_t)(t + 1) * kstep;
            const char* a2 = last ? nA : cA + (size_t)(t + 2) * kstep; const char* b2 = last ? nB : cB + (size_t)(t + 2) * kstep;
            G8_KITER(a1, a2, b2, gc, G8_SWAP_IDS);
        }
#undef G8_SWAP_IDS
#undef G8_KITER
        if (wr == 0) G8_BAR;
        { const int l2 = lane_id_v(); if constexpr (P::SIDE) E(acc, cur, wr, wc, l2 & 15, l2 >> 4, (const LAS float*)(lds + STAGE_BYTES + 12288 + (ui % 3) * 2048)); else E(acc, cur, wr, wc, l2 & 15, l2 >> 4); }
        if (!has_next) break;
#pragma unroll
        for (int a = 0; a < 2; ++a)
#pragma unroll
            for (int b = 0; b < 2; ++b)
#pragma unroll
                for (int m = 0; m < 4; ++m)
#pragma unroll
                    for (int n = 0; n < 2; ++n) acc[a][b][m][n] = (f32x4){0.f, 0.f, 0.f, 0.f};
        if constexpr (Epi::PRELOAD) { const int l0 = lane_id_v(); E.preload(acc, nxt, wr, wc, l0 & 15, l0 >> 4); }
        cur = nxt; cA = nA; cB = nB; ++ui;
        if (wr == 1) G8_BAR;
    }
    G8_WAIT_V(0);
    G8_BAR;
#undef G8_SA
#undef G8_SB
#undef G8_STB
#undef G8_STA
#undef G8_LDA
#undef G8_LDB
#undef G8_MMA
#undef G8_WAIT_V
#undef G8_WAIT_L
#undef G8_BAR
#undef G8_SCHED
}

#define EPI_ROWS_BEGIN() _Pragma("unroll") for (int ai = 0; ai < 2; ++ai) _Pragma("unroll") for (int m = 0; m < 4; ++m) { const int rr = ai * HALF + wr * 64 + m * 16 + fr;
#define EPI_ROWS_END() }
__device__ __forceinline__ u32x4 pack8(const f32x4& a, const f32x4& b) { u32x4 w; w.x = cvt_pk_bf16(a[0], a[1]); w.y = cvt_pk_bf16(a[2], a[3]); w.z = cvt_pk_bf16(b[0], b[1]); w.w = cvt_pk_bf16(b[2], b[3]); return w; }

struct EpiProj {
    static constexpr bool PRELOAD = false;
    bf16_t *PQ, *PRX, *GRG, *GATE; const float* b_gate;
    template <int ACT> __device__ __forceinline__ void tile(const f32x4 (&acc)[2][2][4][2], bf16_t* base, int ldc, int colt, int row0, int wr, int wc, int fr, int fq) const {
        const int cw = wc * 32 + 8 * fq;
        f32x4 bv[2][2];
#pragma unroll
        for (int bj = 0; bj < 2; ++bj)
#pragma unroll
            for (int n = 0; n < 2; ++n) bv[bj][n] = ACT == 2 ? *(const f32x4*)(b_gate + colt + bj * HALF + cw + 4 * n) : (f32x4){0.f, 0.f, 0.f, 0.f};
        EPI_ROWS_BEGIN()
            bf16_t* rowp = base + (size_t)(row0 + rr) * ldc + colt + cw;
#pragma unroll
            for (int bj = 0; bj < 2; ++bj) { f32x4 v0 = acc[ai][bj][m][0], v1 = acc[ai][bj][m][1];
                if (ACT == 1) {
#pragma unroll
                    for (int j = 0; j < 4; ++j) { v0[j] = gelu_tanh(v0[j]); v1[j] = gelu_tanh(v1[j]); } }
                if (ACT == 2) { v0 += bv[bj][0]; v1 += bv[bj][1];
#pragma unroll
                    for (int j = 0; j < 4; ++j) { v0[j] = sigm(v0[j]); v1[j] = sigm(v1[j]); } }
                *(u32x4*)(rowp + bj * HALF) = pack8(v0, v1); }
        EPI_ROWS_END()
    }
    __device__ __forceinline__ void operator()(const f32x4 (&acc)[2][2][4][2], const Unit& u, int wr, int wc, int fr, int fq) const {
        const int pn = u.pn, row0 = u.pm * BM;
        if (pn < 3) tile<0>(acc, PQ, 768, pn * 256, row0, wr, wc, fr, fq);
        else if (pn < 7) tile<0>(acc, PRX, 1024, (pn - 3) * 256, row0, wr, wc, fr, fq);
        else if (pn < 11) tile<1>(acc, GRG, 1024, (pn - 7) * 256, row0, wr, wc, fr, fq);
        else tile<2>(acc, GATE, 2048, (pn - 11) * 256, row0, wr, wc, fr, fq);
    }
};
struct EpiQ {
    static constexpr bool PRELOAD = false;
    bf16_t* Q; const float* COS; const float* SIN;
    __device__ __forceinline__ void operator()(const f32x4 (&acc)[2][2][4][2], const Unit& u, int wr, int wc, int fr, int fq) const {
        EPI_ROWS_BEGIN()
            const int row = u.pm * BM + rr, t = NMETA + (row & 8191);
#pragma unroll
            for (int bj = 0; bj < 2; ++bj) { const int col0 = u.pn * BM + bj * HALF + wc * 32 + 8 * fq, hh = col0 / 96, off = col0 - 96 * hh;
                f32x4 v0 = acc[ai][bj][m][0], v1 = acc[ai][bj][m][1];
                if (off >= 64) { const int i0 = (off - 64) >> 1; const f32x4 c = *(const f32x4*)(COS + t * 16 + i0), s = *(const f32x4*)(SIN + t * 16 + i0);
                    const float a0 = v0[0] * c[0] - v0[1] * s[0], b0 = v0[0] * s[0] + v0[1] * c[0];
                    const float a1 = v0[2] * c[1] - v0[3] * s[1], b1 = v0[2] * s[1] + v0[3] * c[1];
                    const float a2 = v1[0] * c[2] - v1[1] * s[2], b2 = v1[0] * s[2] + v1[1] * c[2];
                    const float a3 = v1[2] * c[3] - v1[3] * s[3], b3 = v1[2] * s[3] + v1[3] * c[3];
                    v0 = (f32x4){a0, b0, a1, b1}; v1 = (f32x4){a2, b2, a3, b3}; }
                *(u32x4*)(Q + (size_t)row * 768 + col0) = pack8(v0, v1); }
        EPI_ROWS_END()
    }
};
struct EpiKV {
    static constexpr bool PRELOAD = false;
    bf16_t *KN, *V;
    __device__ __forceinline__ void operator()(const f32x4 (&acc)[2][2][4][2], const Unit& u, int wr, int wc, int fr, int fq) const {
        EPI_ROWS_BEGIN()
            const int kr = kvrow_of(u.pm * BM + rr);
#pragma unroll
            for (int bj = 0; bj < 2; ++bj) { const int col0 = u.pn * BM + bj * HALF + wc * 32 + 8 * fq, hh = col0 >> 7, j = col0 & 127;
                bf16_t* dst = (j < 64 ? KN + hh * 64 + j : V + hh * 64 + (j - 64)) + (size_t)kr * 512;
                *(u32x4*)dst = pack8(acc[ai][bj][m][0], acc[ai][bj][m][1]); }
        EPI_ROWS_END()
    }
};
struct EpiGates {
    static constexpr bool PRELOAD = false;
    const bf16_t* XC; const float *b_a, *b_x; _Float16 *R16, *U16;
    __device__ __forceinline__ void operator()(const f32x4 (&acc)[2][2][4][2], const Unit& u, int wr, int wc, int fr, int fq) const {
        const int ch = u.pn * 128 + wc * 32 + 8 * fq;
        const f32x4 ba0 = *(const f32x4*)(b_a + ch), ba1 = *(const f32x4*)(b_a + ch + 4), bx0 = *(const f32x4*)(b_x + ch), bx1 = *(const f32x4*)(b_x + ch + 4);
        u32x4 xwv[2][4];
#pragma unroll
        for (int ai = 0; ai < 2; ++ai)
#pragma unroll
            for (int m = 0; m < 4; ++m) xwv[ai][m] = *(const u32x4*)(XC + (size_t)(u.pm * BM + ai * HALF + wr * 64 + m * 16 + fr) * 1024 + ch);
        asm volatile("" ::: "memory");
        EPI_ROWS_BEGIN()
            const size_t o = (size_t)(u.pm * BM + rr) * 1024 + ch;
            const u32x4 xw = xwv[ai][m];
            const f32x4 a0 = acc[ai][0][m][0] + ba0, a1 = acc[ai][0][m][1] + ba1, x0 = acc[ai][1][m][0] + bx0, x1 = acc[ai][1][m][1] + bx1;
            float xc[8] = {bf_lo(xw.x), bf_hi(xw.x), bf_lo(xw.y), bf_hi(xw.y), bf_lo(xw.z), bf_hi(xw.z), bf_lo(xw.w), bf_hi(xw.w)};
            h16x8 rv, uv;
#pragma unroll
            for (int j = 0; j < 4; ++j) { rv[j] = (_Float16)sigm(a0[j]); rv[4 + j] = (_Float16)sigm(a1[j]); uv[j] = (_Float16)(sigm(x0[j]) * xc[j]); uv[4 + j] = (_Float16)(sigm(x1[j]) * xc[4 + j]); }
            *(h16x8*)(R16 + o) = rv; *(h16x8*)(U16 + o) = uv;
        EPI_ROWS_END()
    }
};
struct EpiAo {
    static constexpr bool PRELOAD = false;
    const bf16_t* GATE; bf16_t* MA;
    __device__ __forceinline__ void operator()(const f32x4 (&acc)[2][2][4][2], const Unit& u, int wr, int wc, int fr, int fq) const {
#pragma unroll
        for (int ai = 0; ai < 2; ++ai) { u32x4 gw[4][2];
#pragma unroll
            for (int m = 0; m < 4; ++m) { const int row = u.pm * BM + ai * HALF + wr * 64 + m * 16 + fr;
#pragma unroll
                for (int bj = 0; bj < 2; ++bj) gw[m][bj] = __builtin_nontemporal_load((const u32x4*)(GATE + (size_t)row * 2048 + u.pn * BM + bj * HALF + wc * 32 + 8 * fq)); }
            asm volatile("" ::: "memory");
#pragma unroll
            for (int m = 0; m < 4; ++m) { const int row = u.pm * BM + ai * HALF + wr * 64 + m * 16 + fr;
#pragma unroll
                for (int bj = 0; bj < 2; ++bj) { const int col0 = u.pn * BM + bj * HALF + wc * 32 + 8 * fq; const u32x4 g = gw[m][bj];
                    f32x4 v0 = acc[ai][bj][m][0], v1 = acc[ai][bj][m][1];
                    v0 *= (f32x4){bf_lo(g.x), bf_hi(g.x), bf_lo(g.y), bf_hi(g.y)}; v1 *= (f32x4){bf_lo(g.z), bf_hi(g.z), bf_lo(g.w), bf_hi(g.w)};
                    *(u32x4*)(MA + (size_t)row * 1024 + col0) = pack8(v0, v1); } } }
    }
};
struct EpiRo {
    static constexpr bool PRELOAD = false;
    const bf16_t* GATE; const bf16_t* MA; bf16_t* MG;
    __device__ __forceinline__ void operator()(const f32x4 (&acc)[2][2][4][2], const Unit& u, int wr, int wc, int fr, int fq) const {
#pragma unroll
        for (int ai = 0; ai < 2; ++ai) { u32x4 gw[4][2], mw[4][2];
#pragma unroll
            for (int m = 0; m < 4; ++m) { const int row = u.pm * BM + ai * HALF + wr * 64 + m * 16 + fr;
#pragma unroll
                for (int bj = 0; bj < 2; ++bj) { const int col0 = u.pn * BM + bj * HALF + wc * 32 + 8 * fq;
                    gw[m][bj] = __builtin_nontemporal_load((const u32x4*)(GATE + (size_t)row * 2048 + 1024 + col0)); mw[m][bj] = *(const u32x4*)(MA + (size_t)row * 1024 + col0); } }
            asm volatile("" ::: "memory");
#pragma unroll
            for (int m = 0; m < 4; ++m) { const int row = u.pm * BM + ai * HALF + wr * 64 + m * 16 + fr;
#pragma unroll
                for (int bj = 0; bj < 2; ++bj) { const int col0 = u.pn * BM + bj * HALF + wc * 32 + 8 * fq; const u32x4 g = gw[m][bj], q = mw[m][bj];
                    f32x4 v0 = acc[ai][bj][m][0], v1 = acc[ai][bj][m][1];
                    v0 = v0 * (f32x4){bf_lo(g.x), bf_hi(g.x), bf_lo(g.y), bf_hi(g.y)} + (f32x4){bf_lo(q.x), bf_hi(q.x), bf_lo(q.y), bf_hi(q.y)};
                    v1 = v1 * (f32x4){bf_lo(g.z), bf_hi(g.z), bf_lo(g.w), bf_hi(g.w)} + (f32x4){bf_lo(q.z), bf_hi(q.z), bf_lo(q.w), bf_hi(q.w)};
                    *(u32x4*)(MG + (size_t)row * 1024 + col0) = pack8(v0, v1); } } }
    }
};
struct EpiOut {
    static constexpr bool PRELOAD = true;
    const float* X; bf16_t* H2; unsigned char* H8; const float* gffn;
    __device__ __forceinline__ void preload(f32x4 (&acc)[2][2][4][2], const Unit& u, int wr, int wc, int fr, int fq) const {
        EPI_ROWS_BEGIN()
            const int row = u.pm * BM + rr;
#pragma unroll
            for (int bj = 0; bj < 2; ++bj) { const size_t o = (size_t)row * 1024 + u.pn * BM + bj * HALF + wc * 32 + 8 * fq;
                acc[ai][bj][m][0] = __builtin_nontemporal_load((const f32x4*)(X + o)); acc[ai][bj][m][1] = __builtin_nontemporal_load((const f32x4*)(X + o + 4)); }
        EPI_ROWS_END()
    }
    __device__ __forceinline__ void operator()(const f32x4 (&acc)[2][2][4][2], const Unit& u, int wr, int wc, int fr, int fq) const {
        EPI_ROWS_BEGIN()
            const int row = u.pm * BM + rr;
#pragma unroll
            for (int bj = 0; bj < 2; ++bj) { const size_t o = (size_t)row * 1024 + u.pn * BM + bj * HALF + wc * 32 + 8 * fq;
                const f32x4 v0 = acc[ai][bj][m][0], v1 = acc[ai][bj][m][1];
                *(u32x4*)(H2 + o) = pack8(v0, v1);
                const int cg_ = u.pn * BM + bj * HALF + wc * 32 + 8 * fq; const f32x4 g0 = *(const f32x4*)(gffn + cg_), g1 = *(const f32x4*)(gffn + cg_ + 4);
                u32x2 w8; w8.x = pack_fp8x4(v0[0] * g0[0], v0[1] * g0[1], v0[2] * g0[2], v0[3] * g0[3]); w8.y = pack_fp8x4(v1[0] * g1[0], v1[1] * g1[1], v1[2] * g1[2], v1[3] * g1[3]); *(u32x2*)(H8 + o) = w8; }
        EPI_ROWS_END()
    }
};
struct EpiUp {
    static constexpr bool PRELOAD = false;
    unsigned char* ACT;
    __device__ __forceinline__ void operator()(const f32x4 (&acc)[2][2][4][2], const Unit& u, int wr, int wc, int fr, int fq, const LAS float* side) const {
        const int c0 = u.pn * 128 + wc * 32 + 8 * fq, cl = wc * 32 + 8 * fq;
        const f32x4 bg0 = *(const LAS f32x4*)(side + 256 + cl), bg1 = *(const LAS f32x4*)(side + 256 + cl + 4), bl0 = *(const LAS f32x4*)(side + 384 + cl), bl1 = *(const LAS f32x4*)(side + 384 + cl + 4);
        EPI_ROWS_BEGIN()
            const float rs = side[rr];
            f32x4 g0 = acc[ai][0][m][0] * rs + bg0, g1 = acc[ai][0][m][1] * rs + bg1, l0 = acc[ai][1][m][0] * rs + bl0, l1 = acc[ai][1][m][1] * rs + bl1;
#pragma unroll
            for (int j = 0; j < 4; ++j) {
                const float a = fminf(g0[j], 7.f), b = fminf(g1[j], 7.f);
                const float p = fminf(fmaxf(l0[j], -7.f), 7.f), q = fminf(fmaxf(l1[j], -7.f), 7.f);
                g0[j] = a * sigm(1.702f * a) * (p + 1.f); g1[j] = b * sigm(1.702f * b) * (q + 1.f); }
            { u32x2 w8; w8.x = pack_fp8x4(g0[0] * A8_SCALE, g0[1] * A8_SCALE, g0[2] * A8_SCALE, g0[3] * A8_SCALE); w8.y = pack_fp8x4(g1[0] * A8_SCALE, g1[1] * A8_SCALE, g1[2] * A8_SCALE, g1[3] * A8_SCALE);
              *(u32x2*)(ACT + (size_t)(u.pm * BM + rr) * 1024 + c0) = w8; }
        EPI_ROWS_END()
    }
};
struct EpiDown {
    static constexpr bool PRELOAD = false;
    unsigned char* YE;
    __device__ __forceinline__ void operator()(const f32x4 (&acc)[2][2][4][2], const Unit& u, int wr, int wc, int fr, int fq, const LAS float* side) const {
        f32x4 bdv[2][2];
#pragma unroll
        for (int bj = 0; bj < 2; ++bj) { bdv[bj][0] = *(const LAS f32x4*)(side + 256 + bj * HALF + wc * 32 + 8 * fq); bdv[bj][1] = *(const LAS f32x4*)(side + 256 + bj * HALF + wc * 32 + 8 * fq + 4); }
        EPI_ROWS_BEGIN()
            const float gt = side[rr] * Y8_SCALE;
#pragma unroll
            for (int bj = 0; bj < 2; ++bj) { const int col0 = u.pn * BM + bj * HALF + wc * 32 + 8 * fq;
                const f32x4 v0 = (acc[ai][bj][m][0] + bdv[bj][0]) * gt, v1 = (acc[ai][bj][m][1] + bdv[bj][1]) * gt;
                u32x2 w8; w8.x = pack_fp8x4(v0[0], v0[1], v0[2], v0[3]); w8.y = pack_fp8x4(v1[0], v1[1], v1[2], v1[3]);
                *(u32x2*)(YE + (size_t)(u.pm * BM + rr) * 1024 + col0) = w8; }
        EPI_ROWS_END()
    }
};
}

namespace att {
constexpr int NW = 8, QBLK = 32, KVBLK = 64, QB = 256;
constexpr int LDQ = 768, LDKN = 512, LDKP = 32, LDV = 512, LDO = 512;
constexpr int SHM_K = KVBLK * 256, SHM_V = KVBLK * 64 * 2;
constexpr int LDS_BYTES = 2 * SHM_V + 2 * SHM_K + NW * 64 * 4;
constexpr float SCALE = 0.10206207261596577f;
constexpr float THR = 8.f;
#define KSWZ(row, colB) ((row) * 256 + ((colB) ^ (((row) & 7) << 4)))
#define SBAR() __builtin_amdgcn_sched_barrier(0)
__device__ __forceinline__ int v_st(int k, int c) { const int kk = (k & ~0xC) | ((k & 4) << 1) | ((k & 8) >> 1); return ((kk >> 3) * 2 + (c >> 5)) * 512 + ((kk & 7) * 32 + (c & 31)) * 2; }
__device__ __forceinline__ int v_rd_base(int lane) { return ((lane & 3) << 3) | (((lane >> 2) & 3) << 6) | (((lane >> 4) & 1) << 5) | (((lane >> 5) & 1) << 8); }
__device__ __forceinline__ int crow(int r, int hi) { return (r & 3) + 8 * (r >> 2) + 4 * hi; }
__device__ __forceinline__ unsigned cvtpk(float lo, float hi) { return cvt_pk_bf16(lo, hi); }
__device__ __forceinline__ bf16x8 load8(const bf16_t* p) { return *reinterpret_cast<const bf16x8*>(p); }
__device__ __forceinline__ void mask_tile(f32x16& p0, f32x16& p1, int dq) {
    const float NEG = -__builtin_inff();
#pragma unroll
    for (int r = 0; r < 16; ++r) { const int c = (r & 3) + 8 * (r >> 2); if (c > dq) p0[r] = NEG; if (c + 32 > dq) p1[r] = NEG; }
}
__device__ __forceinline__ void mask_meta(f32x16& p0, f32x16& p1) {
    const float NEG = -__builtin_inff();
#pragma unroll
    for (int r = 8; r < 16; ++r) p0[r] = NEG;
#pragma unroll
    for (int r = 0; r < 16; ++r) p1[r] = NEG;
}
__device__ __forceinline__ void partialSM(f32x16& p0, f32x16& p1, float& m_reg, float& mn, float& alpha) {
    float pmax = p0[0];
#pragma unroll
    for (int r = 1; r < 16; ++r) pmax = fmaxf(pmax, p0[r]);
#pragma unroll
    for (int r = 0; r < 16; ++r) pmax = fmaxf(pmax, p1[r]);
    { auto rr = __builtin_amdgcn_permlane32_swap(__float_as_uint(pmax), __float_as_uint(pmax), false, false);
      pmax = fmaxf(__uint_as_float(rr[0]), __uint_as_float(rr[1])); }
    constexpr float C2 = 1.4426950408889634f * SCALE;
    if (__builtin_expect(__all((pmax - m_reg) * SCALE <= THR), 1)) { mn = m_reg; alpha = 1.f; }
    else { mn = fmaxf(m_reg, pmax); alpha = __builtin_amdgcn_exp2f((m_reg - mn) * C2); m_reg = mn; }
    const float mnL = -mn * C2;
    { const f32x2 c2v = {C2, C2}, mlv = {mnL, mnL};
#pragma unroll
      for (int r = 0; r < 16; r += 2) { f32x2 a = {p0[r], p0[r + 1]}, b = {p1[r], p1[r + 1]}; a = __builtin_elementwise_fma(a, c2v, mlv); b = __builtin_elementwise_fma(b, c2v, mlv);
          p0[r] = a.x; p0[r + 1] = a.y; p1[r] = b.x; p1[r + 1] = b.y; } }
#pragma unroll
    for (int r = 0; r < 16; ++r) p0[r] = __builtin_amdgcn_exp2f(p0[r]);
}
__device__ __forceinline__ void finishSM(f32x16& p0, f32x16& p1, float alpha, float& l_reg, bf16x8& pa0, bf16x8& pa1, bf16x8& pa2, bf16x8& pa3) {
#pragma unroll
    for (int r = 0; r < 16; ++r) p1[r] = __builtin_amdgcn_exp2f(p1[r]);
    float ps;
    { f32x2 s2 = {0.f, 0.f}, t2 = {0.f, 0.f};
#pragma unroll
      for (int r = 0; r < 16; r += 2) { s2 += (f32x2){p0[r], p0[r + 1]}; t2 += (f32x2){p1[r], p1[r + 1]}; }
      s2 += t2; ps = s2.x + s2.y; }
    { auto rr = __builtin_amdgcn_permlane32_swap(__float_as_uint(ps), __float_as_uint(ps), false, false);
      ps = __uint_as_float(rr[0]) + __uint_as_float(rr[1]); }
    l_reg = l_reg * alpha + ps;
#define PK4(P, B_, OUT) do { unsigned a0 = cvtpk(P[B_+0], P[B_+1]), a1 = cvtpk(P[B_+2], P[B_+3]);                          \
        unsigned b0 = cvtpk(P[B_+4], P[B_+5]), b1 = cvtpk(P[B_+6], P[B_+7]);                                             \
        auto r0 = __builtin_amdgcn_permlane32_swap(a0, b0, false, false); auto r1 = __builtin_amdgcn_permlane32_swap(a1, b1, false, false); \
        u32x4 w = {r0[0], r1[0], r0[1], r1[1]}; OUT = *reinterpret_cast<bf16x8*>(&w); } while (0)
    PK4(p0, 0, pa0); PK4(p0, 8, pa1); PK4(p1, 0, pa2); PK4(p1, 8, pa3);
#undef PK4
}
template <int KB>
__device__ __forceinline__ void qkt(f32x16& p0, f32x16& p1, const char* K_lds, int r32, int hi, const bf16x8* qr) {
    p0 = f32x16{}; p1 = f32x16{};
    const char* kb[4];
#pragma unroll
    for (int dd = 0; dd < 4; ++dd) kb[dd] = K_lds + KB * SHM_K + KSWZ(r32, (dd * 16 + hi * 8) * 2);
#pragma unroll
    for (int d0 = 0; d0 < 6; ++d0) { const char* a = kb[d0 & 3] + (d0 >> 2) * 128;
        bf16x8 b0 = *reinterpret_cast<const bf16x8*>(a);
        bf16x8 b1 = *reinterpret_cast<const bf16x8*>(a + 32 * 256);
        p0 = __builtin_amdgcn_mfma_f32_32x32x16_bf16(b0, qr[d0], p0, 0, 0, 0);
        p1 = __builtin_amdgcn_mfma_f32_32x32x16_bf16(b1, qr[d0], p1, 0, 0, 0); }
}
template <int VB>
__device__ __forceinline__ void pv_tile(f32x16* o, int vb0, bf16x8 pa0, bf16x8 pa1, bf16x8 pa2, bf16x8 pa3) {
#define TRRD(dst, off) asm volatile("ds_read_b64_tr_b16 %0, %1 offset:%2" : "=&v"(dst) : "v"(vb0), "i"(off) : "memory")
#define PV_D0(d0) do { s16x4 l0, l1, l2, l3, h0, h1, h2, h3; constexpr int b_ = VB * SHM_V + (d0) * 512;     \
        TRRD(l0, b_); TRRD(h0, b_ + 1024); TRRD(l1, b_ + 2048); TRRD(h1, b_ + 3072); TRRD(l2, b_ + 4096); TRRD(h2, b_ + 5120); TRRD(l3, b_ + 6144); TRRD(h3, b_ + 7168); \
        asm volatile("s_waitcnt lgkmcnt(0)" ::: "memory"); SBAR();   \
        o[d0] = __builtin_amdgcn_mfma_f32_32x32x16_bf16(pa0, (bf16x8){l0[0], l0[1], l0[2], l0[3], h0[0], h0[1], h0[2], h0[3]}, o[d0], 0, 0, 0);   \
        o[d0] = __builtin_amdgcn_mfma_f32_32x32x16_bf16(pa1, (bf16x8){l1[0], l1[1], l1[2], l1[3], h1[0], h1[1], h1[2], h1[3]}, o[d0], 0, 0, 0);   \
        o[d0] = __builtin_amdgcn_mfma_f32_32x32x16_bf16(pa2, (bf16x8){l2[0], l2[1], l2[2], l2[3], h2[0], h2[1], h2[2], h2[3]}, o[d0], 0, 0, 0);   \
        o[d0] = __builtin_amdgcn_mfma_f32_32x32x16_bf16(pa3, (bf16x8){l3[0], l3[1], l3[2], l3[3], h3[0], h3[1], h3[2], h3[3]}, o[d0], 0, 0, 0); } while (0)
    PV_D0(0); PV_D0(1);
#undef PV_D0
#undef TRRD
}
struct BlockRef { const bf16_t* Q; const bf16_t* KN; const bf16_t* KPE; const bf16_t* V; bf16_t* O; int P0; };
struct Seam { bf16x8 qr[6]; bf16x8 st_v[2], st_kn[2], st_kp[2]; };
#define VMW() asm volatile("s_waitcnt vmcnt(0)" ::: "memory")
#define VMWN(n) asm volatile("s_waitcnt vmcnt(%0)" :: "i"(n) : "memory")
#define VMW_KEEP1() asm volatile("s_waitcnt vmcnt(3)" ::: "memory")
#define SLOAD(ref, k0, X) do { S.st_v[X] = load8((ref).V + (size_t)((k0) + vr) * LDV + vc8); S.st_kn[X] = load8((ref).KN + (size_t)((k0) + vr) * LDKN + vc8); \
                            S.st_kp[X] = load8((ref).KPE + (size_t)((k0) + pr) * LDKP + pc8); } while (0)
#define SWRITE_K(bf, X) do { *(bf16x8*)(K_lds + (bf) * SHM_K + kws) = S.st_kn[X]; *(bf16x8*)(K_lds + (bf) * SHM_K + kpws) = S.st_kp[X]; } while (0)
#define SWRITE_V(bf, X) do { *(bf16x8*)(V_lds + (bf) * SHM_V + vst) = S.st_v[X]; } while (0)
__device__ __forceinline__ void attn_prime(const BlockRef& cur, char* lds, Seam& S, const int wid) {
    const int lane = lane_id_v(), tid = wid * 64 + lane, r32 = lane & 31, hi = lane >> 5;
    const int vr = tid >> 3, vc8 = (tid & 7) * 8, pr = (tid >> 2) & 63, pc8 = (tid & 3) * 8;
    const int kws = KSWZ(vr, vc8 * 2), kpws = KSWZ(pr, (64 + pc8) * 2); char* K_lds = lds + 2 * SHM_V;
#pragma unroll
    for (int d0 = 0; d0 < 6; ++d0) S.qr[d0] = load8(cur.Q + (size_t)(wid * QBLK + r32) * LDQ + d0 * 16 + hi * 8);
    SLOAD(cur, 0, 0); VMW(); SWRITE_K(0, 0);
    __syncthreads();
}
__device__ __forceinline__ void attn_block(const BlockRef& cur, const BlockRef& nxt, char* lds, Seam& S, const int wid) {
    const int lane = lane_id_v(), tid = wid * 64 + lane, r32 = lane & 31, hi = lane >> 5;
    const int NT = (cur.P0 + QB - 1) / KVBLK + 1;
    const int qlo = cur.P0 + wid * QBLK, qm = qlo + r32 - 4 * hi;
    char* V_lds = lds; char* K_lds = lds + 2 * SHM_V;
    float* ws = (float*)(lds + 2 * SHM_V + 2 * SHM_K) + wid * 64; float* li_l = ws, * al_l = ws + 32;
    float m_reg = -1e30f, l_reg = 0; f32x16 o[2] = {};
    const int vr = tid >> 3, vc8 = (tid & 7) * 8, pr = (tid >> 2) & 63, pc8 = (tid & 3) * 8;
    const int vst = v_st(vr, vc8), kws = KSWZ(vr, vc8 * 2), kpws = KSWZ(pr, (64 + pc8) * 2);
    const int vb0 = (int)(uintptr_t)V_lds + v_rd_base(lane);
#define RESC(a) do { if (__any((a) < 1.f)) { if (hi == 0) al_l[r32] = (a); asm volatile("s_waitcnt lgkmcnt(0)" ::: "memory");              \
                     _Pragma("unroll") for (int d_ = 0; d_ < 2; ++d_) _Pragma("unroll") for (int r = 0; r < 16; ++r) o[d_][r] *= al_l[crow(r, hi)]; } } while (0)
#define KBASE(t) ((t) * KVBLK)
#define MASKT(P0_, P1_, t) do { const int kb_ = KBASE(t); if ((t) == 0) mask_meta(P0_, P1_); else if (kb_ + KVBLK - 1 > qlo) mask_tile(P0_, P1_, qm - kb_); } while (0)
    constexpr int NQL = 6;
#define SEAM_K0() do { VMWN(NQL); SWRITE_K(0, 0); SBAR(); } while (0)
    f32x16 pA0, pA1, pB0, pB1; float mnA, mnB, alA, alB; bf16x8 pa0, pa1, pa2, pa3;
    SWRITE_V(0, 0); SBAR();
    SLOAD(cur, KBASE(1), 1); SBAR(); SLOAD(cur, KBASE(2), 0);
    SBAR(); qkt<0>(pA0, pA1, K_lds, r32, hi, S.qr);
    MASKT(pA0, pA1, 0); partialSM(pA0, pA1, m_reg, mnA, alA);
    VMW_KEEP1(); SWRITE_V(1, 1); SWRITE_K(1, 1);
    __syncthreads();
#define HALF_STEP(PX0, PX1, mnX, alX, PY0, PY1, alY, t, KB, VB, SB, XS, XL, LOADS, WRITES) do {                                              \
        SBAR(); qkt<KB>(PX0, PX1, K_lds, r32, hi, S.qr);                                                           \
        finishSM(PY0, PY1, alY, l_reg, pa0, pa1, pa2, pa3); SBAR();                                                           \
        if (LOADS) { SLOAD(cur, KBASE((t) + 2), XL); SBAR(); }                                               \
        pv_tile<VB>(o, vb0, pa0, pa1, pa2, pa3); MASKT(PX0, PX1, (t)); partialSM(PX0, PX1, m_reg, mnX, alX);                  \
        __syncthreads();                                                                                                      \
        if (WRITES) { if (LOADS) VMW_KEEP1(); else VMW(); SWRITE_V(SB, XS); SWRITE_K(SB, XS); }                                                                          \
        RESC(alX); __syncthreads(); } while (0)
    int t = 1;
    for (; t + 3 < NT; t += 2) {
        HALF_STEP(pB0, pB1, mnB, alB, pA0, pA1, alA, t, 1, 0, 0, 0, 1, true, true);
        HALF_STEP(pA0, pA1, mnA, alA, pB0, pB1, alB, t + 1, 0, 1, 1, 1, 0, true, true);
    }
    HALF_STEP(pB0, pB1, mnB, alB, pA0, pA1, alA, t, 1, 0, 0, 0, 1, false, true);
    HALF_STEP(pA0, pA1, mnA, alA, pB0, pB1, alB, t + 1, 0, 1, 1, 1, 0, false, false);
    SLOAD(nxt, 0, 0); SBAR();
#pragma unroll
    for (int d0 = 0; d0 < 6; ++d0) S.qr[d0] = load8(nxt.Q + (size_t)(wid * QBLK + r32) * LDQ + d0 * 16 + hi * 8);
    SBAR();
    finishSM(pA0, pA1, alA, l_reg, pa0, pa1, pa2, pa3); SBAR();
    pv_tile<0>(o, vb0, pa0, pa1, pa2, pa3);
    SBAR(); SEAM_K0();
    if (hi == 0) li_l[r32] = l_reg; asm volatile("s_waitcnt lgkmcnt(0)" ::: "memory");
    float rli[16];
#pragma unroll
    for (int r = 0; r < 16; ++r) rli[r] = __builtin_amdgcn_rcpf(li_l[crow(r, hi)]);
    bf16_t* Ow = cur.O + (size_t)(wid * QBLK) * LDO;
#pragma unroll
    for (int r = 0; r < 16; ++r) { const int orow = crow(r, hi);
#pragma unroll
        for (int d0 = 0; d0 < 2; ++d0) { const float v = o[d0][r] * rli[r];
            const float vn = __shfl_xor(v, 1);
            if ((r32 & 1) == 0) *(unsigned*)(Ow + (size_t)orow * LDO + d0 * 32 + r32) = cvtpk(v, vn); } }
    __syncthreads();
#undef RESC
#undef KBASE
#undef MASKT
#undef SEAM_K0
#undef HALF_STEP
}
#undef VMW_KEEP1
#undef VMW
#undef VMWN
#undef SLOAD
#undef SWRITE_K
#undef SWRITE_V
#undef KSWZ
#undef SBAR
}

constexpr int NWAVES = 8;
constexpr int N_PHASES = 13;
constexpr size_t MiB = 1u << 20;
constexpr size_t WS_CTL = 0, CTL_ZERO_BYTES = 64 * 1024;
constexpr size_t WS_WRP  = 1 * MiB;
constexpr size_t WS_WUQ  = 2 * MiB;
constexpr size_t WS_WUKV = 3 * MiB;
constexpr size_t WS_WG   = 4 * MiB;
constexpr size_t WS_WAO  = 5 * MiB;
constexpr size_t WS_WRO  = 6 * MiB;
constexpr size_t WS_WOUT = 8 * MiB;
constexpr size_t WS_WIN  = 10 * MiB;
constexpr size_t WS_WUP  = 20 * MiB;
constexpr size_t WS_WDN  = 148 * MiB;
constexpr size_t WS_ACT  = 212 * MiB;
constexpr size_t WS_GATE = 212 * MiB;
constexpr size_t WS_GRG  = 341 * MiB;
constexpr size_t WS_XN   = 406 * MiB;
constexpr size_t WS_XC   = WS_XN, WS_MA = WS_XN;
constexpr size_t WS_YE   = 484 * MiB;
constexpr size_t WS_PQ   = 484 * MiB;
constexpr size_t WS_Y    = 484 * MiB;
constexpr size_t WS_PRX  = 533 * MiB;
constexpr size_t WS_R16  = 598 * MiB;
constexpr size_t WS_MG   = 598 * MiB;
constexpr size_t WS_U16  = 663 * MiB;
constexpr size_t WS_CQ   = 728 * MiB;
constexpr size_t WS_H2   = 756 * MiB;
constexpr size_t WS_HB   = 884 * MiB;
constexpr size_t WS_Q    = 756 * MiB;
constexpr size_t WS_KN   = 804 * MiB;
constexpr size_t WS_V    = 837 * MiB;
constexpr size_t WS_O    = 870 * MiB;
constexpr size_t WS_CKV  = 902 * MiB;
constexpr size_t WS_KPE  = 919 * MiB;
constexpr size_t WS_ROPE = 922 * MiB;
constexpr size_t WS_AGF  = 924 * MiB;
constexpr size_t WS_AGC  = 932 * MiB;
constexpr size_t WS_ELIST = 948 * MiB;
constexpr size_t WS_RSTDS = 952 * MiB;
constexpr size_t WS_GATES = 956 * MiB;
constexpr size_t WS_TOKSL = 960 * MiB;
constexpr size_t WS_END   = 1024 * MiB;
constexpr int CW_BAR = 1024;
constexpr int CW_CNT = 8192;
constexpr int RING_BYTES = 131072;
constexpr int LDSCTL_OFF = RING_BYTES, MISC_OFF = LDSCTL_OFF + 64;
constexpr int LDS_BYTES = 151552;
constexpr int LT_TS = 64;
constexpr int LT_LCNT = 160, LT_LBASE = 192;

#define XB_TMO      128
#define XB_XCNT(j)  (256  + 64 * (j))
#define XB_XSUB(j)  (1280 + 64 * (j))
#define XB_XGEN(j)  (2304 + 64 * (j))
#define XB_TOP      3328
#define XB_TOPGEN   3392
#define XCD_BAR_WORDS 3456
#define XB_SPIN_CAP (1u << 18)
__device__ __forceinline__ unsigned xb_ld(unsigned* p)              { return __hip_atomic_load(p, __ATOMIC_RELAXED, __HIP_MEMORY_SCOPE_AGENT); }
__device__ __forceinline__ unsigned xb_add(unsigned* p, unsigned v) { return __hip_atomic_fetch_add(p, v, __ATOMIC_RELAXED, __HIP_MEMORY_SCOPE_AGENT); }
__device__ __forceinline__ unsigned xb_xcc_id() { return (unsigned)__builtin_amdgcn_s_getreg((3 << 11) | 20) & 0xFu; }
#define XB_SPIN(cond, bar) do { unsigned _sp = 0; while (cond) { __builtin_amdgcn_s_sleep(1); \
    if ((++_sp & 255u) == 0u) { if (xb_ld(&(bar)[XB_TMO])) break; if (_sp > XB_SPIN_CAP) { atomicAdd(&(bar)[XB_TMO], 1u); break; } } } } while (0)
struct XcdBarrier { unsigned* bar; unsigned x; volatile LAS unsigned* st; int wid; };
__device__ __forceinline__ XcdBarrier xcd_barrier_post(unsigned* bar, volatile LAS unsigned* st, const int wid) {
    XcdBarrier b; b.bar = bar; b.x = xb_xcc_id(); b.st = st; b.wid = wid;
    if (wid == 0 && lane_id_v() == 0) (void)xb_add(&bar[XB_XCNT(b.x)], 1u);
    return b;
}
__device__ __forceinline__ void xcd_barrier_complete(unsigned* bar, unsigned x, unsigned& nloc, unsigned& nx) {
    const unsigned G = gridDim.x * gridDim.y * gridDim.z;
    unsigned sum, cnt, mine, sp = 0u;
    for (;;) {
        sum = 0u; cnt = 0u; mine = 0u;
#pragma unroll
        for (unsigned j = 0; j < 16; ++j) { const unsigned c = xb_ld(&bar[XB_XCNT(j)]); sum += c; cnt += (c > 0u) ? 1u : 0u; mine = (j == x) ? c : mine; }
        if (sum == G) break;
        __builtin_amdgcn_s_sleep(1);
        if ((++sp & 255u) == 0u) { if (xb_ld(&bar[XB_TMO])) break; if (sp > XB_SPIN_CAP) { atomicAdd(&bar[XB_TMO], 1u); break; } }
    }
    nloc = mine > 0u ? mine : 1u; nx = cnt > 0u ? cnt : 1u;
}
__device__ __forceinline__ void xcd_barrier(const XcdBarrier& b) {
    asm volatile("s_waitcnt vmcnt(0)" ::: "memory");
    __syncthreads();
    if (b.wid == 0 && lane_id_v() == 0) {
        unsigned* bar = b.bar;
        __builtin_amdgcn_s_waitcnt(0);
        unsigned nloc = b.st[0], nx = b.st[1];
        if (nloc == 0u) { xcd_barrier_complete(bar, b.x, nloc, nx); b.st[0] = nloc; b.st[1] = nx; }
        const unsigned old = xb_add(&bar[XB_XSUB(b.x)], 1u);
        const unsigned gen = old / nloc;
        if (old + 1u == (gen + 1u) * nloc) {
            __builtin_amdgcn_fence(__ATOMIC_RELEASE, "agent");
            asm volatile("s_waitcnt vmcnt(0)" ::: "memory");
            const unsigned og = xb_add(&bar[XB_TOP], 1u);
            const unsigned tg = og / nx;
            if (og + 1u == (tg + 1u) * nx) xb_add(&bar[XB_TOPGEN], 1u);
            else XB_SPIN(xb_ld(&bar[XB_TOPGEN]) == tg, bar);
            __builtin_amdgcn_fence(__ATOMIC_ACQUIRE, "agent");
            xb_add(&bar[XB_XGEN(b.x)], 1u);
            asm volatile("s_waitcnt vmcnt(0)" ::: "memory");
        } else {
            XB_SPIN(xb_ld(&bar[XB_XGEN(b.x)]) == gen, bar);
            __builtin_amdgcn_fence(__ATOMIC_ACQUIRE, "agent");
            asm volatile("s_waitcnt vmcnt(0)" ::: "memory");
        }
    }
    __syncthreads();
}

struct Args {
    const float* in[27]; float* out; unsigned char* ws; double rope_inv[16]; int ph_lo, ph_hi;
};
enum { I_X = 0, I_META, I_NMG, I_WIN, I_BGATE, I_QNG, I_WUQ, I_KVNG, I_WUKV, I_WAO, I_CONVW, I_CONVB, I_WRGA, I_BRGA, I_WRGX, I_BRGX, I_LAMBDA, I_WRO, I_WOUT, I_NFG, I_WROUTER, I_BROUTER, I_WUP, I_BUP, I_WDOWN, I_BDOWN, I_NFINAL };

struct TMap { const float* W; int ldw; bf16_t* WT; int ldt; int nblk; int mode; const float* ks; };
__device__ __forceinline__ int tmap_col(int mode, int np) {
    if (mode == 0) return np;
    if (mode == 1) return np < 672 ? np : (np < 768 ? -1 : np - 96);
    if (mode == 2) { const int h = np / 96, o = np - 96 * h; if (o < 64) return np; const int p = o - 64; return 96 * h + 64 + (p & 1) * 16 + (p >> 1); }
    const int pn = np >> 8, w = np & 255; return w < 128 ? 128 * pn + w : 1024 + 128 * pn + (w - 128);
}
__device__ __forceinline__ void transpose_item(const TMap& mp, LAS float* scr, int item, int lane) {
    const int kb = item / mp.nblk, nb = item % mp.nblk, k0 = 64 * kb, n0 = 32 * nb;
    const int sc = tmap_col(mp.mode, n0 + (lane & 31));
#pragma unroll 8
    for (int i = 0; i < 32; ++i) { const int kk = 2 * i + (lane >> 5);
        float v = sc >= 0 ? mp.W[(size_t)(k0 + kk) * mp.ldw + sc] : 0.f;
        if (mp.ks) v *= mp.ks[k0 + kk];
        scr[kk * 33 + (lane & 31)] = v; }
    asm volatile("s_waitcnt lgkmcnt(0)" ::: "memory");
    const int c = lane & 7;
#pragma unroll
    for (int j = 0; j < 4; ++j) { const int n = (lane >> 3) + 8 * j; const LAS float* s = scr + (8 * c) * 33 + n;
        u32x4 o; o.x = cvt_pk_bf16(s[0 * 33], s[1 * 33]); o.y = cvt_pk_bf16(s[2 * 33], s[3 * 33]); o.z = cvt_pk_bf16(s[4 * 33], s[5 * 33]); o.w = cvt_pk_bf16(s[6 * 33], s[7 * 33]);
        *(u32x4*)(mp.WT + (size_t)(n0 + n) * mp.ldt + k0 + 8 * c) = o; }
    asm volatile("s_waitcnt lgkmcnt(0)" ::: "memory");
}
__device__ __forceinline__ void transpose_item2(const TMap& mp, LAS unsigned* scr, int item, int lane) {
    const int nblk = mp.nblk >> 2;
    const int kb = item / nblk, nb = item % nblk, k0 = 32 * kb, n0 = 128 * nb;
    const int nl = 4 * (lane & 31), hw = lane >> 5;
    const int sc = tmap_col(mp.mode, n0 + nl);
#pragma unroll
    for (int i = 0; i < 8; ++i) { const int k = k0 + 4 * i + 2 * hw;
        f32x4 a = {0.f, 0.f, 0.f, 0.f}, b = {0.f, 0.f, 0.f, 0.f};
        if (sc >= 0) { a = __builtin_nontemporal_load((const f32x4*)(mp.W + (size_t)k * mp.ldw + sc)); b = __builtin_nontemporal_load((const f32x4*)(mp.W + (size_t)(k + 1) * mp.ldw + sc)); }
        if (mp.ks) { a *= mp.ks[k]; b *= mp.ks[k + 1]; }
        const int kp = 2 * i + hw;
        scr[(nl + 0) * 17 + kp] = cvt_pk_bf16(a.x, b.x); scr[(nl + 1) * 17 + kp] = cvt_pk_bf16(a.y, b.y);
        scr[(nl + 2) * 17 + kp] = cvt_pk_bf16(a.z, b.z); scr[(nl + 3) * 17 + kp] = cvt_pk_bf16(a.w, b.w); }
    asm volatile("s_waitcnt lgkmcnt(0)" ::: "memory");
    const int c = lane & 3;
#pragma unroll
    for (int j = 0; j < 8; ++j) { const int n = (lane >> 2) + 16 * j; const LAS unsigned* sp = scr + n * 17 + 4 * c;
        u32x4 o; o.x = sp[0]; o.y = sp[1]; o.z = sp[2]; o.w = sp[3];
        *(u32x4*)(mp.WT + (size_t)(n0 + n) * mp.ldt + k0 + 8 * c) = o; }
    asm volatile("s_waitcnt lgkmcnt(0)" ::: "memory");
}
__device__ __forceinline__ void transpose_item8(const TMap& mp, LAS unsigned* scr, int item, int lane) {
    const int nblk = mp.nblk >> 2;
    const int kb = item / nblk, nb = item % nblk, k0 = 64 * kb, n0 = 128 * nb;
    const int nl = 4 * (lane & 31), hw = lane >> 5;
    const int sc = tmap_col(mp.mode, n0 + nl);
#pragma unroll
    for (int i = 0; i < 8; ++i) { const int k = k0 + 8 * i + 4 * hw;
        f32x4 r[4];
#pragma unroll
        for (int q = 0; q < 4; ++q) { r[q] = *(const f32x4*)(mp.W + (size_t)(k + q) * mp.ldw + sc); r[q] *= (mp.ks ? mp.ks[k + q] : 1.f) * W8_SCALE; }
        const int kq = 2 * i + hw;
#pragma unroll
        for (int j = 0; j < 4; ++j) scr[(nl + j) * 17 + kq] = pack_fp8x4(r[0][j], r[1][j], r[2][j], r[3][j]); }
    asm volatile("s_waitcnt lgkmcnt(0)" ::: "memory");
    const int c = lane & 3;
    unsigned char* WT8 = (unsigned char*)mp.WT;
#pragma unroll
    for (int j = 0; j < 8; ++j) { const int n = (lane >> 2) + 16 * j; const LAS unsigned* sp = scr + n * 17 + 4 * c;
        u32x4 o; o.x = sp[0]; o.y = sp[1]; o.z = sp[2]; o.w = sp[3];
        *(u32x4*)(WT8 + (size_t)(n0 + n) * mp.ldt + k0 + 16 * c) = o; }
    asm volatile("s_waitcnt lgkmcnt(0)" ::: "memory");
}
__device__ __forceinline__ void xpose8_block(const float* W, int ldw, int mode, int n0, int k0, unsigned char* dst  , LAS unsigned char* lds, int wave, int lane) {
    LAS unsigned* tile = (LAS unsigned*)lds;
    int sc[4];
#pragma unroll
    for (int j = 0; j < 4; ++j) sc[j] = tmap_col(mode, n0 + 256 * j + 4 * lane);
    const unsigned xo = (unsigned)(lane & 15) << 1;
    f32x4 XA[4][4], XB[4][4];
#define X8_LOAD(X_, qd) do { _Pragma("unroll") for (int r = 0; r < 4; ++r) _Pragma("unroll") for (int j = 0; j < 4; ++j) \
        X_[r][j] = __builtin_nontemporal_load((const f32x4*)(W + (size_t)(k0 + 64 * ((qd) >> 1) + 8 * wave + 4 * ((qd) & 1) + r) * ldw + sc[j])); } while (0)
#define X8_CVT(X_, qd) do { const unsigned kd = (unsigned)(16 * ((qd) >> 1) + 2 * wave + ((qd) & 1)); _Pragma("unroll") for (int j = 0; j < 4; ++j) _Pragma("unroll") for (int c = 0; c < 4; ++c) \
        tile[(256 * j + 4 * lane + c) * 32 + (kd ^ xo)] = pack_fp8x4(X_[0][j][c] * W8_SCALE, X_[1][j][c] * W8_SCALE, X_[2][j][c] * W8_SCALE, X_[3][j][c] * W8_SCALE); } while (0)
    X8_LOAD(XA, 0); X8_LOAD(XB, 1); __builtin_amdgcn_sched_barrier(0);
    X8_CVT(XA, 0); __builtin_amdgcn_sched_barrier(0); X8_LOAD(XA, 2); __builtin_amdgcn_sched_barrier(0);
    X8_CVT(XB, 1); __builtin_amdgcn_sched_barrier(0); X8_LOAD(XB, 3); __builtin_amdgcn_sched_barrier(0);
    X8_CVT(XA, 2); __builtin_amdgcn_sched_barrier(0); X8_CVT(XB, 3);
#undef X8_LOAD
#undef X8_CVT
    __syncthreads();
    const int t = wave * 64 + lane;
#pragma unroll 4
    for (int i = 0; i < 16; ++i) { const int id = t + 512 * i, row = id >> 3, q = id & 7; const unsigned xr = (unsigned)((row >> 2) & 15) << 1;
        const u32x2 a = *(const LAS u32x2*)(tile + row * 32 + ((4u * q) ^ xr)), b = *(const LAS u32x2*)(tile + row * 32 + ((4u * q + 2u) ^ xr));
        u32x4 o; o.x = a.x; o.y = a.y; o.z = b.x; o.w = b.y;
        *(u32x4*)(dst + (size_t)row * 1024 + 16 * q) = o; }
    __syncthreads();
}
__device__ __forceinline__ void rms_row_to_bf16(const float* xrow, const float* gain, bf16_t* orow, int lane) {
    const f32x4* xr = (const f32x4*)xrow + lane; const f32x4* gr = (const f32x4*)gain + lane;
    f32x4 v[4]; float s = 0.f;
#pragma unroll
    for (int j = 0; j < 4; ++j) { v[j] = xr[64 * j]; s += (v[j].x * v[j].x + v[j].y * v[j].y) + (v[j].z * v[j].z + v[j].w * v[j].w); }
    const float rstd = 1.f / sqrtf(wave_sum(s) * (1.f / 1024.f) + EPS);
    u32x2* o8 = (u32x2*)orow + lane;
#pragma unroll
    for (int j = 0; j < 4; ++j) { const f32x4 g = gr[64 * j]; u32x2 w; w.x = cvt_pk_bf16(v[j].x * rstd * g.x, v[j].y * rstd * g.y); w.y = cvt_pk_bf16(v[j].z * rstd * g.z, v[j].w * rstd * g.w); o8[64 * j] = w; }
}

__device__ __forceinline__ void build_moe_table(volatile LAS int* tbl, const unsigned* gcnt, const int wid) {
    const int t_ = wid * 64 + lane_id_v();
    __syncthreads();
    if (t_ < 32) tbl[LT_TS + 40 + t_] = (int)__hip_atomic_load(gcnt + t_, __ATOMIC_RELAXED, __HIP_MEMORY_SCOPE_AGENT);
    __syncthreads();
    if (t_ == 0) { int acc = 0; for (int e = 0; e < 32; ++e) { tbl[LT_TS + e] = acc; acc += (tbl[LT_TS + 40 + e] + 255) >> 8; } tbl[LT_TS + 32] = acc; }
    __syncthreads();
}

__device__ __forceinline__ att::BlockRef att_mkref(int item, int pass, bf16_t* QB, bf16_t* KN, bf16_t* KPE, bf16_t* VB, bf16_t* OB) {
    const int bh = item >> 4, x = item & 15, qb = pass ? 31 - x : x, b = bh >> 3, h = bh & 7;
    att::BlockRef r; r.Q = QB + ((size_t)b * 8192 + (size_t)qb * 256) * 768 + h * 96; r.KN = KN + (size_t)b * TP * 512 + h * 64; r.KPE = KPE + (size_t)b * TP * 32;
    r.V = VB + (size_t)b * TP * 512 + h * 64; r.O = OB + ((size_t)b * 8192 + (size_t)qb * 256) * 512 + h * 64; r.P0 = MBLK + 256 * qb; return r;
}
__device__ __forceinline__ void lru_step8(const h16x8 r, const h16x8 u, const float (&kc)[8], float (&h)[8], float (&A)[8]) {
#pragma unroll
    for (int j = 0; j < 8; ++j) { const float a = __builtin_amdgcn_exp2f((float)r[j] * kc[j]); const float b = __builtin_amdgcn_sqrtf(fmaxf(1.f - a * a, 0.f)) * (float)u[j]; h[j] = a * h[j] + b; A[j] *= a; }
}
__device__ __forceinline__ void lru_kc8(const float* lam, int ch, float (&kc)[8]) {
    const f32x4 l0 = *(const f32x4*)(lam + ch), l1 = *(const f32x4*)(lam + ch + 4); const float l[8] = {l0.x, l0.y, l0.z, l0.w, l1.x, l1.y, l1.z, l1.w};
#pragma unroll
    for (int j = 0; j < 8; ++j) { const float x = -l[j]; const float sp = x > 15.f ? x : log1pf(expf(x)); kc[j] = -8.f * sp * 1.4426950408889634f; }
}
__global__ void __launch_bounds__(NWAVES * 64, 2) mk_fwd(Args args) {
    extern __shared__ __attribute__((aligned(16))) unsigned char lds_raw[];
    LAS unsigned char* lds = (LAS unsigned char*)lds_raw;
    volatile LAS unsigned* MISC = (volatile LAS unsigned*)(lds + MISC_OFF);
    volatile LAS int* TBL = (volatile LAS int*)(lds + MISC_OFF);
    const int wave = __builtin_amdgcn_readfirstlane((int)threadIdx.x >> 6);
    const int G = gridDim.x; const int bx = blockIdx.x; const int vcu = (G % 8 == 0) ? (bx % 8) * (G / 8) + bx / 8 : bx;
    unsigned char* ws = args.ws;
    unsigned* ctl = (unsigned*)(ws + WS_CTL);
    for (int u = (int)threadIdx.x; u < (LDS_BYTES - LDSCTL_OFF) / 4; u += NWAVES * 64) ((LAS unsigned*)(lds + LDSCTL_OFF))[u] = 0u;
    __syncthreads();
    XcdBarrier bar; bar.bar = ctl + CW_BAR; bar.x = 0; bar.st = nullptr; bar.wid = wave;
    if (MK_N_LAUNCHES == 1) bar = xcd_barrier_post(ctl + CW_BAR, MISC, wave);
    const int lo = args.ph_lo, hi = args.ph_hi;
#define IN(k) (lo <= (k) && (k) < hi)
#define SEAM(k) do { if (IN(k) && IN((k) + 1)) xcd_barrier(bar); } while (0)
    bf16_t* WIN = (bf16_t*)(ws + WS_WIN); bf16_t* WUQ = (bf16_t*)(ws + WS_WUQ); bf16_t* WUKV = (bf16_t*)(ws + WS_WUKV); bf16_t* WG = (bf16_t*)(ws + WS_WG);
    bf16_t* WAO = (bf16_t*)(ws + WS_WAO); bf16_t* WRO = (bf16_t*)(ws + WS_WRO); bf16_t* WOUT = (bf16_t*)(ws + WS_WOUT); unsigned char* WUP8 = ws + WS_WUP; unsigned char* WDN8 = ws + WS_WDN;
    float* WRP = (float*)(ws + WS_WRP);
    bf16_t* XN = (bf16_t*)(ws + WS_XN); bf16_t* XC = (bf16_t*)(ws + WS_XC); bf16_t* MA = (bf16_t*)(ws + WS_MA);
    bf16_t* PQ = (bf16_t*)(ws + WS_PQ); bf16_t* PRX = (bf16_t*)(ws + WS_PRX); bf16_t* GRG = (bf16_t*)(ws + WS_GRG); bf16_t* GATE = (bf16_t*)(ws + WS_GATE);
    bf16_t* CQ = (bf16_t*)(ws + WS_CQ); bf16_t* CKV = (bf16_t*)(ws + WS_CKV); bf16_t* KPE = (bf16_t*)(ws + WS_KPE);
    float* COS = (float*)(ws + WS_ROPE); float* SIN = COS + TPOS * 16;
    bf16_t* QB = (bf16_t*)(ws + WS_Q); bf16_t* KN = (bf16_t*)(ws + WS_KN); bf16_t* VB = (bf16_t*)(ws + WS_V); bf16_t* OB = (bf16_t*)(ws + WS_O);
    _Float16* R16 = (_Float16*)(ws + WS_R16); _Float16* U16 = (_Float16*)(ws + WS_U16);
    float* AGF = (float*)(ws + WS_AGF); float* AGC = (float*)(ws + WS_AGC);
    bf16_t* YB = (bf16_t*)(ws + WS_Y); bf16_t* MG = (bf16_t*)(ws + WS_MG);
    bf16_t* H2 = (bf16_t*)(ws + WS_H2); unsigned char* H8 = ws + WS_HB;
    int* ELIST = (int*)(ws + WS_ELIST); float* RSTDS = (float*)(ws + WS_RSTDS); float* GATES = (float*)(ws + WS_GATES); int* TOKSL = (int*)(ws + WS_TOKSL);
    unsigned char* ACT = ws + WS_ACT; unsigned char* YE = ws + WS_YE;
    unsigned* GCNT = ctl + CW_CNT;
    const int gw = vcu * NWAVES + wave, NGW = G * NWAVES;
    const int NGT = G * NWAVES * 64;
#define PHASE_IDS() const int lane = lane_id_v(); const int tid = wave * 64 + lane; const int gt = vcu * (NWAVES * 64) + tid; (void)gt; (void)tid; (void)lane

    auto convert_tile = [&](const int it) {
        const int lane = lane_id_v();
        {
            if (it < 512) { const int e = it >> 4, kb = (it >> 1) & 7, nb = it & 1;
                xpose8_block(args.in[I_WUP] + (size_t)e * 1024 * 2048, 2048, 3, 1024 * nb, 128 * kb, WUP8 + (size_t)e * 2048 * 1024 + (size_t)(1024 * nb) * 1024 + 128 * kb, lds, wave, lane); }
            else { const int q = it - 512, e = q >> 3, kb = q & 7;
                xpose8_block(args.in[I_WDOWN] + (size_t)e * 1024 * 1024, 1024, 0, 0, 128 * kb, WDN8 + (size_t)e * 1024 * 1024 + 128 * kb, lds, wave, lane); }
        }
    };
    if (IN(0)) for (int rep_ = 0; rep_ < REP_P0; ++rep_) {
        if (rep_) xcd_barrier(bar);
        PHASE_IDS();
        LAS float* scr = (LAS float*)(lds + wave * 16384);
        {
            constexpr int I_1 = 32 * 38, I_3 = 8 * 8, I_4 = 16 * 8, I_5 = 32 * 8, I_6 = 32 * 8;
            constexpr int NITEMS = I_1 + I_3 + I_4 + I_5 + I_6;
            for (int it = gw; it < NITEMS; it += NGW) {
                int r = it; TMap mp;
                if (r < I_1) { mp = TMap{args.in[I_WIN], 4768, WIN, 1024, 152, 1, nullptr}; }
                else if ((r -= I_1) < I_3) { mp = TMap{args.in[I_WUKV], 1024, WUKV, 256, 32, 0, nullptr}; }
                else if ((r -= I_3) < I_4) { mp = TMap{args.in[I_WAO], 1024, WAO, 512, 32, 0, nullptr}; }
                else if ((r -= I_4) < I_5) { mp = TMap{args.in[I_WRO], 1024, WRO, 1024, 32, 0, nullptr}; }
                else { r -= I_5; mp = TMap{args.in[I_WOUT], 1024, WOUT, 1024, 32, 0, nullptr}; }
                transpose_item2(mp, (LAS unsigned*)scr, r, lane);
            }
            { const TMap mq = TMap{args.in[I_WUQ], 768, WUQ, 384, 24, 2, nullptr};
              for (int it = gw; it < 6 * 24; it += NGW) transpose_item(mq, scr, it, lane); }
        }
        __syncthreads();
        for (int idx = gt; idx < 8 * 256 * 256; idx += NGT) { const int b = idx >> 16, np = (idx >> 8) & 255, kp = idx & 255;
            float v = 0.f; if ((kp >> 7) == (b & 1)) { const int i = kp & 127; v = np < 128 ? args.in[I_WRGA][(b * 128 + i) * 128 + np] : args.in[I_WRGX][(b * 128 + i) * 128 + (np - 128)]; }
            WG[idx] = (bf16_t)(cvt_pk_bf16(v, 0.f) & 0xffffu); }
        for (int idx = gt; idx < 32768; idx += NGT) { const int k = idx >> 5, e = idx & 31; const float w = args.in[I_NFG][k] * args.in[I_WROUTER][k * 32 + e];
            const unsigned hb = cvt_pk_bf16(w, 0.f) & 0xffffu; const float hf = __uint_as_float(hb << 16); const unsigned lb = cvt_pk_bf16(w - hf, 0.f) & 0xffffu;
            const int pos = ((((k >> 5) * 2 + (e >> 4)) * 2) * 64 + ((((k >> 3) & 3) << 4) | (e & 15))) * 8 + (k & 7);
            ((unsigned short*)WRP)[pos] = (unsigned short)hb; ((unsigned short*)WRP)[pos + 512] = (unsigned short)lb; }
        for (int idx = gt; idx < TPOS * 16; idx += NGT) { const int t = idx >> 4, i = idx & 15; const double ang = (double)t * args.rope_inv[i] * 0.15915494309189535; const float rev = (float)(ang - floor(ang));
            COS[idx] = __builtin_amdgcn_cosf(rev); SIN[idx] = __builtin_amdgcn_sinf(rev); }
        { const f32x4* gr = (const f32x4*)args.in[I_NMG] + lane; f32x4 gn4[4];
#pragma unroll
          for (int j = 0; j < 4; ++j) gn4[j] = gr[64 * j];
          for (int m4 = gw * 4; m4 < RROWS; m4 += NGW * 4) {
              const int i4 = (m4 - NX) & 63;
              if (m4 >= NX && i4 >= NMETA) { const u32x2 z = {0u, 0u};
#pragma unroll
                  for (int r = 0; r < 4; ++r) { u32x2* o8 = (u32x2*)(XN + (size_t)(m4 + r) * 1024) + lane;
#pragma unroll
                      for (int j = 0; j < 4; ++j) o8[64 * j] = z; }
                  continue; }
              const float* src = m4 < NX ? args.in[I_X] + (size_t)m4 * 1024 : args.in[I_META] + (size_t)i4 * 1024;
              f32x4 v[4][4]; float ss[4];
#pragma unroll
              for (int r = 0; r < 4; ++r) { const f32x4* xr = (const f32x4*)(src + (size_t)r * 1024) + lane;
#pragma unroll
                  for (int j = 0; j < 4; ++j) v[r][j] = __builtin_nontemporal_load(xr + 64 * j); }
#pragma unroll
              for (int r = 0; r < 4; ++r) { float a = 0.f;
#pragma unroll
                  for (int j = 0; j < 4; ++j) a += (v[r][j].x * v[r][j].x + v[r][j].y * v[r][j].y) + (v[r][j].z * v[r][j].z + v[r][j].w * v[r][j].w);
                  ss[r] = a; }
#pragma unroll
              for (int o = 1; o < 64; o <<= 1) {
#pragma unroll
                  for (int r = 0; r < 4; ++r) ss[r] += __shfl_xor(ss[r], o); }
#pragma unroll
              for (int r = 0; r < 4; ++r) { const float rstd = 1.f / sqrtf(ss[r] * (1.f / 1024.f) + EPS); u32x2* o8 = (u32x2*)(XN + (size_t)(m4 + r) * 1024) + lane;
#pragma unroll
                  for (int j = 0; j < 4; ++j) { const f32x4 g = gn4[j]; u32x2 w; w.x = cvt_pk_bf16(v[r][j].x * rstd * g.x, v[r][j].y * rstd * g.y); w.y = cvt_pk_bf16(v[r][j].z * rstd * g.z, v[r][j].w * rstd * g.w); o8[64 * j] = w; } }
          }
        }
    }
    SEAM(0);
    if (IN(1)) {
        g8::PPlain g{XN, WIN, 2048u, 2048u, 16}; g8::StaticOrder S; S.init(RROWS, NPROJ, G, bx);
        g8::EpiProj E{PQ, PRX, GRG, GATE, args.in[I_BGATE]};
        for (int rep_ = 0; rep_ < REP_P1; ++rep_) { if (rep_) xcd_barrier(bar); g8::gemm_phase(lds, wave, g, S, E); }
    }
    SEAM(1);
    if (IN(2)) for (int rep_ = 0; rep_ < REP_P2; ++rep_) {
        if (rep_) xcd_barrier(bar);
        PHASE_IDS();
        const float* gq = args.in[I_QNG]; const float* gkv = args.in[I_KVNG];
        {
            const int l16 = lane & 15, rsub = lane >> 4;
            f32x4 gqv[3][2], gkvv[2][2];
#pragma unroll
            for (int j = 0; j < 3; ++j) { gqv[j][0] = *(const f32x4*)(gq + 8 * (l16 + 16 * j)); gqv[j][1] = *(const f32x4*)(gq + 8 * (l16 + 16 * j) + 4); }
#pragma unroll
            for (int j = 0; j < 2; ++j) { gkvv[j][0] = *(const f32x4*)(gkv + 8 * (l16 + 16 * j)); gkvv[j][1] = *(const f32x4*)(gkv + 8 * (l16 + 16 * j) + 4); }
            for (int gi = gw; gi < RROWS / 4; gi += NGW) {
                const int m = 4 * gi + rsub; const bf16_t* prow = PQ + (size_t)m * 768;
                u32x4 wq[3], wk[2];
#pragma unroll
                for (int j = 0; j < 3; ++j) wq[j] = *(const u32x4*)(prow + 8 * (l16 + 16 * j));
#pragma unroll
                for (int j = 0; j < 2; ++j) wk[j] = *(const u32x4*)(prow + 384 + 8 * (l16 + 16 * j));
                const float x1 = __uint_as_float((unsigned)prow[640 + l16] << 16), x2 = __uint_as_float((unsigned)prow[656 + l16] << 16);
                const int t = pos_of(m);
                const float cs = COS[t * 16 + l16], sn = SIN[t * 16 + l16];
                float sq = 0.f, sk = 0.f;
#pragma unroll
                for (int j = 0; j < 3; ++j) { const u32x4 w = wq[j]; sq += bf_lo(w.x) * bf_lo(w.x) + bf_hi(w.x) * bf_hi(w.x) + bf_lo(w.y) * bf_lo(w.y) + bf_hi(w.y) * bf_hi(w.y) + bf_lo(w.z) * bf_lo(w.z) + bf_hi(w.z) * bf_hi(w.z) + bf_lo(w.w) * bf_lo(w.w) + bf_hi(w.w) * bf_hi(w.w); }
#pragma unroll
                for (int j = 0; j < 2; ++j) { const u32x4 w = wk[j]; sk += bf_lo(w.x) * bf_lo(w.x) + bf_hi(w.x) * bf_hi(w.x) + bf_lo(w.y) * bf_lo(w.y) + bf_hi(w.y) * bf_hi(w.y) + bf_lo(w.z) * bf_lo(w.z) + bf_hi(w.z) * bf_hi(w.z) + bf_lo(w.w) * bf_lo(w.w) + bf_hi(w.w) * bf_hi(w.w); }
#pragma unroll
                for (int o = 1; o < 16; o <<= 1) { sq += __shfl_xor(sq, o); sk += __shfl_xor(sk, o); }
                const float rq = 1.f / sqrtf(sq * (1.f / 384.f) + EPS), rk = 1.f / sqrtf(sk * (1.f / 256.f) + EPS);
                if (m < NX) {
#pragma unroll
                    for (int j = 0; j < 3; ++j) { const u32x4 w = wq[j]; const f32x4 g0 = gqv[j][0], g1 = gqv[j][1]; u32x4 o;
                        o.x = cvt_pk_bf16(bf_lo(w.x) * rq * g0.x, bf_hi(w.x) * rq * g0.y); o.y = cvt_pk_bf16(bf_lo(w.y) * rq * g0.z, bf_hi(w.y) * rq * g0.w);
                        o.z = cvt_pk_bf16(bf_lo(w.z) * rq * g1.x, bf_hi(w.z) * rq * g1.y); o.w = cvt_pk_bf16(bf_lo(w.w) * rq * g1.z, bf_hi(w.w) * rq * g1.w);
                        *(u32x4*)(CQ + (size_t)m * 384 + 8 * (l16 + 16 * j)) = o; } }
#pragma unroll
                for (int j = 0; j < 2; ++j) { const u32x4 w = wk[j]; const f32x4 g0 = gkvv[j][0], g1 = gkvv[j][1]; u32x4 o;
                    o.x = cvt_pk_bf16(bf_lo(w.x) * rk * g0.x, bf_hi(w.x) * rk * g0.y); o.y = cvt_pk_bf16(bf_lo(w.y) * rk * g0.z, bf_hi(w.y) * rk * g0.w);
                    o.z = cvt_pk_bf16(bf_lo(w.z) * rk * g1.x, bf_hi(w.z) * rk * g1.y); o.w = cvt_pk_bf16(bf_lo(w.w) * rk * g1.z, bf_hi(w.w) * rk * g1.w);
                    *(u32x4*)(CKV + (size_t)m * 256 + 8 * (l16 + 16 * j)) = o; }
                *(unsigned*)(KPE + (size_t)kvrow_of(m) * 32 + 2 * l16) = cvt_pk_bf16(x1 * cs - x2 * sn, x1 * sn + x2 * cs);
            }
        }
        { const int rg = tid >> 7, ch = (tid & 127) * 8;
          float cw[4][8], cb[8];
#pragma unroll
          for (int k = 0; k < 4; ++k) { const f32x4 a = *(const f32x4*)(args.in[I_CONVW] + k * 1024 + ch), b = *(const f32x4*)(args.in[I_CONVW] + k * 1024 + ch + 4);
              cw[k][0] = a.x; cw[k][1] = a.y; cw[k][2] = a.z; cw[k][3] = a.w; cw[k][4] = b.x; cw[k][5] = b.y; cw[k][6] = b.z; cw[k][7] = b.w; }
          { const f32x4 a = *(const f32x4*)(args.in[I_CONVB] + ch), b = *(const f32x4*)(args.in[I_CONVB] + ch + 4); cb[0] = a.x; cb[1] = a.y; cb[2] = a.z; cb[3] = a.w; cb[4] = b.x; cb[5] = b.y; cb[6] = b.z; cb[7] = b.w; }
          for (int it = vcu; it < BATCH * 129; it += G) {
              const int b = it / 129, c = it % 129;
              if (c == 0 && rg > 0) continue;
              const int q0 = c == 0 ? 0 : NMETA + 64 * (c - 1) + 16 * rg;
              float w0[8], w1[8], w2[8];
#pragma unroll
              for (int j = 0; j < 8; ++j) { w0[j] = 0.f; w1[j] = 0.f; w2[j] = 0.f; }
#define SEQROW(q) ((q) < NMETA ? NX + 64 * b + (q) : b * 8192 + (q) - NMETA)
#define LDROW(dst, q) do { const u32x4 w_ = *(const u32x4*)(PRX + (size_t)SEQROW(q) * 1024 + ch); dst[0] = bf_lo(w_.x); dst[1] = bf_hi(w_.x); dst[2] = bf_lo(w_.y); dst[3] = bf_hi(w_.y); dst[4] = bf_lo(w_.z); dst[5] = bf_hi(w_.z); dst[6] = bf_lo(w_.w); dst[7] = bf_hi(w_.w); } while (0)
              if (q0 >= 3) { LDROW(w0, q0 - 3); LDROW(w1, q0 - 2); LDROW(w2, q0 - 1); }
              for (int i = 0; i < 16; ++i) { const int q = q0 + i; float cur[8]; LDROW(cur, q);
                  float o[8];
#pragma unroll
                  for (int j = 0; j < 8; ++j) o[j] = cb[j] + cw[0][j] * w0[j] + cw[1][j] * w1[j] + cw[2][j] * w2[j] + cw[3][j] * cur[j];
                  u32x4 ow; ow.x = cvt_pk_bf16(o[0], o[1]); ow.y = cvt_pk_bf16(o[2], o[3]); ow.z = cvt_pk_bf16(o[4], o[5]); ow.w = cvt_pk_bf16(o[6], o[7]);
                  *(u32x4*)(XC + (size_t)SEQROW(q) * 1024 + ch) = ow;
#pragma unroll
                  for (int j = 0; j < 8; ++j) { w0[j] = w1[j]; w1[j] = w2[j]; w2[j] = cur[j]; } }
#undef LDROW
          }
          for (int idx = gt; idx < BATCH * 48 * 128; idx += NGT) { const int b = idx / (48 * 128), r = (idx / 128) % 48, c8 = (idx & 127) * 8; u32x4 z = {0u, 0u, 0u, 0u}; *(u32x4*)(XC + (size_t)(NX + 64 * b + 16 + r) * 1024 + c8) = z; }
        }
    }
    SEAM(2);
    if (IN(3)) for (int rep_ = 0; rep_ < REP_P3; ++rep_) {
        if (rep_) xcd_barrier(bar);
        { g8::PPlain g{CQ, WUQ, 768u, 768u, 6}; g8::StaticOrder S; S.init(NX, 768, G, bx); g8::EpiQ E{QB, COS, SIN}; g8::gemm_phase(lds, wave, g, S, E); }
        { g8::PPlain g{CKV, WUKV, 512u, 512u, 4}; g8::StaticOrder S; S.init(RROWS, 1024, G, (bx + 128) % G); g8::EpiKV E{KN, VB}; g8::gemm_phase(lds, wave, g, S, E); }
        { g8::PGates g{XC, WG, 2048u, 512u, 4}; g8::StaticOrder S; S.init(RROWS, 2048, G, (bx + 136) % G); g8::EpiGates E{XC, args.in[I_BRGA], args.in[I_BRGX], R16, U16}; g8::gemm_phase(lds, wave, g, S, E); }
    }
    SEAM(3);
    if (IN(4)) for (int rep_ = 0; rep_ < REP_P4; ++rep_) {
        if (rep_) xcd_barrier(bar);
        PHASE_IDS();
        const int slot = tid >> 7, t7 = tid & 127, ch = t7 * 8;
        float kc[8]; lru_kc8(args.in[I_LAMBDA], ch, kc);
        LAS float* red = (LAS float*)lds;
        for (int it = vcu; it < BATCH * 64; it += G) {
            const int b = it >> 6, sc = it & 63, c = 4 * sc + slot;
            float h[8], A[8];
#pragma unroll
            for (int j = 0; j < 8; ++j) { h[j] = 0.f; A[j] = 1.f; }
            if (c == 0) {
#pragma unroll 4
                for (int i = 0; i < NMETA; ++i) { const size_t o = (size_t)(NX + 64 * b + i) * 1024 + ch; lru_step8(*(const h16x8*)(R16 + o), *(const h16x8*)(U16 + o), kc, h, A); } }
#pragma unroll 4
            for (int i = 0; i < 32; ++i) { const size_t o = (size_t)(b * 8192 + 32 * c + i) * 1024 + ch; lru_step8(*(const h16x8*)(R16 + o), *(const h16x8*)(U16 + o), kc, h, A); }
            float* fa = AGF + ((size_t)(b * 256 + c) * 2) * 1024 + ch;
            *(f32x4*)fa = (f32x4){A[0], A[1], A[2], A[3]}; *(f32x4*)(fa + 4) = (f32x4){A[4], A[5], A[6], A[7]};
            *(f32x4*)(fa + 1024) = (f32x4){h[0], h[1], h[2], h[3]}; *(f32x4*)(fa + 1028) = (f32x4){h[4], h[5], h[6], h[7]};
#pragma unroll
            for (int j = 0; j < 8; ++j) { red[(slot * 16 + j) * 128 + t7] = A[j]; red[(slot * 16 + 8 + j) * 128 + t7] = h[j]; }
            __syncthreads();
            if (slot == 0) { float At[8], Ht[8];
#pragma unroll
                for (int j = 0; j < 8; ++j) { At[j] = 1.f; Ht[j] = 0.f; }
#pragma unroll
                for (int q = 0; q < 4; ++q)
#pragma unroll
                    for (int j = 0; j < 8; ++j) { const float a = red[(q * 16 + j) * 128 + t7], hh = red[(q * 16 + 8 + j) * 128 + t7]; Ht[j] = a * Ht[j] + hh; At[j] *= a; }
                float* ca = AGC + ((size_t)(b * 64 + sc) * 2) * 1024 + ch;
                *(f32x4*)ca = (f32x4){At[0], At[1], At[2], At[3]}; *(f32x4*)(ca + 4) = (f32x4){At[4], At[5], At[6], At[7]};
                *(f32x4*)(ca + 1024) = (f32x4){Ht[0], Ht[1], Ht[2], Ht[3]}; *(f32x4*)(ca + 1028) = (f32x4){Ht[4], Ht[5], Ht[6], Ht[7]}; }
            __syncthreads();
        }
    }
    if (IN(4) && IN(5)) xcd_barrier(bar);
    if (IN(5)) {
        PHASE_IDS();
        {
            const int slot = tid >> 7, t7 = tid & 127, ch = t7 * 8;
            float kc[8]; lru_kc8(args.in[I_LAMBDA], ch, kc);
            for (int it = vcu; it < BATCH * 64; it += G) {
                const int b = it >> 6, sc = it & 63, c = 4 * sc + slot;
                float h[8], A[8];
#pragma unroll
                for (int j = 0; j < 8; ++j) { h[j] = 0.f; A[j] = 1.f; }
                { float Ac[8], Hc[8];
#pragma unroll
                  for (int j = 0; j < 8; ++j) { Ac[j] = 1.f; Hc[j] = 0.f; }
                  const int q1 = sc < 16 * slot + 16 ? sc : 16 * slot + 16;
#pragma unroll 4
                  for (int q = 16 * slot; q < q1; ++q) { const float* ca = AGC + ((size_t)(b * 64 + q) * 2) * 1024 + ch;
                      const f32x4 a0 = *(const f32x4*)ca, a1 = *(const f32x4*)(ca + 4), h0 = *(const f32x4*)(ca + 1024), h1 = *(const f32x4*)(ca + 1028);
                      const float av[8] = {a0.x, a0.y, a0.z, a0.w, a1.x, a1.y, a1.z, a1.w}, hv[8] = {h0.x, h0.y, h0.z, h0.w, h1.x, h1.y, h1.z, h1.w};
#pragma unroll
                      for (int j = 0; j < 8; ++j) { Hc[j] = av[j] * Hc[j] + hv[j]; Ac[j] *= av[j]; } }
                  LAS float* red = (LAS float*)lds;
                  __syncthreads();
#pragma unroll
                  for (int j = 0; j < 8; ++j) { red[(slot * 16 + j) * 128 + t7] = Ac[j]; red[(slot * 16 + 8 + j) * 128 + t7] = Hc[j]; }
                  __syncthreads();
#pragma unroll
                  for (int q = 0; q < 4; ++q)
#pragma unroll
                      for (int j = 0; j < 8; ++j) h[j] = red[(q * 16 + j) * 128 + t7] * h[j] + red[(q * 16 + 8 + j) * 128 + t7]; }
                for (int q = 0; q < slot; ++q) { const float* fa = AGF + ((size_t)(b * 256 + 4 * sc + q) * 2) * 1024 + ch;
                    const f32x4 a0 = *(const f32x4*)fa, a1 = *(const f32x4*)(fa + 4), h0 = *(const f32x4*)(fa + 1024), h1 = *(const f32x4*)(fa + 1028);
                    h[0] = a0.x * h[0] + h0.x; h[1] = a0.y * h[1] + h0.y; h[2] = a0.z * h[2] + h0.z; h[3] = a0.w * h[3] + h0.w;
                    h[4] = a1.x * h[4] + h1.x; h[5] = a1.y * h[5] + h1.y; h[6] = a1.z * h[6] + h1.z; h[7] = a1.w * h[7] + h1.w; }
                if (c == 0) {
#pragma unroll 4
                    for (int i = 0; i < NMETA; ++i) { const size_t o = (size_t)(NX + 64 * b + i) * 1024 + ch; lru_step8(*(const h16x8*)(R16 + o), *(const h16x8*)(U16 + o), kc, h, A); } }
#pragma unroll 4
                for (int i = 0; i < 32; ++i) { const size_t o = (size_t)(b * 8192 + 32 * c + i) * 1024 + ch;
                    lru_step8(__builtin_nontemporal_load((const h16x8*)(R16 + o)), __builtin_nontemporal_load((const h16x8*)(U16 + o)), kc, h, A);
                    const u32x4 gq = __builtin_nontemporal_load((const u32x4*)(GRG + o));
                    u32x4 yw; yw.x = cvt_pk_bf16(h[0] * bf_lo(gq.x), h[1] * bf_hi(gq.x)); yw.y = cvt_pk_bf16(h[2] * bf_lo(gq.y), h[3] * bf_hi(gq.y));
                    yw.z = cvt_pk_bf16(h[4] * bf_lo(gq.z), h[5] * bf_hi(gq.z)); yw.w = cvt_pk_bf16(h[6] * bf_lo(gq.w), h[7] * bf_hi(gq.w));
                    *(u32x4*)(YB + o) = yw; }
            }
        }
    }
    if (IN(5)) __syncthreads();
    int ctile = vcu;
    if (IN(5)) for (int rep_ = 0; rep_ < REP_P5; ++rep_) {
        if (rep_) xcd_barrier(bar);
        att::Seam S;
        const int nitems = BATCH * 8 * 16;
        int it = vcu;
        if (it < nitems) {
#define mkref(item_, pass_) att_mkref((item_), (pass_), QB, KN, KPE, VB, OB)
            int pass = 0; att::BlockRef cur = mkref(it, 0);
            att::attn_prime(cur, (char*)lds_raw, S, wave);
            for (;;) {
                const bool more_pass = pass == 0, more_item = it + G < nitems, last = !more_pass && !more_item;
                int itn = it, passn = 1; if (!more_pass) { passn = 0; itn = more_item ? it + G : it; }
                const att::BlockRef nxt = last ? cur : mkref(itn, passn);
                att::attn_block(cur, nxt, (char*)lds_raw, S, wave);
                if (last) break;
                cur = nxt; it = itn; pass = passn;
                if (ctile < 768 && pass == 1) { __syncthreads(); convert_tile(ctile); ctile += G; if (ctile < 768 && it == vcu) { __syncthreads(); convert_tile(ctile); ctile += G; } __syncthreads(); att::attn_prime(cur, (char*)lds_raw, S, wave); }
            }
        }
    }
#undef mkref
    if (IN(5)) { __syncthreads(); for (; ctile < 768; ctile += G) convert_tile(ctile); }
    SEAM(5);
    if (IN(6)) for (int rep_ = 0; rep_ < REP_P6; ++rep_) {
        if (rep_) xcd_barrier(bar);
        { g8::PPlain g{OB, WAO, 1024u, 1024u, 8}; g8::StaticOrder S; S.init(NX, 1024, G, bx); g8::EpiAo E{GATE, MA}; g8::gemm_phase(lds, wave, g, S, E); }
    }
    if (IN(6) && IN(7)) { asm volatile("s_waitcnt vmcnt(0)" ::: "memory"); __syncthreads(); }
    if (IN(7)) for (int rep_ = 0; rep_ < REP_P7; ++rep_) {
        if (rep_) xcd_barrier(bar);
        g8::PPlain g{YB, WRO, 2048u, 2048u, 16}; g8::StaticOrder S; S.init(NX, 1024, G, bx); g8::EpiRo E{GATE, MA, MG}; g8::gemm_phase(lds, wave, g, S, E);
    }
    SEAM(7);
    if (IN(8)) for (int rep_ = 0; rep_ < REP_P8; ++rep_) {
        if (rep_) xcd_barrier(bar);
        g8::PPlain g{MG, WOUT, 2048u, 2048u, 16}; g8::StaticOrder S; S.init(NX, 1024, G, bx); g8::EpiOut E{args.in[I_X], H2, H8, args.in[I_NFG]}; g8::gemm_phase(lds, wave, g, S, E);
    }
    SEAM(8);
    if (IN(9)) {
        PHASE_IDS();
        const int j16 = lane & 15, kq = lane >> 4;
        const int ngroups = NX / 16, per_round = G * NWAVES, nrounds = (ngroups + per_round - 1) / per_round;
        volatile LAS int* lcnt = TBL + LT_LCNT; volatile LAS int* lbase = TBL + LT_LBASE;
        for (int rd = 0; rd < nrounds; ++rd) {
            if (tid < 32) lcnt[tid] = 0;
            __syncthreads();
            const int gi = rd * per_round + vcu * NWAVES + wave; const bool active = gi < ngroups;
            int tok = 0; float rstd = 0.f; float tv[4] = {0.f, 0.f, 0.f, 0.f}; int ti[4] = {0, 0, 0, 0}; int sl[4] = {0, 0, 0, 0};
            if (active) {
                tok = gi * 16 + j16;
                const bf16_t* hrow = H2 + (size_t)tok * 1024 + kq * 8;
                const bf16_t* wh = (const bf16_t*)WRP + lane * 8;
                f32x4 acc0 = {0.f, 0.f, 0.f, 0.f}, acc1 = {0.f, 0.f, 0.f, 0.f}; float ss = 0.f;
#pragma unroll 4
                for (int c = 0; c < 32; ++c) {
                    const bf16x8 hv = *(const bf16x8*)(hrow + c * 32);
                    const bf16x8 a0h = *(const bf16x8*)(wh + c * 2048), a0l = *(const bf16x8*)(wh + c * 2048 + 512), a1h = *(const bf16x8*)(wh + c * 2048 + 1024), a1l = *(const bf16x8*)(wh + c * 2048 + 1536);
                    { const u32x4 hw_ = __builtin_bit_cast(u32x4, hv);
#pragma unroll
                      for (int q = 0; q < 4; ++q) { const float x0 = bf_lo(hw_[q]), x1 = bf_hi(hw_[q]); ss += x0 * x0; ss += x1 * x1; } }
                    acc0 = __builtin_amdgcn_mfma_f32_16x16x32_bf16(a0h, hv, acc0, 0, 0, 0); acc1 = __builtin_amdgcn_mfma_f32_16x16x32_bf16(a1h, hv, acc1, 0, 0, 0);
                    acc0 = __builtin_amdgcn_mfma_f32_16x16x32_bf16(a0l, hv, acc0, 0, 0, 0); acc1 = __builtin_amdgcn_mfma_f32_16x16x32_bf16(a1l, hv, acc1, 0, 0, 0);
                }
                ss += __shfl_xor(ss, 16); ss += __shfl_xor(ss, 32);
                rstd = 1.f / sqrtf(ss * (1.f / 1024.f) + EPS);
                float cv[8]; int ci[8];
                const f32x4 b0 = *(const f32x4*)(args.in[I_BROUTER] + 4 * kq), b1 = *(const f32x4*)(args.in[I_BROUTER] + 16 + 4 * kq);
#pragma unroll
                for (int r = 0; r < 4; ++r) { cv[r] = acc0[r] * rstd + b0[r]; ci[r] = 4 * kq + r; cv[4 + r] = acc1[r] * rstd + b1[r]; ci[4 + r] = 16 + 4 * kq + r; }
                const float NEG = -__builtin_inff();
#define TOP4_OF8() do { _Pragma("unroll") for (int s_ = 0; s_ < 4; ++s_) { float bv_ = cv[0]; int bi_ = ci[0]; \
                    _Pragma("unroll") for (int c_ = 1; c_ < 8; ++c_) { const bool bt_ = cv[c_] > bv_ || (cv[c_] == bv_ && ci[c_] < bi_); bv_ = bt_ ? cv[c_] : bv_; bi_ = bt_ ? ci[c_] : bi_; } \
                    tv[s_] = bv_; ti[s_] = bi_; _Pragma("unroll") for (int c_ = 0; c_ < 8; ++c_) if (ci[c_] == bi_) cv[c_] = NEG; } } while (0)
                TOP4_OF8();
#pragma unroll
                for (int step = 16; step <= 32; step <<= 1) {
#pragma unroll
                    for (int s = 0; s < 4; ++s) { cv[s] = tv[s]; ci[s] = ti[s]; cv[4 + s] = __shfl_xor(tv[s], step); ci[4 + s] = __shfl_xor(ti[s], step); }
                    TOP4_OF8();
                }
#undef TOP4_OF8
                { const float mx = tv[0]; float e[4], sum = 0.f;
#pragma unroll
                  for (int s = 0; s < 4; ++s) { e[s] = __builtin_amdgcn_exp2f((tv[s] - mx) * 1.4426950408889634f); sum += e[s]; }
                  const float inv = 1.f / sum;
#pragma unroll
                  for (int s = 0; s < 4; ++s) tv[s] = e[s] * inv; }
                if (kq == 0) {
#pragma unroll
                    for (int s = 0; s < 4; ++s) sl[s] = __hip_atomic_fetch_add((LAS int*)(lcnt + ti[s]), 1, __ATOMIC_RELAXED, __HIP_MEMORY_SCOPE_WORKGROUP);
                }
            }
            __syncthreads();
            if (tid < 32) lbase[tid] = (int)__hip_atomic_fetch_add(GCNT + tid, (unsigned)lcnt[tid], __ATOMIC_RELAXED, __HIP_MEMORY_SCOPE_AGENT);
            __syncthreads();
            if (active && kq == 0) {
#pragma unroll
                for (int s = 0; s < 4; ++s) { const int e = ti[s], pos = lbase[e] + sl[s];
                    ELIST[e * ECAP + pos] = tok; RSTDS[e * ECAP + pos] = rstd; GATES[e * ECAP + pos] = tv[s]; TOKSL[tok * 4 + s] = (e << 20) | pos; }
            }
            __syncthreads();
        }
    }
    SEAM(9);
    if (IN(10)) {
        build_moe_table(TBL, GCNT, wave);
        g8::PUp g{H8, WUP8, ELIST, 1024u, 1024u, 8, 124, RSTDS, args.in[I_BUP]};   g8::MoeOrder S{TBL + LT_TS, 8, G, vcu}; g8::EpiUp E{ACT}; for (int rep_ = 0; rep_ < REP_P10; ++rep_) { if (rep_) xcd_barrier(bar); g8::gemm_phase(lds, wave, g, S, E); }
    }
    SEAM(10);
    if (IN(11)) {
        build_moe_table(TBL, GCNT, wave);
        g8::PDown g{ACT, WDN8, 1024u, 1024u, 8, 123, GATES, args.in[I_BDOWN]};   g8::MoeOrder S{TBL + LT_TS, 4, G, vcu}; g8::EpiDown E{YE}; for (int rep_ = 0; rep_ < REP_P11; ++rep_) { if (rep_) xcd_barrier(bar); g8::gemm_phase(lds, wave, g, S, E); }
    }
    SEAM(11);
    if (IN(12)) for (int rep_ = 0; rep_ < REP_P12; ++rep_) {
        if (rep_) xcd_barrier(bar);
        build_moe_table(TBL, GCNT, wave);
        const int lane = lane_id_v();
        const float* gf = args.in[I_NFINAL];
        unsigned poison = 0u;
        if (MK_N_LAUNCHES == 1) poison = xb_ld(&bar.bar[XB_TMO]);
        f32x4 gfin[4];
#pragma unroll
        for (int j = 0; j < 4; ++j) gfin[j] = ((const f32x4*)gf)[64 * j + lane];
        for (int gi = gw; gi < NX / 16; gi += NGW) {
            const int m0 = gi * 16;
            const int tsw = TOKSL[m0 * 4 + lane];
            const int yrow = TBL[LT_TS + (tsw >> 20)] * 256 + (tsw & 0xfffff);
#pragma unroll 1
            for (int r = 0; r < 16; r += 2) {
                f32x4 v[2][4]; unsigned w[2][4][4];
#pragma unroll
                for (int q = 0; q < 2; ++q) { const u32x2* hr = (const u32x2*)(H2 + (size_t)(m0 + r + q) * 1024) + lane;
#pragma unroll
                    for (int j = 0; j < 4; ++j) { const u32x2 hw_ = hr[64 * j]; v[q][j] = (f32x4){bf_lo(hw_.x), bf_hi(hw_.x), bf_lo(hw_.y), bf_hi(hw_.y)}; }
#pragma unroll
                    for (int k = 0; k < 4; ++k) { const int yr_ = __shfl(yrow, 4 * (r + q) + k); const unsigned* yr = (const unsigned*)(YE + (size_t)yr_ * 1024) + lane;
#pragma unroll
                        for (int j = 0; j < 4; ++j) w[q][k][j] = yr[64 * j]; } }
#pragma unroll
                for (int q = 0; q < 2; ++q) {
#pragma unroll
                    for (int k = 0; k < 4; ++k)
#pragma unroll
                        for (int j = 0; j < 4; ++j) { const f32x2 lo = __builtin_amdgcn_cvt_pk_f32_fp8((int)w[q][k][j], false), hi = __builtin_amdgcn_cvt_pk_f32_fp8((int)w[q][k][j], true);
                            v[q][j] += (f32x4){lo.x, lo.y, hi.x, hi.y} * (1.f / Y8_SCALE); }
                    float s = 0.f;
#pragma unroll
                    for (int j = 0; j < 4; ++j) s += (v[q][j].x * v[q][j].x + v[q][j].y * v[q][j].y) + (v[q][j].z * v[q][j].z + v[q][j].w * v[q][j].w);
                    float rstd = 1.f / sqrtf(wave_sum(s) * (1.f / 1024.f) + EPS);
                    if (poison) rstd = __builtin_nanf("");
                    f32x4* orow = (f32x4*)(args.out + (size_t)(m0 + r + q) * 1024) + lane;
#pragma unroll
                    for (int j = 0; j < 4; ++j) orow[64 * j] = v[q][j] * rstd * gfin[j];
                }
            }
        }
    }
#undef IN
#undef SEAM
#undef SEQROW
}

extern "C" void kernel_launch(void* const* d_in, const int* in_sizes, int n_in, void* d_out, int out_size, void* d_ws, size_t ws_size, hipStream_t stream) {
    static int grid = 0;
    if (grid == 0) {
        if (n_in != 27 || in_sizes[0] != NX * DM || out_size != NX * DM || ws_size < WS_END) { fprintf(stderr, "kernel_launch: unexpected shapes (n_in %d, in0 %d, out %d, ws %zu)\n", n_in, n_in > 0 ? in_sizes[0] : -1, out_size, ws_size); grid = -1; return; }
        int dev = 0, cus = 0, per_cu = 0;
        if (hipGetDevice(&dev) != hipSuccess || hipDeviceGetAttribute(&cus, hipDeviceAttributeMultiprocessorCount, dev) != hipSuccess) { grid = -1; return; }
        if (hipFuncSetAttribute((const void*)mk_fwd, hipFuncAttributeMaxDynamicSharedMemorySize, LDS_BYTES) != hipSuccess) { fprintf(stderr, "kernel_launch: hipFuncSetAttribute failed\n"); grid = -1; return; }
        if (hipOccupancyMaxActiveBlocksPerMultiprocessor(&per_cu, (const void*)mk_fwd, NWAVES * 64, LDS_BYTES) != hipSuccess || per_cu < 1) fprintf(stderr, "kernel_launch: occupancy query reports %d\n", per_cu);
        (void)hipGetLastError();
        grid = cus;
    }
    if (grid < 0) return;
    if (hipMemsetAsync((char*)d_ws + WS_CTL, 0, CTL_ZERO_BYTES, stream) != hipSuccess) { fprintf(stderr, "kernel_launch: memset failed\n"); return; }
    Args a{};
    for (int i = 0; i < 27; ++i) a.in[i] = (const float*)d_in[i];
    a.out = (float*)d_out; a.ws = (unsigned char*)d_ws;
    for (int i = 0; i < 16; ++i) a.rope_inv[i] = pow(10000.0, -(double)(2 * i) / 32.0);
    if (MK_N_LAUNCHES == 1) { a.ph_lo = 0; a.ph_hi = N_PHASES; hipLaunchKernelGGL(mk_fwd, dim3(grid), dim3(NWAVES * 64), LDS_BYTES, stream, a); }
    else for (int p = 0; p < N_PHASES; ++p) { a.ph_lo = p; a.ph_hi = p + 1; hipLaunchKernelGGL(mk_fwd, dim3(grid), dim3(NWAVES * 64), LDS_BYTES, stream, a); }
    const hipError_t le = hipPeekAtLastError();
    if (le != hipSuccess) fprintf(stderr, "kernel_launch: launch failed: %s\n", hipGetErrorName(le));
}
```

```cpp
#include <hip/hip_runtime.h>
#include <hip/hip_bf16.h>
#include <cstdio>
#include <cstdint>
#include <cmath>

#ifndef REP_P0
#define REP_P0 1
#endif
#ifndef REP_P1
#define REP_P1 1
#endif
#ifndef REP_P5
#define REP_P5 1
#endif
#ifndef REP_P10
#define REP_P10 1
#endif
#ifndef REP_P11
#define REP_P11 1
#endif
#ifndef REP_P2
#define REP_P2 1
#endif
#ifndef REP_P3
#define REP_P3 1
#endif
#ifndef REP_P4
#define REP_P4 1
#endif
#ifndef REP_P6
#define REP_P6 1
#endif
#ifndef REP_P7
#define REP_P7 1
#endif
#ifndef REP_P8
#define REP_P8 1
#endif
#ifndef REP_P12
#define REP_P12 1
#endif
#ifndef MK_N_LAUNCHES
#define MK_N_LAUNCHES 1
#endif

#define LAS __attribute__((address_space(3)))
#define GAS __attribute__((address_space(1)))
typedef unsigned short bf16_t;
typedef short bf16x8 __attribute__((ext_vector_type(8)));
typedef short s16x4 __attribute__((ext_vector_type(4)));
typedef float f32x2 __attribute__((ext_vector_type(2)));
typedef float f32x4 __attribute__((ext_vector_type(4)));
typedef float f32x16 __attribute__((ext_vector_type(16)));
typedef unsigned u32x2 __attribute__((ext_vector_type(2)));
typedef unsigned u32x4 __attribute__((ext_vector_type(4)));
typedef int i32x4 __attribute__((ext_vector_type(4)));
typedef int i32x8 __attribute__((ext_vector_type(8)));
typedef _Float16 h16x2 __attribute__((ext_vector_type(2)));
typedef _Float16 h16x8 __attribute__((ext_vector_type(8)));

constexpr int BATCH = 4, SEQ = 8192, DM = 1024, NX = BATCH * SEQ;
constexpr int NMETA = 16, MBLK = 64;
constexpr int RROWS = NX + BATCH * MBLK;
constexpr int TP = MBLK + SEQ;
constexpr int TPOS = NMETA + SEQ;
constexpr int NPROJ = 4864;
constexpr int NEXP = 32, ECAP = 32768;
constexpr int PROWS = 544 * 256;
constexpr float EPS = 1e-6f;

__device__ __forceinline__ float bf_lo(unsigned w) { return __uint_as_float(w << 16); }
__device__ __forceinline__ float bf_hi(unsigned w) { return __uint_as_float(w & 0xffff0000u); }
typedef __bf16 bf16x2_t __attribute__((ext_vector_type(2)));
__device__ __forceinline__ unsigned cvt_pk_bf16(float lo, float hi) { f32x2 v = {lo, hi}; bf16x2_t b = __builtin_convertvector(v, bf16x2_t); return __builtin_bit_cast(unsigned, b); }
__device__ __forceinline__ unsigned pack_fp8x4(float a, float b, float c, float d) {
    a = fminf(fmaxf(a, -448.f), 448.f); b = fminf(fmaxf(b, -448.f), 448.f); c = fminf(fmaxf(c, -448.f), 448.f); d = fminf(fmaxf(d, -448.f), 448.f);
    int w = 0; w = __builtin_amdgcn_cvt_pk_fp8_f32(a, b, w, false); w = __builtin_amdgcn_cvt_pk_fp8_f32(c, d, w, true); return (unsigned)w;
}
__device__ __forceinline__ unsigned pack_fp8x4_nc(float a, float b, float c, float d) {
    int w = 0; w = __builtin_amdgcn_cvt_pk_fp8_f32(a, b, w, false); w = __builtin_amdgcn_cvt_pk_fp8_f32(c, d, w, true); return (unsigned)w;
}
constexpr float W8_SCALE = 64.f;
constexpr float A8_SCALE = 4.f;
constexpr float Y8_SCALE = 16.f;
__device__ __forceinline__ float sigm(float x) { return __builtin_amdgcn_rcpf(1.f + __builtin_amdgcn_exp2f(-1.4426950408889634f * x)); }
__device__ __forceinline__ float gelu_tanh(float v) { const float z = v + 0.044715f * v * v * v; return v * __builtin_amdgcn_rcpf(1.f + __builtin_amdgcn_exp2f(-2.3022082f * z)); }
__device__ __forceinline__ int kvrow_of(int m) { return m < NX ? (m >> 13) * TP + MBLK + (m & 8191) : ((m - NX) >> 6) * TP + ((m - NX) & 63); }
__device__ __forceinline__ int pos_of(int m) { return m < NX ? NMETA + (m & 8191) : ((m - NX) & 63); }
__device__ __forceinline__ int lane_id_v() { int l; asm volatile("v_mbcnt_lo_u32_b32 %0, -1, 0\n\tv_mbcnt_hi_u32_b32 %0, -1, %0" : "=v"(l)); return l; }
__device__ __forceinline__ float wave_sum(float v) {
#pragma unroll
    for (int o = 1; o < 64; o <<= 1) v += __shfl_xor(v, o);
    return v;
}

__device__ __forceinline__ void glds16_s(const void* sbase, unsigned voff, unsigned lds_dst) {
    unsigned keep;
    asm volatile("s_mov_b32 %0, m0\n\ts_mov_b32 m0, %3\n\ts_nop 0\n\tglobal_load_lds_dwordx4 %1, %2\n\ts_mov_b32 m0, %0" : "=&s"(keep) : "v"(voff), "s"(sbase), "s"(lds_dst) : "memory");
}
__device__ __forceinline__ void glds4_s(const void* sbase, unsigned voff, unsigned lds_dst) {
    unsigned keep;
    asm volatile("s_mov_b32 %0, m0\n\ts_mov_b32 m0, %3\n\ts_nop 0\n\tglobal_load_lds_dword %1, %2\n\ts_mov_b32 m0, %0" : "=&s"(keep) : "v"(voff), "s"(sbase), "s"(lds_dst) : "memory");
}
namespace g8 {
constexpr int BM = 256, BK = 64, HALF = 128, HTB = HALF * BK * 2, STAGE_BYTES = 8 * HTB, NXCD = 8, WGM = 8;
__host__ __device__ __forceinline__ int lds_byte(int r, int c) { const int st = (r >> 4) * 2 + (c >> 5), rr = r & 15, cc = c & 31, ob = rr * 64 + cc * 2; return st * 1024 + (ob ^ (((ob >> 9) & 1) << 5)); }
__host__ __device__ __forceinline__ void stage_rc(int b, int& R, int& C) { const int st = b / 1024, sb = b % 1024, swz = sb ^ (((sb >> 9) & 1) << 5); R = (st >> 1) * 16 + swz / 64; C = (st & 1) * 32 + (swz % 64) / 2; }
__host__ __device__ __forceinline__ int perm32(int rho) { const int n = rho >> 4, i = rho & 15; return 8 * (i >> 2) + 4 * n + (i & 3); }

struct Unit { int pm, pn, e, mt, rem; };

struct StaticOrder {
    int nM, nN, nwg, G, c;
    __device__ void init(int M, int N, int G_, int c_) { nM = M / BM; nN = N / BM; nwg = nM * nN; G = G_; c = c_; }
    __device__ bool next(int i, Unit& u) const {
        const long L = (long)i * G + c; if (L >= nwg) return false;
        int wgid = (int)L; { const int q = nwg / NXCD, r = nwg % NXCD, xcd = wgid % NXCD, off = wgid / NXCD; wgid = (xcd < r ? xcd * (q + 1) : r * (q + 1) + (xcd - r) * q) + off; }
        const int nig = WGM * nN, gid = wgid / nig, fm = gid * WGM, gsz = (nM - fm) < WGM ? (nM - fm) : WGM;
        u.pm = fm + ((wgid % nig) % gsz); u.pn = (wgid % nig) / gsz; u.e = 0; u.mt = 0; u.rem = 256; return true;
    }
};
struct MoeOrder {
    const volatile LAS int* ts; int npn, G, vcu;
    __device__ bool next(int i, Unit& u) const {
        const long L = (long)i * G + vcu; const int g = (int)(L / npn), pn = (int)(L % npn);
        const int el = lane_id_v() & 31;
        const volatile LAS int* tl = ts + el;
        const int lo = tl[0], hi = tl[1], cn = tl[40];
        if (g >= __builtin_amdgcn_readlane(hi, 31)) return false;
        const unsigned long long mk = __ballot(lo <= g && g < hi);
        const int e = mk ? (int)__builtin_ctzll(mk) : 0;
        u.pm = g; u.pn = pn; u.e = e; u.mt = g - __builtin_amdgcn_readlane(lo, e); u.rem = __builtin_amdgcn_readlane(cn, e) - u.mt * 256; return true;
    }
};

struct PPlain { static constexpr bool GATHER = false, FP8 = false, SIDE = false; const bf16_t* A; const bf16_t* Bt; unsigned lda2, ldb2; int nt;
    __device__ __forceinline__ const char* a_tile(const Unit& u) const { return (const char*)A + (size_t)u.pm * 256 * lda2; }
    __device__ __forceinline__ const char* b_tile(const Unit& u) const { return (const char*)Bt + (size_t)u.pn * 256 * ldb2; }
    __device__ __forceinline__ const int* a_row_ptr(const Unit&, int) const { return nullptr; } };
struct PGates { static constexpr bool GATHER = false, FP8 = false, SIDE = false; const bf16_t* A; const bf16_t* Bt; unsigned lda2, ldb2; int nt;
    __device__ __forceinline__ const char* a_tile(const Unit& u) const { return (const char*)A + (size_t)u.pm * 256 * lda2 + (size_t)(u.pn >> 1) * 512; }
    __device__ __forceinline__ const char* b_tile(const Unit& u) const { return (const char*)Bt + (size_t)u.pn * 256 * ldb2; }
    __device__ __forceinline__ const int* a_row_ptr(const Unit&, int) const { return nullptr; } };
struct PUp { static constexpr bool GATHER = true, FP8 = true, SIDE = true; const unsigned char* A; const unsigned char* Bt; const int* elist; unsigned lda2, ldb2; int nt; int s2; const float* rowv; const float* bias;
    __device__ __forceinline__ const char* a_tile(const Unit&) const { return (const char*)A; }
    __device__ __forceinline__ const char* b_tile(const Unit& u) const { return (const char*)Bt + ((size_t)u.e * 2048 + (size_t)u.pn * 256) * ldb2; }
    __device__ __forceinline__ const int* a_row_ptr(const Unit& u, int r) const { const int rc = r < u.rem ? r : u.rem - 1; return elist + u.e * ECAP + u.mt * 256 + rc; }
    __device__ __forceinline__ void side_dma(const Unit& u, unsigned lds_slot, int wid, int lane) const {
        if (wid < 4) { const int r = 64 * wid + lane; glds4_s(rowv, (unsigned)(u.e * ECAP + u.mt * 256 + (r < u.rem ? r : u.rem - 1)) * 4u, lds_slot + wid * 256); }
        else { const int i = 64 * (wid - 4) + lane; glds4_s(bias, (unsigned)(u.e * 2048 + (i < 128 ? u.pn * 128 + i : 1024 + u.pn * 128 + (i - 128))) * 4u, lds_slot + wid * 256); } } };
struct PDown { static constexpr bool GATHER = false, FP8 = true, SIDE = true; const unsigned char* A; const unsigned char* Bt; unsigned lda2, ldb2; int nt; int s2; const float* rowv; const float* bias;
    __device__ __forceinline__ const char* a_tile(const Unit& u) const { return (const char*)A + (size_t)u.pm * 256 * lda2; }
    __device__ __forceinline__ const char* b_tile(const Unit& u) const { return (const char*)Bt + ((size_t)u.e * 1024 + (size_t)u.pn * 256) * ldb2; }
    __device__ __forceinline__ const int* a_row_ptr(const Unit&, int) const { return nullptr; }
    __device__ __forceinline__ void side_dma(const Unit& u, unsigned lds_slot, int wid, int lane) const {
        if (wid < 4) { const int r = 64 * wid + lane; glds4_s(rowv, (unsigned)(u.e * ECAP + u.mt * 256 + (r < u.rem ? r : u.rem - 1)) * 4u, lds_slot + wid * 256); }
        else { const int i = 64 * (wid - 4) + lane; glds4_s(bias, (unsigned)(u.e * 1024 + u.pn * 256 + i) * 4u, lds_slot + wid * 256); } } };

template <class P, class Epi, class Sched>
__device__ __forceinline__ void gemm_phase(LAS unsigned char* lds, const int wid, const P g, const Sched& S, const Epi& E) {
    const int lane = lane_id_v(), tid = wid * 64 + lane, wr = wid >> 2, wc = wid & 3;
    const int nt = g.nt;
    int fp8_s = 127; if constexpr (P::FP8) fp8_s = g.s2;
    (void)fp8_s;
    unsigned voffA0, voffB0, CA2; int RA0;
    { int R, C; stage_rc(tid * 16, R, C); const int Rb = (R & ~31) + perm32(R & 31);
      voffA0 = (unsigned)R * g.lda2 + (unsigned)C * 2u; voffB0 = (unsigned)Rb * g.ldb2 + (unsigned)C * 2u; RA0 = R; CA2 = (unsigned)C * 2u; }
    const size_t pstepA = (size_t)64 * g.lda2, pstepB = (size_t)64 * g.ldb2;
    LAS unsigned char* idlds = lds + STAGE_BYTES + 4096 + wid * 256;
    const size_t kstep = (size_t)(BK * 2);
    const size_t hstepA = (size_t)HALF * g.lda2, hstepB = (size_t)HALF * g.ldb2;
    const unsigned ldsw = (unsigned)wid * 1024u;
    const unsigned ldsbase = (unsigned)(uintptr_t)lds + ldsw;
    const int aoff = lds_byte(wr * 64 + (lane & 15), (lane >> 4) * 8), boff = lds_byte(wc * 32 + (lane & 15), (lane >> 4) * 8);
#define G8_SA(b, h) (((b) * 2 + (h)) * HTB)
#define G8_SB(b, h) ((4 + (b) * 2 + (h)) * HTB)
#define G8_STB(bufoff, gbase) do { _Pragma("unroll") for (int _i = 0; _i < 2; ++_i) { \
        if constexpr (P::FP8) glds16_s((const char*)(gbase) + (size_t)_i * pstepB, voffB0, ldsbase + (unsigned)((bufoff) + _i * 8192)); \
        else __builtin_amdgcn_global_load_lds((const unsigned*)((const char*)(gbase) + (size_t)_i * pstepB + voffB0), (LAS unsigned*)(lds + (bufoff) + ldsw + _i * 8192), 16, 0, 0); } } while (0)
#define G8_STA(bufoff, kp, h, GO) do { _Pragma("unroll") for (int _i = 0; _i < 2; ++_i) { \
        if constexpr (P::FP8) { if constexpr (P::GATHER) glds16_s((const char*)(kp), GO[h][_i] * g.lda2 + CA2, ldsbase + (unsigned)((bufoff) + _i * 8192)); \
                                else glds16_s((const char*)(kp) + (size_t)(h) * hstepA + (size_t)_i * pstepA, voffA0, ldsbase + (unsigned)((bufoff) + _i * 8192)); } \
        else { const char* _p = P::GATHER ? ((const char*)(kp) + (GO[h][_i] * g.lda2 + CA2)) : ((const char*)(kp) + (size_t)(h) * hstepA + (size_t)_i * pstepA + voffA0); \
        __builtin_amdgcn_global_load_lds((const unsigned*)_p, (LAS unsigned*)(lds + (bufoff) + ldsw + _i * 8192), 16, 0, 0); } } } while (0)
#define G8_LDA(dst, b, h) do { _Pragma("unroll") for (int m = 0; m < 4; ++m) _Pragma("unroll") for (int k = 0; k < 2; ++k) dst[m][k] = *(const LAS bf16x8*)(lds + G8_SA(b, h) + aoff + m * 2048 + k * 1024); } while (0)
#define G8_LDB(dst, b, h) do { _Pragma("unroll") for (int n = 0; n < 2; ++n) _Pragma("unroll") for (int k = 0; k < 2; ++k) dst[n][k] = *(const LAS bf16x8*)(lds + G8_SB(b, h) + boff + n * 2048 + k * 1024); } while (0)
#define G8_MMA(ai, bj, At, Bt) do { __builtin_amdgcn_s_setprio(1); \
        if constexpr (P::FP8) { _Pragma("unroll") for (int m = 0; m < 4; ++m) _Pragma("unroll") for (int n = 0; n < 2; ++n) { \
            const i32x8 a8_ = __builtin_shufflevector(__builtin_bit_cast(i32x4, At[m][0]), __builtin_bit_cast(i32x4, At[m][1]), 0, 1, 2, 3, 4, 5, 6, 7); \
            const i32x8 b8_ = __builtin_shufflevector(__builtin_bit_cast(i32x4, Bt[n][0]), __builtin_bit_cast(i32x4, Bt[n][1]), 0, 1, 2, 3, 4, 5, 6, 7); \
            acc[ai][bj][m][n] = __builtin_amdgcn_mfma_scale_f32_16x16x128_f8f6f4(b8_, a8_, acc[ai][bj][m][n], 0, 0, 0, fp8_s, 0, fp8_s); } } \
        else { _Pragma("unroll") for (int m = 0; m < 4; ++m) _Pragma("unroll") for (int n = 0; n < 2; ++n) _Pragma("unroll") for (int k = 0; k < 2; ++k) \
            acc[ai][bj][m][n] = __builtin_amdgcn_mfma_f32_16x16x32_bf16(Bt[n][k], At[m][k], acc[ai][bj][m][n], 0, 0, 0); } \
        __builtin_amdgcn_s_setprio(0); } while (0)
#define G8_WAIT_V(n) asm volatile("s_waitcnt vmcnt(" #n ")" ::: "memory")
#define G8_WAIT_L(n) asm volatile("s_waitcnt lgkmcnt(" #n ")" ::: "memory")
#define G8_BAR __builtin_amdgcn_s_barrier()
#define G8_SCHED __builtin_amdgcn_sched_barrier(0)
    Unit cur, nxt; int ui = 0;
    if (!S.next(0, cur)) return;
    f32x4 acc[2][2][4][2];
#pragma unroll
    for (int a = 0; a < 2; ++a)
#pragma unroll
        for (int b = 0; b < 2; ++b)
#pragma unroll
            for (int m = 0; m < 4; ++m)
#pragma unroll
                for (int n = 0; n < 2; ++n) acc[a][b][m][n] = (f32x4){0.f, 0.f, 0.f, 0.f};
    if constexpr (Epi::PRELOAD) { const int l0 = lane_id_v(); E.preload(acc, cur, wr, wc, l0 & 15, l0 >> 4); }
    bf16x8 At[4][2], B0[2][2], B1[2][2];
    unsigned gc[2][2];
#pragma unroll
    for (int h = 0; h < 2; ++h)
#pragma unroll
        for (int i = 0; i < 2; ++i) gc[h][i] = P::GATHER ? (unsigned)*g.a_row_ptr(cur, h * 128 + i * 64 + RA0) : 0u;
    const unsigned sidebase = (unsigned)(uintptr_t)lds + (unsigned)STAGE_BYTES + 12288u;
    if constexpr (P::SIDE) g.side_dma(cur, sidebase, wid, lane_id_v());
    const char* cA = g.a_tile(cur); const char* cB = g.b_tile(cur);
    G8_STB(G8_SB(0, 0), cB); G8_STB(G8_SB(0, 1), cB + hstepB); G8_STA(G8_SA(0, 0), cA, 0, gc); G8_STA(G8_SA(0, 1), cA, 1, gc);
    if (wr == 1) G8_BAR;
    G8_WAIT_V(2); G8_BAR;
    G8_STB(G8_SB(1, 0), cB + kstep); G8_STA(G8_SA(1, 0), cA + kstep, 0, gc); G8_STB(G8_SB(1, 1), cB + hstepB + kstep);
    G8_WAIT_V(6); G8_BAR;
    for (;;) {
        const bool has_next = S.next(ui + 1, nxt);
        const char* nA = has_next ? g.a_tile(nxt) : cA; const char* nB = has_next ? g.b_tile(nxt) : cB;
        if constexpr (P::SIDE) { if (has_next) g.side_dma(nxt, sidebase + (unsigned)(((ui + 1) % 3) * 2048), wid, lane_id_v()); }
        if (P::GATHER && has_next) {
#pragma unroll
            for (int h = 0; h < 2; ++h)
#pragma unroll
                for (int i = 0; i < 2; ++i) __builtin_amdgcn_global_load_lds((const unsigned*)g.a_row_ptr(nxt, h * 128 + i * 64 + RA0), (LAS unsigned*)(idlds + (h * 2 + i) * 2048), 4, 0, 0);
        }
#define G8_KITER(a1, a2, b2, O2, G8_IDSWAP) do { \
            const char* a3 = (a2) + kstep; const char* b3 = (b2) + kstep; \
              \
            G8_LDB(B0, 0, 0); G8_LDB(B1, 0, 1); G8_SCHED; G8_LDA(At, 0, 0); G8_STA(G8_SA(1, 1), a1, 1, gc); G8_IDSWAP(); \
            G8_WAIT_V(8); G8_WAIT_L(0); G8_BAR; G8_MMA(0, 0, At, B0); G8_MMA(0, 1, At, B1); G8_BAR; G8_SCHED; \
              \
            G8_LDA(At, 0, 1); G8_STB(G8_SB(0, 0), b2); G8_STB(G8_SB(0, 1), (b2) + hstepB); G8_STA(G8_SA(0, 0), a2, 0, O2); \
            G8_WAIT_V(8); G8_WAIT_L(0); G8_BAR; G8_MMA(1, 0, At, B0); G8_MMA(1, 1, At, B1); G8_BAR; G8_SCHED; \
              \
            G8_LDB(B0, 1, 0); G8_LDB(B1, 1, 1); G8_SCHED; G8_LDA(At, 1, 0); G8_STA(G8_SA(0, 1), a2, 1, O2); \
            G8_WAIT_V(8); G8_WAIT_L(0); G8_BAR; G8_MMA(0, 0, At, B0); G8_MMA(0, 1, At, B1); G8_BAR; G8_SCHED; \
              \
            G8_LDA(At, 1, 1); G8_STB(G8_SB(1, 0), b3); G8_STB(G8_SB(1, 1), b3 + hstepB); G8_STA(G8_SA(1, 0), a3, 0, O2); \
            G8_WAIT_V(8); G8_WAIT_L(0); G8_BAR; G8_MMA(1, 0, At, B0); G8_MMA(1, 1, At, B1); G8_BAR; G8_SCHED; } while (0)
#define G8_SWAP_IDS() do { if (P::GATHER && last && has_next) { const unsigned ida = (unsigned)(uintptr_t)(idlds + lane_id_v() * 4); \
                asm volatile("ds_read_b32 %0, %4\n\tds_read_b32 %1, %4 offset:2048\n\tds_read_b32 %2, %4 offset:4096\n\tds_read_b32 %3, %4 offset:6144\n\ts_waitcnt lgkmcnt(0)" \
                             : "=&v"(gc[0][0]), "=&v"(gc[0][1]), "=&v"(gc[1][0]), "=&v"(gc[1][1]) : "v"(ida) : "memory"); } } while (0)
#pragma nounroll
        for (int t = 0; t < nt; t += 2) {
            const bool last = (t == nt - 2);
            const char* a1 = cA + (size_t)(t + 1) * kstep;
            const char* a2 = last ? nA : cA + (size_t)(t + 2) * kstep; const char* b2 = last ? nB : cB + (size_t)(t + 2) * kstep;
            G8_KITER(a1, a2, b2, gc, G8_SWAP_IDS);
        }
#undef G8_SWAP_IDS
#undef G8_KITER
        if (wr == 0) G8_BAR;
        { const int l2 = lane_id_v(); if constexpr (P::SIDE) E(acc, cur, wr, wc, l2 & 15, l2 >> 4, (const LAS float*)(lds + STAGE_BYTES + 12288 + (ui % 3) * 2048)); else E(acc, cur, wr, wc, l2 & 15, l2 >> 4); }
        if (!has_next) break;
#pragma unroll
        for (int a = 0; a < 2; ++a)
#pragma unroll
            for (int b = 0; b < 2; ++b)
#pragma unroll
                for (int m = 0; m < 4; ++m)
#pragma unroll
                    for (int n = 0; n < 2; ++n) acc[a][b][m][n] = (f32x4){0.f, 0.f, 0.f, 0.f};
        if constexpr (Epi::PRELOAD) { const int l0 = lane_id_v(); E.preload(acc, nxt, wr, wc, l0 & 15, l0 >> 4); }
        cur = nxt; cA = nA; cB = nB; ++ui;
        if (wr == 1) G8_BAR;
    }
    G8_WAIT_V(0);
    G8_BAR;
#undef G8_SA
#undef G8_SB
#undef G8_STB
#undef G8_STA
#undef G8_LDA
#undef G8_LDB
#undef G8_MMA
#undef G8_WAIT_V
#undef G8_WAIT_L
#undef G8_BAR
#undef G8_SCHED
}

#define EPI_ROWS_BEGIN() _Pragma("unroll") for (int ai = 0; ai < 2; ++ai) _Pragma("unroll") for (int m = 0; m < 4; ++m) { const int rr = ai * HALF + wr * 64 + m * 16 + fr;
#define EPI_ROWS_END() }
__device__ __forceinline__ u32x4 pack8(const f32x4& a, const f32x4& b) { u32x4 w; w.x = cvt_pk_bf16(a[0], a[1]); w.y = cvt_pk_bf16(a[2], a[3]); w.z = cvt_pk_bf16(b[0], b[1]); w.w = cvt_pk_bf16(b[2], b[3]); return w; }

struct EpiProj {
    static constexpr bool PRELOAD = false;
    bf16_t *PQ, *PRX, *GRG, *GATE; const float* b_gate;
    template <int ACT> __device__ __forceinline__ void tile(const f32x4 (&acc)[2][2][4][2], bf16_t* base, int ldc, int colt, int row0, int wr, int wc, int fr, int fq) const {
        const int cw = wc * 32 + 8 * fq;
        f32x4 bv[2][2];
#pragma unroll
        for (int bj = 0; bj < 2; ++bj)
#pragma unroll
            for (int n = 0; n < 2; ++n) bv[bj][n] = ACT == 2 ? *(const f32x4*)(b_gate + colt + bj * HALF + cw + 4 * n) : (f32x4){0.f, 0.f, 0.f, 0.f};
        EPI_ROWS_BEGIN()
            bf16_t* rowp = base + (size_t)(row0 + rr) * ldc + colt + cw;
#pragma unroll
            for (int bj = 0; bj < 2; ++bj) { f32x4 v0 = acc[ai][bj][m][0], v1 = acc[ai][bj][m][1];
                if (ACT == 1) {
#pragma unroll
                    for (int j = 0; j < 4; ++j) { v0[j] = gelu_tanh(v0[j]); v1[j] = gelu_tanh(v1[j]); } }
                if (ACT == 2) { v0 += bv[bj][0]; v1 += bv[bj][1];
#pragma unroll
                    for (int j = 0; j < 4; ++j) { v0[j] = sigm(v0[j]); v1[j] = sigm(v1[j]); } }
                *(u32x4*)(rowp + bj * HALF) = pack8(v0, v1); }
        EPI_ROWS_END()
    }
    __device__ __forceinline__ void operator()(const f32x4 (&acc)[2][2][4][2], const Unit& u, int wr, int wc, int fr, int fq) const {
        const int pn = u.pn, row0 = u.pm * BM;
        if (pn < 3) tile<0>(acc, PQ, 768, pn * 256, row0, wr, wc, fr, fq);
        else if (pn < 7) tile<0>(acc, PRX, 1024, (pn - 3) * 256, row0, wr, wc, fr, fq);
        else if (pn < 11) tile<1>(acc, GRG, 1024, (pn - 7) * 256, row0, wr, wc, fr, fq);
        else tile<2>(acc, GATE, 2048, (pn - 11) * 256, row0, wr, wc, fr, fq);
    }
};
struct EpiQ {
    static constexpr bool PRELOAD = false;
    bf16_t* Q; const float* COS; const float* SIN;
    __device__ __forceinline__ void operator()(const f32x4 (&acc)[2][2][4][2], const Unit& u, int wr, int wc, int fr, int fq) const {
        EPI_ROWS_BEGIN()
            const int row = u.pm * BM + rr, t = NMETA + (row & 8191);
#pragma unroll
            for (int bj = 0; bj < 2; ++bj) { const int col0 = u.pn * BM + bj * HALF + wc * 32 + 8 * fq, hh = col0 / 96, off = col0 - 96 * hh;
                f32x4 v0 = acc[ai][bj][m][0], v1 = acc[ai][bj][m][1];
                if (off >= 64) { const int i0 = (off - 64) >> 1; const f32x4 c = *(const f32x4*)(COS + t * 16 + i0), s = *(const f32x4*)(SIN + t * 16 + i0);
                    const float a0 = v0[0] * c[0] - v0[1] * s[0], b0 = v0[0] * s[0] + v0[1] * c[0];
                    const float a1 = v0[2] * c[1] - v0[3] * s[1], b1 = v0[2] * s[1] + v0[3] * c[1];
                    const float a2 = v1[0] * c[2] - v1[1] * s[2], b2 = v1[0] * s[2] + v1[1] * c[2];
                    const float a3 = v1[2] * c[3] - v1[3] * s[3], b3 = v1[2] * s[3] + v1[3] * c[3];
                    v0 = (f32x4){a0, b0, a1, b1}; v1 = (f32x4){a2, b2, a3, b3}; }
                *(u32x4*)(Q + (size_t)row * 768 + col0) = pack8(v0, v1); }
        EPI_ROWS_END()
    }
};
struct EpiKV {
    static constexpr bool PRELOAD = false;
    bf16_t *KN, *V;
    __device__ __forceinline__ void operator()(const f32x4 (&acc)[2][2][4][2], const Unit& u, int wr, int wc, int fr, int fq) const {
        EPI_ROWS_BEGIN()
            const int kr = kvrow_of(u.pm * BM + rr);
#pragma unroll
            for (int bj = 0; bj < 2; ++bj) { const int col0 = u.pn * BM + bj * HALF + wc * 32 + 8 * fq, hh = col0 >> 7, j = col0 & 127;
                bf16_t* dst = (j < 64 ? KN + hh * 64 + j : V + hh * 64 + (j - 64)) + (size_t)kr * 512;
                *(u32x4*)dst = pack8(acc[ai][bj][m][0], acc[ai][bj][m][1]); }
        EPI_ROWS_END()
    }
};
struct EpiGates {
    static constexpr bool PRELOAD = false;
    const bf16_t* XC; const float *b_a, *b_x; _Float16 *R16, *U16;
    __device__ __forceinline__ void operator()(const f32x4 (&acc)[2][2][4][2], const Unit& u, int wr, int wc, int fr, int fq) const {
        const int ch = u.pn * 128 + wc * 32 + 8 * fq;
        const f32x4 ba0 = *(const f32x4*)(b_a + ch), ba1 = *(const f32x4*)(b_a + ch + 4), bx0 = *(const f32x4*)(b_x + ch), bx1 = *(const f32x4*)(b_x + ch + 4);
        u32x4 xwv[2][4];
#pragma unroll
        for (int ai = 0; ai < 2; ++ai)
#pragma unroll
            for (int m = 0; m < 4; ++m) xwv[ai][m] = *(const u32x4*)(XC + (size_t)(u.pm * BM + ai * HALF + wr * 64 + m * 16 + fr) * 1024 + ch);
        asm volatile("" ::: "memory");
        EPI_ROWS_BEGIN()
            const size_t o = (size_t)(u.pm * BM + rr) * 1024 + ch;
            const u32x4 xw = xwv[ai][m];
            const f32x4 a0 = acc[ai][0][m][0] + ba0, a1 = acc[ai][0][m][1] + ba1, x0 = acc[ai][1][m][0] + bx0, x1 = acc[ai][1][m][1] + bx1;
            float xc[8] = {bf_lo(xw.x), bf_hi(xw.x), bf_lo(xw.y), bf_hi(xw.y), bf_lo(xw.z), bf_hi(xw.z), bf_lo(xw.w), bf_hi(xw.w)};
            h16x8 rv, uv;
#pragma unroll
            for (int j = 0; j < 4; ++j) { rv[j] = (_Float16)sigm(a0[j]); rv[4 + j] = (_Float16)sigm(a1[j]); uv[j] = (_Float16)(sigm(x0[j]) * xc[j]); uv[4 + j] = (_Float16)(sigm(x1[j]) * xc[4 + j]); }
            *(h16x8*)(R16 + o) = rv; *(h16x8*)(U16 + o) = uv;
        EPI_ROWS_END()
    }
};
struct EpiAo {
    static constexpr bool PRELOAD = false;
    const bf16_t* GATE; bf16_t* MA;
    __device__ __forceinline__ void operator()(const f32x4 (&acc)[2][2][4][2], const Unit& u, int wr, int wc, int fr, int fq) const {
#pragma unroll
        for (int ai = 0; ai < 2; ++ai) { u32x4 gw[4][2];
#pragma unroll
            for (int m = 0; m < 4; ++m) { const int row = u.pm * BM + ai * HALF + wr * 64 + m * 16 + fr;
#pragma unroll
                for (int bj = 0; bj < 2; ++bj) gw[m][bj] = __builtin_nontemporal_load((const u32x4*)(GATE + (size_t)row * 2048 + u.pn * BM + bj * HALF + wc * 32 + 8 * fq)); }
            asm volatile("" ::: "memory");
#pragma unroll
            for (int m = 0; m < 4; ++m) { const int row = u.pm * BM + ai * HALF + wr * 64 + m * 16 + fr;
#pragma unroll
                for (int bj = 0; bj < 2; ++bj) { const int col0 = u.pn * BM + bj * HALF + wc * 32 + 8 * fq; const u32x4 g = gw[m][bj];
                    f32x4 v0 = acc[ai][bj][m][0], v1 = acc[ai][bj][m][1];
                    v0 *= (f32x4){bf_lo(g.x), bf_hi(g.x), bf_lo(g.y), bf_hi(g.y)}; v1 *= (f32x4){bf_lo(g.z), bf_hi(g.z), bf_lo(g.w), bf_hi(g.w)};
                    *(u32x4*)(MA + (size_t)row * 1024 + col0) = pack8(v0, v1); } } }
    }
};
struct EpiRo {
    static constexpr bool PRELOAD = false;
    const bf16_t* GATE; const bf16_t* MA; bf16_t* MG;
    __device__ __forceinline__ void operator()(const f32x4 (&acc)[2][2][4][2], const Unit& u, int wr, int wc, int fr, int fq) const {
#pragma unroll
        for (int ai = 0; ai < 2; ++ai) { u32x4 gw[4][2], mw[4][2];
#pragma unroll
            for (int m = 0; m < 4; ++m) { const int row = u.pm * BM + ai * HALF + wr * 64 + m * 16 + fr;
#pragma unroll
                for (int bj = 0; bj < 2; ++bj) { const int col0 = u.pn * BM + bj * HALF + wc * 32 + 8 * fq;
                    gw[m][bj] = __builtin_nontemporal_load((const u32x4*)(GATE + (size_t)row * 2048 + 1024 + col0)); mw[m][bj] = *(const u32x4*)(MA + (size_t)row * 1024 + col0); } }
            asm volatile("" ::: "memory");
#pragma unroll
            for (int m = 0; m < 4; ++m) { const int row = u.pm * BM + ai * HALF + wr * 64 + m * 16 + fr;
#pragma unroll
                for (int bj = 0; bj < 2; ++bj) { const int col0 = u.pn * BM + bj * HALF + wc * 32 + 8 * fq; const u32x4 g = gw[m][bj], q = mw[m][bj];
                    f32x4 v0 = acc[ai][bj][m][0], v1 = acc[ai][bj][m][1];
                    v0 = v0 * (f32x4){bf_lo(g.x), bf_hi(g.x), bf_lo(g.y), bf_hi(g.y)} + (f32x4){bf_lo(q.x), bf_hi(q.x), bf_lo(q.y), bf_hi(q.y)};
                    v1 = v1 * (f32x4){bf_lo(g.z), bf_hi(g.z), bf_lo(g.w), bf_hi(g.w)} + (f32x4){bf_lo(q.z), bf_hi(q.z), bf_lo(q.w), bf_hi(q.w)};
                    *(u32x4*)(MG + (size_t)row * 1024 + col0) = pack8(v0, v1); } } }
    }
};
struct EpiOut {
    static constexpr bool PRELOAD = true;
    const float* X; bf16_t* H2; unsigned char* H8; const float* gffn;
    __device__ __forceinline__ void preload(f32x4 (&acc)[2][2][4][2], const Unit& u, int wr, int wc, int fr, int fq) const {
        EPI_ROWS_BEGIN()
            const int row = u.pm * BM + rr;
#pragma unroll
            for (int bj = 0; bj < 2; ++bj) { const size_t o = (size_t)row * 1024 + u.pn * BM + bj * HALF + wc * 32 + 8 * fq;
                acc[ai][bj][m][0] = __builtin_nontemporal_load((const f32x4*)(X + o)); acc[ai][bj][m][1] = __builtin_nontemporal_load((const f32x4*)(X + o + 4)); }
        EPI_ROWS_END()
    }
    __device__ __forceinline__ void operator()(const f32x4 (&acc)[2][2][4][2], const Unit& u, int wr, int wc, int fr, int fq) const {
        EPI_ROWS_BEGIN()
            const int row = u.pm * BM + rr;
#pragma unroll
            for (int bj = 0; bj < 2; ++bj) { const size_t o = (size_t)row * 1024 + u.pn * BM + bj * HALF + wc * 32 + 8 * fq;
                const f32x4 v0 = acc[ai][bj][m][0], v1 = acc[ai][bj][m][1];
                *(u32x4*)(H2 + o) = pack8(v0, v1);
                const int cg_ = u.pn * BM + bj * HALF + wc * 32 + 8 * fq; const f32x4 g0 = *(const f32x4*)(gffn + cg_), g1 = *(const f32x4*)(gffn + cg_ + 4);
                u32x2 w8; w8.x = pack_fp8x4(v0[0] * g0[0], v0[1] * g0[1], v0[2] * g0[2], v0[3] * g0[3]); w8.y = pack_fp8x4(v1[0] * g1[0], v1[1] * g1[1], v1[2] * g1[2], v1[3] * g1[3]); *(u32x2*)(H8 + o) = w8; }
        EPI_ROWS_END()
    }
};
struct EpiUp {
    static constexpr bool PRELOAD = false;
    unsigned char* ACT;
    __device__ __forceinline__ void operator()(const f32x4 (&acc)[2][2][4][2], const Unit& u, int wr, int wc, int fr, int fq, const LAS float* side) const {
        const int c0 = u.pn * 128 + wc * 32 + 8 * fq, cl = wc * 32 + 8 * fq;
        const f32x4 bg0 = *(const LAS f32x4*)(side + 256 + cl), bg1 = *(const LAS f32x4*)(side + 256 + cl + 4), bl0 = *(const LAS f32x4*)(side + 384 + cl), bl1 = *(const LAS f32x4*)(side + 384 + cl + 4);
        EPI_ROWS_BEGIN()
            const float rs = side[rr];
            f32x4 g0 = acc[ai][0][m][0] * rs + bg0, g1 = acc[ai][0][m][1] * rs + bg1, l0 = acc[ai][1][m][0] * rs + bl0, l1 = acc[ai][1][m][1] * rs + bl1;
#define UP_PAIR(G_, L_, i0) do { f32x2 a2 = {fminf(G_[i0], 7.f), fminf(G_[i0 + 1], 7.f)}; f32x2 p2 = {fminf(fmaxf(L_[i0], -7.f), 7.f), fminf(fmaxf(L_[i0 + 1], -7.f), 7.f)}; \
                const f32x2 k4 = {A8_SCALE, A8_SCALE}, kc = {-1.702f * 1.4426950408889634f, -1.702f * 1.4426950408889634f}, one = {1.f, 1.f}; \
                p2 = __builtin_elementwise_fma(p2, k4, k4); f32x2 e2 = a2 * kc; e2.x = __builtin_amdgcn_exp2f(e2.x); e2.y = __builtin_amdgcn_exp2f(e2.y); e2 += one; \
                e2.x = __builtin_amdgcn_rcpf(e2.x); e2.y = __builtin_amdgcn_rcpf(e2.y); a2 = (a2 * e2) * p2; G_[i0] = a2.x; G_[i0 + 1] = a2.y; } while (0)
            UP_PAIR(g0, l0, 0); UP_PAIR(g0, l0, 2); UP_PAIR(g1, l1, 0); UP_PAIR(g1, l1, 2);
#undef UP_PAIR
            { u32x2 w8; w8.x = pack_fp8x4_nc(g0[0], g0[1], g0[2], g0[3]); w8.y = pack_fp8x4_nc(g1[0], g1[1], g1[2], g1[3]);
              *(u32x2*)(ACT + (size_t)(u.pm * BM + rr) * 1024 + c0) = w8; }
        EPI_ROWS_END()
    }
};
struct EpiDown {
    static constexpr bool PRELOAD = false;
    unsigned char* YE;
    __device__ __forceinline__ void operator()(const f32x4 (&acc)[2][2][4][2], const Unit& u, int wr, int wc, int fr, int fq, const LAS float* side) const {
        f32x4 bdv[2][2];
#pragma unroll
        for (int bj = 0; bj < 2; ++bj) { bdv[bj][0] = *(const LAS f32x4*)(side + 256 + bj * HALF + wc * 32 + 8 * fq); bdv[bj][1] = *(const LAS f32x4*)(side + 256 + bj * HALF + wc * 32 + 8 * fq + 4); }
        EPI_ROWS_BEGIN()
            const float gt = side[rr] * Y8_SCALE;
#pragma unroll
            for (int bj = 0; bj < 2; ++bj) { const int col0 = u.pn * BM + bj * HALF + wc * 32 + 8 * fq;
                const f32x4 v0 = (acc[ai][bj][m][0] + bdv[bj][0]) * gt, v1 = (acc[ai][bj][m][1] + bdv[bj][1]) * gt;
                u32x2 w8; w8.x = pack_fp8x4(v0[0], v0[1], v0[2], v0[3]); w8.y = pack_fp8x4(v1[0], v1[1], v1[2], v1[3]);
                *(u32x2*)(YE + (size_t)(u.pm * BM + rr) * 1024 + col0) = w8; }
        EPI_ROWS_END()
    }
};
}

namespace att {
constexpr int NW = 8, QBLK = 32, KVBLK = 64, QB = 256;
constexpr int LDQ = 768, LDKN = 512, LDKP = 32, LDV = 512, LDO = 512;
constexpr int SHM_K = KVBLK * 256, SHM_V = KVBLK * 64 * 2;
constexpr int LDS_BYTES = 2 * SHM_V + 2 * SHM_K + NW * 64 * 4;
constexpr float SCALE = 0.10206207261596577f;
constexpr float THR = 8.f;
#define KSWZ(row, colB) ((row) * 256 + ((colB) ^ (((row) & 7) << 4)))
#define SBAR() __builtin_amdgcn_sched_barrier(0)
__device__ __forceinline__ int v_st(int k, int c) { const int kk = (k & ~0xC) | ((k & 4) << 1) | ((k & 8) >> 1); return ((kk >> 3) * 2 + (c >> 5)) * 512 + ((kk & 7) * 32 + (c & 31)) * 2; }
__device__ __forceinline__ int v_rd_base(int lane) { return ((lane & 3) << 3) | (((lane >> 2) & 3) << 6) | (((lane >> 4) & 1) << 5) | (((lane >> 5) & 1) << 8); }
__device__ __forceinline__ int crow(int r, int hi) { return (r & 3) + 8 * (r >> 2) + 4 * hi; }
__device__ __forceinline__ unsigned cvtpk(float lo, float hi) { return cvt_pk_bf16(lo, hi); }
__device__ __forceinline__ bf16x8 load8(const bf16_t* p) { return *reinterpret_cast<const bf16x8*>(p); }
__device__ __forceinline__ void mask_tile(f32x16& p0, f32x16& p1, int dq) {
    const float NEG = -__builtin_inff();
#pragma unroll
    for (int r = 0; r < 16; ++r) { const int c = (r & 3) + 8 * (r >> 2); if (c > dq) p0[r] = NEG; if (c + 32 > dq) p1[r] = NEG; }
}
__device__ __forceinline__ void mask_meta(f32x16& p0, f32x16& p1) {
    const float NEG = -__builtin_inff();
#pragma unroll
    for (int r = 8; r < 16; ++r) p0[r] = NEG;
#pragma unroll
    for (int r = 0; r < 16; ++r) p1[r] = NEG;
}
__device__ __forceinline__ void partialSM(f32x16& p0, f32x16& p1, float& m_reg, float& mn, float& alpha) {
    float pmax = p0[0];
#pragma unroll
    for (int r = 1; r < 16; ++r) pmax = fmaxf(pmax, p0[r]);
#pragma unroll
    for (int r = 0; r < 16; ++r) pmax = fmaxf(pmax, p1[r]);
    { auto rr = __builtin_amdgcn_permlane32_swap(__float_as_uint(pmax), __float_as_uint(pmax), false, false);
      pmax = fmaxf(__uint_as_float(rr[0]), __uint_as_float(rr[1])); }
    constexpr float C2 = 1.4426950408889634f * SCALE;
    if (__builtin_expect(__all((pmax - m_reg) * SCALE <= THR), 1)) { mn = m_reg; alpha = 1.f; }
    else { mn = fmaxf(m_reg, pmax); alpha = __builtin_amdgcn_exp2f((m_reg - mn) * C2); m_reg = mn; }
    const float mnL = -mn * C2;
    { const f32x2 c2v = {C2, C2}, mlv = {mnL, mnL};
#pragma unroll
      for (int r = 0; r < 16; r += 2) { f32x2 a = {p0[r], p0[r + 1]}, b = {p1[r], p1[r + 1]}; a = __builtin_elementwise_fma(a, c2v, mlv); b = __builtin_elementwise_fma(b, c2v, mlv);
          p0[r] = a.x; p0[r + 1] = a.y; p1[r] = b.x; p1[r + 1] = b.y; } }
#pragma unroll
    for (int r = 0; r < 16; ++r) p0[r] = __builtin_amdgcn_exp2f(p0[r]);
}
__device__ __forceinline__ void finishSM(f32x16& p0, f32x16& p1, float alpha, float& l_reg, bf16x8& pa0, bf16x8& pa1, bf16x8& pa2, bf16x8& pa3) {
#pragma unroll
    for (int r = 0; r < 16; ++r) p1[r] = __builtin_amdgcn_exp2f(p1[r]);
    float ps;
    { f32x2 s2 = {0.f, 0.f}, t2 = {0.f, 0.f};
#pragma unroll
      for (int r = 0; r < 16; r += 2) { s2 += (f32x2){p0[r], p0[r + 1]}; t2 += (f32x2){p1[r], p1[r + 1]}; }
      s2 += t2; ps = s2.x + s2.y; }
    { auto rr = __builtin_amdgcn_permlane32_swap(__float_as_uint(ps), __float_as_uint(ps), false, false);
      ps = __uint_as_float(rr[0]) + __uint_as_float(rr[1]); }
    l_reg = l_reg * alpha + ps;
#define PK4(P, B_, OUT) do { unsigned a0 = cvtpk(P[B_+0], P[B_+1]), a1 = cvtpk(P[B_+2], P[B_+3]);                          \
        unsigned b0 = cvtpk(P[B_+4], P[B_+5]), b1 = cvtpk(P[B_+6], P[B_+7]);                                             \
        auto r0 = __builtin_amdgcn_permlane32_swap(a0, b0, false, false); auto r1 = __builtin_amdgcn_permlane32_swap(a1, b1, false, false); \
        u32x4 w = {r0[0], r1[0], r0[1], r1[1]}; OUT = *reinterpret_cast<bf16x8*>(&w); } while (0)
    PK4(p0, 0, pa0); PK4(p0, 8, pa1); PK4(p1, 0, pa2); PK4(p1, 8, pa3);
#undef PK4
}
template <int KB>
__device__ __forceinline__ void qkt(f32x16& p0, f32x16& p1, const char* K_lds, int r32, int hi, const bf16x8* qr) {
    p0 = f32x16{}; p1 = f32x16{};
    const char* kb[4];
#pragma unroll
    for (int dd = 0; dd < 4; ++dd) kb[dd] = K_lds + KB * SHM_K + KSWZ(r32, (dd * 16 + hi * 8) * 2);
#pragma unroll
    for (int d0 = 0; d0 < 6; ++d0) { const char* a = kb[d0 & 3] + (d0 >> 2) * 128;
        bf16x8 b0 = *reinterpret_cast<const bf16x8*>(a);
        bf16x8 b1 = *reinterpret_cast<const bf16x8*>(a + 32 * 256);
        p0 = __builtin_amdgcn_mfma_f32_32x32x16_bf16(b0, qr[d0], p0, 0, 0, 0);
        p1 = __builtin_amdgcn_mfma_f32_32x32x16_bf16(b1, qr[d0], p1, 0, 0, 0); }
}
template <int VB>
__device__ __forceinline__ void pv_tile(f32x16* o, int vb0, bf16x8 pa0, bf16x8 pa1, bf16x8 pa2, bf16x8 pa3) {
#define TRRD(dst, off) asm volatile("ds_read_b64_tr_b16 %0, %1 offset:%2" : "=&v"(dst) : "v"(vb0), "i"(off) : "memory")
#define PV_D0(d0) do { s16x4 l0, l1, l2, l3, h0, h1, h2, h3; constexpr int b_ = VB * SHM_V + (d0) * 512;     \
        TRRD(l0, b_); TRRD(h0, b_ + 1024); TRRD(l1, b_ + 2048); TRRD(h1, b_ + 3072); TRRD(l2, b_ + 4096); TRRD(h2, b_ + 5120); TRRD(l3, b_ + 6144); TRRD(h3, b_ + 7168); \
        asm volatile("s_waitcnt lgkmcnt(0)" ::: "memory"); SBAR();   \
        o[d0] = __builtin_amdgcn_mfma_f32_32x32x16_bf16(pa0, (bf16x8){l0[0], l0[1], l0[2], l0[3], h0[0], h0[1], h0[2], h0[3]}, o[d0], 0, 0, 0);   \
        o[d0] = __builtin_amdgcn_mfma_f32_32x32x16_bf16(pa1, (bf16x8){l1[0], l1[1], l1[2], l1[3], h1[0], h1[1], h1[2], h1[3]}, o[d0], 0, 0, 0);   \
        o[d0] = __builtin_amdgcn_mfma_f32_32x32x16_bf16(pa2, (bf16x8){l2[0], l2[1], l2[2], l2[3], h2[0], h2[1], h2[2], h2[3]}, o[d0], 0, 0, 0);   \
        o[d0] = __builtin_amdgcn_mfma_f32_32x32x16_bf16(pa3, (bf16x8){l3[0], l3[1], l3[2], l3[3], h3[0], h3[1], h3[2], h3[3]}, o[d0], 0, 0, 0); } while (0)
    PV_D0(0); PV_D0(1);
#undef PV_D0
#undef TRRD
}
struct BlockRef { const bf16_t* Q; const bf16_t* KN; const bf16_t* KPE; const bf16_t* V; bf16_t* O; int P0; };
struct Seam { bf16x8 qr[6]; bf16x8 st_v[2], st_kn[2], st_kp[2]; };
#define VMW() asm volatile("s_waitcnt vmcnt(0)" ::: "memory")
#define VMWN(n) asm volatile("s_waitcnt vmcnt(%0)" :: "i"(n) : "memory")
#define VMW_KEEP1() asm volatile("s_waitcnt vmcnt(3)" ::: "memory")
#define SLOAD(ref, k0, X) do { S.st_v[X] = load8((ref).V + (size_t)((k0) + vr) * LDV + vc8); S.st_kn[X] = load8((ref).KN + (size_t)((k0) + vr) * LDKN + vc8); \
                            S.st_kp[X] = load8((ref).KPE + (size_t)((k0) + pr) * LDKP + pc8); } while (0)
#define SWRITE_K(bf, X) do { *(bf16x8*)(K_lds + (bf) * SHM_K + kws) = S.st_kn[X]; *(bf16x8*)(K_lds + (bf) * SHM_K + kpws) = S.st_kp[X]; } while (0)
#define SWRITE_V(bf, X) do { *(bf16x8*)(V_lds + (bf) * SHM_V + vst) = S.st_v[X]; } while (0)
__device__ __forceinline__ void attn_prime(const BlockRef& cur, char* lds, Seam& S, const int wid) {
    const int lane = lane_id_v(), tid = wid * 64 + lane, r32 = lane & 31, hi = lane >> 5;
    const int vr = tid >> 3, vc8 = (tid & 7) * 8, pr = (tid >> 2) & 63, pc8 = (tid & 3) * 8;
    const int kws = KSWZ(vr, vc8 * 2), kpws = KSWZ(pr, (64 + pc8) * 2); char* K_lds = lds + 2 * SHM_V;
#pragma unroll
    for (int d0 = 0; d0 < 6; ++d0) S.qr[d0] = load8(cur.Q + (size_t)(wid * QBLK + r32) * LDQ + d0 * 16 + hi * 8);
    SLOAD(cur, 0, 0); VMW(); SWRITE_K(0, 0);
    __syncthreads();
}
__device__ __forceinline__ void attn_block(const BlockRef& cur, const BlockRef& nxt, char* lds, Seam& S, const int wid) {
    const int lane = lane_id_v(), tid = wid * 64 + lane, r32 = lane & 31, hi = lane >> 5;
    const int NT = (cur.P0 + QB - 1) / KVBLK + 1;
    const int qlo = cur.P0 + wid * QBLK, qm = qlo + r32 - 4 * hi;
    char* V_lds = lds; char* K_lds = lds + 2 * SHM_V;
    float* ws = (float*)(lds + 2 * SHM_V + 2 * SHM_K) + wid * 64; float* li_l = ws, * al_l = ws + 32;
    float m_reg = -1e30f, l_reg = 0; f32x16 o[2] = {};
    const int vr = tid >> 3, vc8 = (tid & 7) * 8, pr = (tid >> 2) & 63, pc8 = (tid & 3) * 8;
    const int vst = v_st(vr, vc8), kws = KSWZ(vr, vc8 * 2), kpws = KSWZ(pr, (64 + pc8) * 2);
    const int vb0 = (int)(uintptr_t)V_lds + v_rd_base(lane);
#define RESC(a) do { if (__any((a) < 1.f)) { if (hi == 0) al_l[r32] = (a); asm volatile("s_waitcnt lgkmcnt(0)" ::: "memory");              \
                     _Pragma("unroll") for (int d_ = 0; d_ < 2; ++d_) _Pragma("unroll") for (int r = 0; r < 16; ++r) o[d_][r] *= al_l[crow(r, hi)]; } } while (0)
#define KBASE(t) ((t) * KVBLK)
#define MASKT(P0_, P1_, t) do { const int kb_ = KBASE(t); if ((t) == 0) mask_meta(P0_, P1_); else if (kb_ + KVBLK - 1 > qlo) mask_tile(P0_, P1_, qm - kb_); } while (0)
    constexpr int NQL = 6;
#define SEAM_K0() do { VMWN(NQL); SWRITE_K(0, 0); SBAR(); } while (0)
    f32x16 pA0, pA1, pB0, pB1; float mnA, mnB, alA, alB; bf16x8 pa0, pa1, pa2, pa3;
    SWRITE_V(0, 0); SBAR();
    SLOAD(cur, KBASE(1), 1); SBAR(); SLOAD(cur, KBASE(2), 0);
    SBAR(); qkt<0>(pA0, pA1, K_lds, r32, hi, S.qr);
    MASKT(pA0, pA1, 0); partialSM(pA0, pA1, m_reg, mnA, alA);
    VMW_KEEP1(); SWRITE_V(1, 1); SWRITE_K(1, 1);
    __syncthreads();
#define HALF_STEP(PX0, PX1, mnX, alX, PY0, PY1, alY, t, KB, VB, SB, XS, XL, LOADS, WRITES) do {                                              \
        SBAR(); qkt<KB>(PX0, PX1, K_lds, r32, hi, S.qr);                                                           \
        finishSM(PY0, PY1, alY, l_reg, pa0, pa1, pa2, pa3); SBAR();                                                           \
        if (LOADS) { SLOAD(cur, KBASE((t) + 2), XL); SBAR(); }                                               \
        pv_tile<VB>(o, vb0, pa0, pa1, pa2, pa3); MASKT(PX0, PX1, (t)); partialSM(PX0, PX1, m_reg, mnX, alX);                  \
        __syncthreads();                                                                                                      \
        if (WRITES) { if (LOADS) VMW_KEEP1(); else VMW(); SWRITE_V(SB, XS); SWRITE_K(SB, XS); }                                                                          \
        RESC(alX); __syncthreads(); } while (0)
    int t = 1;
    for (; t + 3 < NT; t += 2) {
        HALF_STEP(pB0, pB1, mnB, alB, pA0, pA1, alA, t, 1, 0, 0, 0, 1, true, true);
        HALF_STEP(pA0, pA1, mnA, alA, pB0, pB1, alB, t + 1, 0, 1, 1, 1, 0, true, true);
    }
    HALF_STEP(pB0, pB1, mnB, alB, pA0, pA1, alA, t, 1, 0, 0, 0, 1, false, true);
    HALF_STEP(pA0, pA1, mnA, alA, pB0, pB1, alB, t + 1, 0, 1, 1, 1, 0, false, false);
    SLOAD(nxt, 0, 0); SBAR();
#pragma unroll
    for (int d0 = 0; d0 < 6; ++d0) S.qr[d0] = load8(nxt.Q + (size_t)(wid * QBLK + r32) * LDQ + d0 * 16 + hi * 8);
    SBAR();
    finishSM(pA0, pA1, alA, l_reg, pa0, pa1, pa2, pa3); SBAR();
    pv_tile<0>(o, vb0, pa0, pa1, pa2, pa3);
    SBAR(); SEAM_K0();
    if (hi == 0) li_l[r32] = l_reg; asm volatile("s_waitcnt lgkmcnt(0)" ::: "memory");
    float rli[16];
#pragma unroll
    for (int r = 0; r < 16; ++r) rli[r] = __builtin_amdgcn_rcpf(li_l[crow(r, hi)]);
    bf16_t* Ow = cur.O + (size_t)(wid * QBLK) * LDO;
#pragma unroll
    for (int r = 0; r < 16; ++r) { const int orow = crow(r, hi);
#pragma unroll
        for (int d0 = 0; d0 < 2; ++d0) { const float v = o[d0][r] * rli[r];
            const float vn = __shfl_xor(v, 1);
            if ((r32 & 1) == 0) *(unsigned*)(Ow + (size_t)orow * LDO + d0 * 32 + r32) = cvtpk(v, vn); } }
    __syncthreads();
#undef RESC
#undef KBASE
#undef MASKT
#undef SEAM_K0
#undef HALF_STEP
}
#undef VMW_KEEP1
#undef VMW
#undef VMWN
#undef SLOAD
#undef SWRITE_K
#undef SWRITE_V
#undef KSWZ
#undef SBAR
}

constexpr int NWAVES = 8;
constexpr int N_PHASES = 13;
constexpr size_t MiB = 1u << 20;
constexpr size_t WS_CTL = 0, CTL_ZERO_BYTES = 64 * 1024;
constexpr size_t WS_WRP  = 1 * MiB;
constexpr size_t WS_WUQ  = 2 * MiB;
constexpr size_t WS_WUKV = 3 * MiB;
constexpr size_t WS_WG   = 4 * MiB;
constexpr size_t WS_WAO  = 5 * MiB;
constexpr size_t WS_WRO  = 6 * MiB;
constexpr size_t WS_WOUT = 8 * MiB;
constexpr size_t WS_WIN  = 10 * MiB;
constexpr size_t WS_WUP  = 20 * MiB;
constexpr size_t WS_WDN  = 148 * MiB;
constexpr size_t WS_ACT  = 212 * MiB;
constexpr size_t WS_GATE = 212 * MiB;
constexpr size_t WS_GRG  = 341 * MiB;
constexpr size_t WS_XN   = 406 * MiB;
constexpr size_t WS_XC   = WS_XN, WS_MA = WS_XN;
constexpr size_t WS_YE   = 484 * MiB;
constexpr size_t WS_PQ   = 484 * MiB;
constexpr size_t WS_Y    = 484 * MiB;
constexpr size_t WS_PRX  = 533 * MiB;
constexpr size_t WS_R16  = 598 * MiB;
constexpr size_t WS_MG   = 598 * MiB;
constexpr size_t WS_U16  = 663 * MiB;
constexpr size_t WS_CQ   = 728 * MiB;
constexpr size_t WS_H2   = 756 * MiB;
constexpr size_t WS_HB   = 884 * MiB;
constexpr size_t WS_Q    = 756 * MiB;
constexpr size_t WS_KN   = 804 * MiB;
constexpr size_t WS_V    = 837 * MiB;
constexpr size_t WS_O    = 870 * MiB;
constexpr size_t WS_CKV  = 902 * MiB;
constexpr size_t WS_KPE  = 919 * MiB;
constexpr size_t WS_ROPE = 922 * MiB;
constexpr size_t WS_AGF  = 924 * MiB;
constexpr size_t WS_AGC  = 932 * MiB;
constexpr size_t WS_ELIST = 948 * MiB;
constexpr size_t WS_RSTDS = 952 * MiB;
constexpr size_t WS_GATES = 956 * MiB;
constexpr size_t WS_TOKSL = 960 * MiB;
constexpr size_t WS_END   = 1024 * MiB;
constexpr int CW_BAR = 1024;
constexpr int CW_CNT = 8192;
constexpr int RING_BYTES = 131072;
constexpr int LDSCTL_OFF = RING_BYTES, MISC_OFF = LDSCTL_OFF + 64;
constexpr int LDS_BYTES = 151552;
constexpr int LT_TS = 64;
constexpr int LT_LCNT = 160, LT_LBASE = 192;

#define XB_TMO      128
#define XB_XCNT(j)  (256  + 64 * (j))
#define XB_XSUB(j)  (1280 + 64 * (j))
#define XB_XGEN(j)  (2304 + 64 * (j))
#define XB_TOP      3328
#define XB_TOPGEN   3392
#define XCD_BAR_WORDS 3456
#define XB_SPIN_CAP (1u << 18)
__device__ __forceinline__ unsigned xb_ld(unsigned* p)              { return __hip_atomic_load(p, __ATOMIC_RELAXED, __HIP_MEMORY_SCOPE_AGENT); }
__device__ __forceinline__ unsigned xb_add(unsigned* p, unsigned v) { return __hip_atomic_fetch_add(p, v, __ATOMIC_RELAXED, __HIP_MEMORY_SCOPE_AGENT); }
__device__ __forceinline__ unsigned xb_xcc_id() { return (unsigned)__builtin_amdgcn_s_getreg((3 << 11) | 20) & 0xFu; }
#define XB_SPIN(cond, bar) do { unsigned _sp = 0; while (cond) { __builtin_amdgcn_s_sleep(1); \
    if ((++_sp & 255u) == 0u) { if (xb_ld(&(bar)[XB_TMO])) break; if (_sp > XB_SPIN_CAP) { atomicAdd(&(bar)[XB_TMO], 1u); break; } } } } while (0)
struct XcdBarrier { unsigned* bar; unsigned x; volatile LAS unsigned* st; int wid; };
__device__ __forceinline__ XcdBarrier xcd_barrier_post(unsigned* bar, volatile LAS unsigned* st, const int wid) {
    XcdBarrier b; b.bar = bar; b.x = xb_xcc_id(); b.st = st; b.wid = wid;
    if (wid == 0 && lane_id_v() == 0) (void)xb_add(&bar[XB_XCNT(b.x)], 1u);
    return b;
}
__device__ __forceinline__ void xcd_barrier_complete(unsigned* bar, unsigned x, unsigned& nloc, unsigned& nx) {
    const unsigned G = gridDim.x * gridDim.y * gridDim.z;
    unsigned sum, cnt, mine, sp = 0u;
    for (;;) {
        sum = 0u; cnt = 0u; mine = 0u;
#pragma unroll
        for (unsigned j = 0; j < 16; ++j) { const unsigned c = xb_ld(&bar[XB_XCNT(j)]); sum += c; cnt += (c > 0u) ? 1u : 0u; mine = (j == x) ? c : mine; }
        if (sum == G) break;
        __builtin_amdgcn_s_sleep(1);
        if ((++sp & 255u) == 0u) { if (xb_ld(&bar[XB_TMO])) break; if (sp > XB_SPIN_CAP) { atomicAdd(&bar[XB_TMO], 1u); break; } }
    }
    nloc = mine > 0u ? mine : 1u; nx = cnt > 0u ? cnt : 1u;
}
__device__ __forceinline__ void xcd_barrier(const XcdBarrier& b) {
    asm volatile("s_waitcnt vmcnt(0)" ::: "memory");
    __syncthreads();
    if (b.wid == 0 && lane_id_v() == 0) {
        unsigned* bar = b.bar;
        __builtin_amdgcn_s_waitcnt(0);
        unsigned nloc = b.st[0], nx = b.st[1];
        if (nloc == 0u) { xcd_barrier_complete(bar, b.x, nloc, nx); b.st[0] = nloc; b.st[1] = nx; }
        const unsigned old = xb_add(&bar[XB_XSUB(b.x)], 1u);
        const unsigned gen = old / nloc;
        if (old + 1u == (gen + 1u) * nloc) {
            __builtin_amdgcn_fence(__ATOMIC_RELEASE, "agent");
            asm volatile("s_waitcnt vmcnt(0)" ::: "memory");
            const unsigned og = xb_add(&bar[XB_TOP], 1u);
            const unsigned tg = og / nx;
            if (og + 1u == (tg + 1u) * nx) xb_add(&bar[XB_TOPGEN], 1u);
            else XB_SPIN(xb_ld(&bar[XB_TOPGEN]) == tg, bar);
            __builtin_amdgcn_fence(__ATOMIC_ACQUIRE, "agent");
            xb_add(&bar[XB_XGEN(b.x)], 1u);
            asm volatile("s_waitcnt vmcnt(0)" ::: "memory");
        } else {
            XB_SPIN(xb_ld(&bar[XB_XGEN(b.x)]) == gen, bar);
            __builtin_amdgcn_fence(__ATOMIC_ACQUIRE, "agent");
            asm volatile("s_waitcnt vmcnt(0)" ::: "memory");
        }
    }
    __syncthreads();
}

struct Args {
    const float* in[27]; float* out; unsigned char* ws; double rope_inv[16]; int ph_lo, ph_hi;
};
enum { I_X = 0, I_META, I_NMG, I_WIN, I_BGATE, I_QNG, I_WUQ, I_KVNG, I_WUKV, I_WAO, I_CONVW, I_CONVB, I_WRGA, I_BRGA, I_WRGX, I_BRGX, I_LAMBDA, I_WRO, I_WOUT, I_NFG, I_WROUTER, I_BROUTER, I_WUP, I_BUP, I_WDOWN, I_BDOWN, I_NFINAL };

struct TMap { const float* W; int ldw; bf16_t* WT; int ldt; int nblk; int mode; const float* ks; };
__device__ __forceinline__ int tmap_col(int mode, int np) {
    if (mode == 0) return np;
    if (mode == 1) return np < 672 ? np : (np < 768 ? -1 : np - 96);
    if (mode == 2) { const int h = np / 96, o = np - 96 * h; if (o < 64) return np; const int p = o - 64; return 96 * h + 64 + (p & 1) * 16 + (p >> 1); }
    const int pn = np >> 8, w = np & 255; return w < 128 ? 128 * pn + w : 1024 + 128 * pn + (w - 128);
}
__device__ __forceinline__ void transpose_item(const TMap& mp, LAS float* scr, int item, int lane) {
    const int kb = item / mp.nblk, nb = item % mp.nblk, k0 = 64 * kb, n0 = 32 * nb;
    const int sc = tmap_col(mp.mode, n0 + (lane & 31));
#pragma unroll 8
    for (int i = 0; i < 32; ++i) { const int kk = 2 * i + (lane >> 5);
        float v = sc >= 0 ? mp.W[(size_t)(k0 + kk) * mp.ldw + sc] : 0.f;
        if (mp.ks) v *= mp.ks[k0 + kk];
        scr[kk * 33 + (lane & 31)] = v; }
    asm volatile("s_waitcnt lgkmcnt(0)" ::: "memory");
    const int c = lane & 7;
#pragma unroll
    for (int j = 0; j < 4; ++j) { const int n = (lane >> 3) + 8 * j; const LAS float* s = scr + (8 * c) * 33 + n;
        u32x4 o; o.x = cvt_pk_bf16(s[0 * 33], s[1 * 33]); o.y = cvt_pk_bf16(s[2 * 33], s[3 * 33]); o.z = cvt_pk_bf16(s[4 * 33], s[5 * 33]); o.w = cvt_pk_bf16(s[6 * 33], s[7 * 33]);
        *(u32x4*)(mp.WT + (size_t)(n0 + n) * mp.ldt + k0 + 8 * c) = o; }
    asm volatile("s_waitcnt lgkmcnt(0)" ::: "memory");
}
__device__ __forceinline__ void transpose_item2(const TMap& mp, LAS unsigned* scr, int item, int lane) {
    const int nblk = mp.nblk >> 2;
    const int kb = item / nblk, nb = item % nblk, k0 = 32 * kb, n0 = 128 * nb;
    const int nl = 4 * (lane & 31), hw = lane >> 5;
    const int sc = tmap_col(mp.mode, n0 + nl);
#pragma unroll
    for (int i = 0; i < 8; ++i) { const int k = k0 + 4 * i + 2 * hw;
        f32x4 a = {0.f, 0.f, 0.f, 0.f}, b = {0.f, 0.f, 0.f, 0.f};
        if (sc >= 0) { a = __builtin_nontemporal_load((const f32x4*)(mp.W + (size_t)k * mp.ldw + sc)); b = __builtin_nontemporal_load((const f32x4*)(mp.W + (size_t)(k + 1) * mp.ldw + sc)); }
        if (mp.ks) { a *= mp.ks[k]; b *= mp.ks[k + 1]; }
        const int kp = 2 * i + hw;
        scr[(nl + 0) * 17 + kp] = cvt_pk_bf16(a.x, b.x); scr[(nl + 1) * 17 + kp] = cvt_pk_bf16(a.y, b.y);
        scr[(nl + 2) * 17 + kp] = cvt_pk_bf16(a.z, b.z); scr[(nl + 3) * 17 + kp] = cvt_pk_bf16(a.w, b.w); }
    asm volatile("s_waitcnt lgkmcnt(0)" ::: "memory");
    const int c = lane & 3;
#pragma unroll
    for (int j = 0; j < 8; ++j) { const int n = (lane >> 2) + 16 * j; const LAS unsigned* sp = scr + n * 17 + 4 * c;
        u32x4 o; o.x = sp[0]; o.y = sp[1]; o.z = sp[2]; o.w = sp[3];
        *(u32x4*)(mp.WT + (size_t)(n0 + n) * mp.ldt + k0 + 8 * c) = o; }
    asm volatile("s_waitcnt lgkmcnt(0)" ::: "memory");
}
__device__ __forceinline__ void transpose_item8(const TMap& mp, LAS unsigned* scr, int item, int lane) {
    const int nblk = mp.nblk >> 2;
    const int kb = item / nblk, nb = item % nblk, k0 = 64 * kb, n0 = 128 * nb;
    const int nl = 4 * (lane & 31), hw = lane >> 5;
    const int sc = tmap_col(mp.mode, n0 + nl);
#pragma unroll
    for (int i = 0; i < 8; ++i) { const int k = k0 + 8 * i + 4 * hw;
        f32x4 r[4];
#pragma unroll
        for (int q = 0; q < 4; ++q) { r[q] = *(const f32x4*)(mp.W + (size_t)(k + q) * mp.ldw + sc); r[q] *= (mp.ks ? mp.ks[k + q] : 1.f) * W8_SCALE; }
        const int kq = 2 * i + hw;
#pragma unroll
        for (int j = 0; j < 4; ++j) scr[(nl + j) * 17 + kq] = pack_fp8x4(r[0][j], r[1][j], r[2][j], r[3][j]); }
    asm volatile("s_waitcnt lgkmcnt(0)" ::: "memory");
    const int c = lane & 3;
    unsigned char* WT8 = (unsigned char*)mp.WT;
#pragma unroll
    for (int j = 0; j < 8; ++j) { const int n = (lane >> 2) + 16 * j; const LAS unsigned* sp = scr + n * 17 + 4 * c;
        u32x4 o; o.x = sp[0]; o.y = sp[1]; o.z = sp[2]; o.w = sp[3];
        *(u32x4*)(WT8 + (size_t)(n0 + n) * mp.ldt + k0 + 16 * c) = o; }
    asm volatile("s_waitcnt lgkmcnt(0)" ::: "memory");
}
__device__ __forceinline__ void xpose8_block(const float* W, int ldw, int mode, int n0, int k0, unsigned char* dst  , LAS unsigned char* lds, int wave, int lane) {
    LAS unsigned* tile = (LAS unsigned*)lds;
    int sc[4];
#pragma unroll
    for (int j = 0; j < 4; ++j) sc[j] = tmap_col(mode, n0 + 256 * j + 4 * lane);
    const unsigned xo = (unsigned)(lane & 15) << 1;
    f32x4 XA[4][4], XB[4][4];
#define X8_LOAD(X_, qd) do { _Pragma("unroll") for (int r = 0; r < 4; ++r) _Pragma("unroll") for (int j = 0; j < 4; ++j) \
        X_[r][j] = __builtin_nontemporal_load((const f32x4*)(W + (size_t)(k0 + 64 * ((qd) >> 1) + 8 * wave + 4 * ((qd) & 1) + r) * ldw + sc[j])); } while (0)
#define X8_CVT(X_, qd) do { const unsigned kd = (unsigned)(16 * ((qd) >> 1) + 2 * wave + ((qd) & 1)); _Pragma("unroll") for (int j = 0; j < 4; ++j) _Pragma("unroll") for (int c = 0; c < 4; ++c) \
        tile[(256 * j + 4 * lane + c) * 32 + (kd ^ xo)] = pack_fp8x4(X_[0][j][c] * W8_SCALE, X_[1][j][c] * W8_SCALE, X_[2][j][c] * W8_SCALE, X_[3][j][c] * W8_SCALE); } while (0)
    X8_LOAD(XA, 0); X8_LOAD(XB, 1); __builtin_amdgcn_sched_barrier(0);
    X8_CVT(XA, 0); __builtin_amdgcn_sched_barrier(0); X8_LOAD(XA, 2); __builtin_amdgcn_sched_barrier(0);
    X8_CVT(XB, 1); __builtin_amdgcn_sched_barrier(0); X8_LOAD(XB, 3); __builtin_amdgcn_sched_barrier(0);
    X8_CVT(XA, 2); __builtin_amdgcn_sched_barrier(0); X8_CVT(XB, 3);
#undef X8_LOAD
#undef X8_CVT
    __syncthreads();
    const int t = wave * 64 + lane;
#pragma unroll 4
    for (int i = 0; i < 16; ++i) { const int id = t + 512 * i, row = id >> 3, q = id & 7; const unsigned xr = (unsigned)((row >> 2) & 15) << 1;
        const u32x2 a = *(const LAS u32x2*)(tile + row * 32 + ((4u * q) ^ xr)), b = *(const LAS u32x2*)(tile + row * 32 + ((4u * q + 2u) ^ xr));
        u32x4 o; o.x = a.x; o.y = a.y; o.z = b.x; o.w = b.y;
        *(u32x4*)(dst + (size_t)row * 1024 + 16 * q) = o; }
    __syncthreads();
}
__device__ __forceinline__ void rms_row_to_bf16(const float* xrow, const float* gain, bf16_t* orow, int lane) {
    const f32x4* xr = (const f32x4*)xrow + lane; const f32x4* gr = (const f32x4*)gain + lane;
    f32x4 v[4]; float s = 0.f;
#pragma unroll
    for (int j = 0; j < 4; ++j) { v[j] = xr[64 * j]; s += (v[j].x * v[j].x + v[j].y * v[j].y) + (v[j].z * v[j].z + v[j].w * v[j].w); }
    const float rstd = 1.f / sqrtf(wave_sum(s) * (1.f / 1024.f) + EPS);
    u32x2* o8 = (u32x2*)orow + lane;
#pragma unroll
    for (int j = 0; j < 4; ++j) { const f32x4 g = gr[64 * j]; u32x2 w; w.x = cvt_pk_bf16(v[j].x * rstd * g.x, v[j].y * rstd * g.y); w.y = cvt_pk_bf16(v[j].z * rstd * g.z, v[j].w * rstd * g.w); o8[64 * j] = w; }
}

__device__ __forceinline__ void build_moe_table(volatile LAS int* tbl, const unsigned* gcnt, const int wid) {
    const int t_ = wid * 64 + lane_id_v();
    __syncthreads();
    if (t_ < 32) tbl[LT_TS + 40 + t_] = (int)__hip_atomic_load(gcnt + t_, __ATOMIC_RELAXED, __HIP_MEMORY_SCOPE_AGENT);
    __syncthreads();
    if (t_ == 0) { int acc = 0; for (int e = 0; e < 32; ++e) { tbl[LT_TS + e] = acc; acc += (tbl[LT_TS + 40 + e] + 255) >> 8; } tbl[LT_TS + 32] = acc; }
    __syncthreads();
}

__device__ __forceinline__ att::BlockRef att_mkref(int item, int pass, bf16_t* QB, bf16_t* KN, bf16_t* KPE, bf16_t* VB, bf16_t* OB) {
    const int bh = item >> 4, x = item & 15, qb = pass ? 31 - x : x, b = bh >> 3, h = bh & 7;
    att::BlockRef r; r.Q = QB + ((size_t)b * 8192 + (size_t)qb * 256) * 768 + h * 96; r.KN = KN + (size_t)b * TP * 512 + h * 64; r.KPE = KPE + (size_t)b * TP * 32;
    r.V = VB + (size_t)b * TP * 512 + h * 64; r.O = OB + ((size_t)b * 8192 + (size_t)qb * 256) * 512 + h * 64; r.P0 = MBLK + 256 * qb; return r;
}
__device__ __forceinline__ void lru_step8(const h16x8 r, const h16x8 u, const float (&kc)[8], float (&h)[8], float (&A)[8]) {
#pragma unroll
    for (int j = 0; j < 8; ++j) { const float a = __builtin_amdgcn_exp2f((float)r[j] * kc[j]); const float b = __builtin_amdgcn_sqrtf(fmaxf(1.f - a * a, 0.f)) * (float)u[j]; h[j] = a * h[j] + b; A[j] *= a; }
}
__device__ __forceinline__ void lru_kc8(const float* lam, int ch, float (&kc)[8]) {
    const f32x4 l0 = *(const f32x4*)(lam + ch), l1 = *(const f32x4*)(lam + ch + 4); const float l[8] = {l0.x, l0.y, l0.z, l0.w, l1.x, l1.y, l1.z, l1.w};
#pragma unroll
    for (int j = 0; j < 8; ++j) { const float x = -l[j]; const float sp = x > 15.f ? x : log1pf(expf(x)); kc[j] = -8.f * sp * 1.4426950408889634f; }
}
__global__ void __launch_bounds__(NWAVES * 64, 2) mk_fwd(Args args) {
    extern __shared__ __attribute__((aligned(16))) unsigned char lds_raw[];
    LAS unsigned char* lds = (LAS unsigned char*)lds_raw;
    volatile LAS unsigned* MISC = (volatile LAS unsigned*)(lds + MISC_OFF);
    volatile LAS int* TBL = (volatile LAS int*)(lds + MISC_OFF);
    const int wave = __builtin_amdgcn_readfirstlane((int)threadIdx.x >> 6);
    const int G = gridDim.x; const int bx = blockIdx.x; const int vcu = (G % 8 == 0) ? (bx % 8) * (G / 8) + bx / 8 : bx;
    unsigned char* ws = args.ws;
    unsigned* ctl = (unsigned*)(ws + WS_CTL);
    for (int u = (int)threadIdx.x; u < (LDS_BYTES - LDSCTL_OFF) / 4; u += NWAVES * 64) ((LAS unsigned*)(lds + LDSCTL_OFF))[u] = 0u;
    __syncthreads();
    XcdBarrier bar; bar.bar = ctl + CW_BAR; bar.x = 0; bar.st = nullptr; bar.wid = wave;
    if (MK_N_LAUNCHES == 1) bar = xcd_barrier_post(ctl + CW_BAR, MISC, wave);
    const int lo = args.ph_lo, hi = args.ph_hi;
#define IN(k) (lo <= (k) && (k) < hi)
#define SEAM(k) do { if (IN(k) && IN((k) + 1)) xcd_barrier(bar); } while (0)
    bf16_t* WIN = (bf16_t*)(ws + WS_WIN); bf16_t* WUQ = (bf16_t*)(ws + WS_WUQ); bf16_t* WUKV = (bf16_t*)(ws + WS_WUKV); bf16_t* WG = (bf16_t*)(ws + WS_WG);
    bf16_t* WAO = (bf16_t*)(ws + WS_WAO); bf16_t* WRO = (bf16_t*)(ws + WS_WRO); bf16_t* WOUT = (bf16_t*)(ws + WS_WOUT); unsigned char* WUP8 = ws + WS_WUP; unsigned char* WDN8 = ws + WS_WDN;
    float* WRP = (float*)(ws + WS_WRP);
    bf16_t* XN = (bf16_t*)(ws + WS_XN); bf16_t* XC = (bf16_t*)(ws + WS_XC); bf16_t* MA = (bf16_t*)(ws + WS_MA);
    bf16_t* PQ = (bf16_t*)(ws + WS_PQ); bf16_t* PRX = (bf16_t*)(ws + WS_PRX); bf16_t* GRG = (bf16_t*)(ws + WS_GRG); bf16_t* GATE = (bf16_t*)(ws + WS_GATE);
    bf16_t* CQ = (bf16_t*)(ws + WS_CQ); bf16_t* CKV = (bf16_t*)(ws + WS_CKV); bf16_t* KPE = (bf16_t*)(ws + WS_KPE);
    float* COS = (float*)(ws + WS_ROPE); float* SIN = COS + TPOS * 16;
    bf16_t* QB = (bf16_t*)(ws + WS_Q); bf16_t* KN = (bf16_t*)(ws + WS_KN); bf16_t* VB = (bf16_t*)(ws + WS_V); bf16_t* OB = (bf16_t*)(ws + WS_O);
    _Float16* R16 = (_Float16*)(ws + WS_R16); _Float16* U16 = (_Float16*)(ws + WS_U16);
    float* AGF = (float*)(ws + WS_AGF); float* AGC = (float*)(ws + WS_AGC);
    bf16_t* YB = (bf16_t*)(ws + WS_Y); bf16_t* MG = (bf16_t*)(ws + WS_MG);
    bf16_t* H2 = (bf16_t*)(ws + WS_H2); unsigned char* H8 = ws + WS_HB;
    int* ELIST = (int*)(ws + WS_ELIST); float* RSTDS = (float*)(ws + WS_RSTDS); float* GATES = (float*)(ws + WS_GATES); int* TOKSL = (int*)(ws + WS_TOKSL);
    unsigned char* ACT = ws + WS_ACT; unsigned char* YE = ws + WS_YE;
    unsigned* GCNT = ctl + CW_CNT;
    const int gw = vcu * NWAVES + wave, NGW = G * NWAVES;
    const int NGT = G * NWAVES * 64;
#define PHASE_IDS() const int lane = lane_id_v(); const int tid = wave * 64 + lane; const int gt = vcu * (NWAVES * 64) + tid; (void)gt; (void)tid; (void)lane

    auto convert_tile = [&](const int it) {
        const int lane = lane_id_v();
        {
            if (it < 512) { const int e = it >> 4, kb = (it >> 1) & 7, nb = it & 1;
                xpose8_block(args.in[I_WUP] + (size_t)e * 1024 * 2048, 2048, 3, 1024 * nb, 128 * kb, WUP8 + (size_t)e * 2048 * 1024 + (size_t)(1024 * nb) * 1024 + 128 * kb, lds, wave, lane); }
            else { const int q = it - 512, e = q >> 3, kb = q & 7;
                xpose8_block(args.in[I_WDOWN] + (size_t)e * 1024 * 1024, 1024, 0, 0, 128 * kb, WDN8 + (size_t)e * 1024 * 1024 + 128 * kb, lds, wave, lane); }
        }
    };
    if (IN(0)) for (int rep_ = 0; rep_ < REP_P0; ++rep_) {
        if (rep_) xcd_barrier(bar);
        PHASE_IDS();
        LAS float* scr = (LAS float*)(lds + wave * 16384);
        {
            constexpr int I_1 = 32 * 38, I_3 = 8 * 8, I_4 = 16 * 8, I_5 = 32 * 8, I_6 = 32 * 8;
            constexpr int NITEMS = I_1 + I_3 + I_4 + I_5 + I_6;
            for (int it = gw; it < NITEMS; it += NGW) {
                int r = it; TMap mp;
                if (r < I_1) { mp = TMap{args.in[I_WIN], 4768, WIN, 1024, 152, 1, nullptr}; }
                else if ((r -= I_1) < I_3) { mp = TMap{args.in[I_WUKV], 1024, WUKV, 256, 32, 0, nullptr}; }
                else if ((r -= I_3) < I_4) { mp = TMap{args.in[I_WAO], 1024, WAO, 512, 32, 0, nullptr}; }
                else if ((r -= I_4) < I_5) { mp = TMap{args.in[I_WRO], 1024, WRO, 1024, 32, 0, nullptr}; }
                else { r -= I_5; mp = TMap{args.in[I_WOUT], 1024, WOUT, 1024, 32, 0, nullptr}; }
                transpose_item2(mp, (LAS unsigned*)scr, r, lane);
            }
            { const TMap mq = TMap{args.in[I_WUQ], 768, WUQ, 384, 24, 2, nullptr};
              for (int it = gw; it < 6 * 24; it += NGW) transpose_item(mq, scr, it, lane); }
        }
        __syncthreads();
        for (int idx = gt; idx < 8 * 256 * 256; idx += NGT) { const int b = idx >> 16, np = (idx >> 8) & 255, kp = idx & 255;
            float v = 0.f; if ((kp >> 7) == (b & 1)) { const int i = kp & 127; v = np < 128 ? args.in[I_WRGA][(b * 128 + i) * 128 + np] : args.in[I_WRGX][(b * 128 + i) * 128 + (np - 128)]; }
            WG[idx] = (bf16_t)(cvt_pk_bf16(v, 0.f) & 0xffffu); }
        for (int idx = gt; idx < 32768; idx += NGT) { const int k = idx >> 5, e = idx & 31; const float w = args.in[I_NFG][k] * args.in[I_WROUTER][k * 32 + e];
            const unsigned hb = cvt_pk_bf16(w, 0.f) & 0xffffu; const float hf = __uint_as_float(hb << 16); const unsigned lb = cvt_pk_bf16(w - hf, 0.f) & 0xffffu;
            const int pos = ((((k >> 5) * 2 + (e >> 4)) * 2) * 64 + ((((k >> 3) & 3) << 4) | (e & 15))) * 8 + (k & 7);
            ((unsigned short*)WRP)[pos] = (unsigned short)hb; ((unsigned short*)WRP)[pos + 512] = (unsigned short)lb; }
        for (int idx = gt; idx < TPOS * 16; idx += NGT) { const int t = idx >> 4, i = idx & 15; const double ang = (double)t * args.rope_inv[i] * 0.15915494309189535; const float rev = (float)(ang - floor(ang));
            COS[idx] = __builtin_amdgcn_cosf(rev); SIN[idx] = __builtin_amdgcn_sinf(rev); }
        { const f32x4* gr = (const f32x4*)args.in[I_NMG] + lane; f32x4 gn4[4];
#pragma unroll
          for (int j = 0; j < 4; ++j) gn4[j] = gr[64 * j];
          for (int m4 = gw * 4; m4 < RROWS; m4 += NGW * 4) {
              const int i4 = (m4 - NX) & 63;
              if (m4 >= NX && i4 >= NMETA) { const u32x2 z = {0u, 0u};
#pragma unroll
                  for (int r = 0; r < 4; ++r) { u32x2* o8 = (u32x2*)(XN + (size_t)(m4 + r) * 1024) + lane;
#pragma unroll
                      for (int j = 0; j < 4; ++j) o8[64 * j] = z; }
                  continue; }
              const float* src = m4 < NX ? args.in[I_X] + (size_t)m4 * 1024 : args.in[I_META] + (size_t)i4 * 1024;
              f32x4 v[4][4]; float ss[4];
#pragma unroll
              for (int r = 0; r < 4; ++r) { const f32x4* xr = (const f32x4*)(src + (size_t)r * 1024) + lane;
#pragma unroll
                  for (int j = 0; j < 4; ++j) v[r][j] = __builtin_nontemporal_load(xr + 64 * j); }
#pragma unroll
              for (int r = 0; r < 4; ++r) { float a = 0.f;
#pragma unroll
                  for (int j = 0; j < 4; ++j) a += (v[r][j].x * v[r][j].x + v[r][j].y * v[r][j].y) + (v[r][j].z * v[r][j].z + v[r][j].w * v[r][j].w);
                  ss[r] = a; }
#pragma unroll
              for (int o = 1; o < 64; o <<= 1) {
#pragma unroll
                  for (int r = 0; r < 4; ++r) ss[r] += __shfl_xor(ss[r], o); }
#pragma unroll
              for (int r = 0; r < 4; ++r) { const float rstd = 1.f / sqrtf(ss[r] * (1.f / 1024.f) + EPS); u32x2* o8 = (u32x2*)(XN + (size_t)(m4 + r) * 1024) + lane;
#pragma unroll
                  for (int j = 0; j < 4; ++j) { const f32x4 g = gn4[j]; u32x2 w; w.x = cvt_pk_bf16(v[r][j].x * rstd * g.x, v[r][j].y * rstd * g.y); w.y = cvt_pk_bf16(v[r][j].z * rstd * g.z, v[r][j].w * rstd * g.w); o8[64 * j] = w; } }
          }
        }
    }
    SEAM(0);
    if (IN(1)) {
        g8::PPlain g{XN, WIN, 2048u, 2048u, 16}; g8::StaticOrder S; S.init(RROWS, NPROJ, G, bx);
        g8::EpiProj E{PQ, PRX, GRG, GATE, args.in[I_BGATE]};
        for (int rep_ = 0; rep_ < REP_P1; ++rep_) { if (rep_) xcd_barrier(bar); g8::gemm_phase(lds, wave, g, S, E); }
    }
    SEAM(1);
    if (IN(2)) for (int rep_ = 0; rep_ < REP_P2; ++rep_) {
        if (rep_) xcd_barrier(bar);
        PHASE_IDS();
        const float* gq = args.in[I_QNG]; const float* gkv = args.in[I_KVNG];
        {
            const int l16 = lane & 15, rsub = lane >> 4;
            f32x4 gqv[3][2], gkvv[2][2];
#pragma unroll
            for (int j = 0; j < 3; ++j) { gqv[j][0] = *(const f32x4*)(gq + 8 * (l16 + 16 * j)); gqv[j][1] = *(const f32x4*)(gq + 8 * (l16 + 16 * j) + 4); }
#pragma unroll
            for (int j = 0; j < 2; ++j) { gkvv[j][0] = *(const f32x4*)(gkv + 8 * (l16 + 16 * j)); gkvv[j][1] = *(const f32x4*)(gkv + 8 * (l16 + 16 * j) + 4); }
            for (int gi = gw; gi < RROWS / 4; gi += NGW) {
                const int m = 4 * gi + rsub; const bf16_t* prow = PQ + (size_t)m * 768;
                u32x4 wq[3], wk[2];
#pragma unroll
                for (int j = 0; j < 3; ++j) wq[j] = *(const u32x4*)(prow + 8 * (l16 + 16 * j));
#pragma unroll
                for (int j = 0; j < 2; ++j) wk[j] = *(const u32x4*)(prow + 384 + 8 * (l16 + 16 * j));
                const float x1 = __uint_as_float((unsigned)prow[640 + l16] << 16), x2 = __uint_as_float((unsigned)prow[656 + l16] << 16);
                const int t = pos_of(m);
                const float cs = COS[t * 16 + l16], sn = SIN[t * 16 + l16];
                float sq = 0.f, sk = 0.f;
#pragma unroll
                for (int j = 0; j < 3; ++j) { const u32x4 w = wq[j]; sq += bf_lo(w.x) * bf_lo(w.x) + bf_hi(w.x) * bf_hi(w.x) + bf_lo(w.y) * bf_lo(w.y) + bf_hi(w.y) * bf_hi(w.y) + bf_lo(w.z) * bf_lo(w.z) + bf_hi(w.z) * bf_hi(w.z) + bf_lo(w.w) * bf_lo(w.w) + bf_hi(w.w) * bf_hi(w.w); }
#pragma unroll
                for (int j = 0; j < 2; ++j) { const u32x4 w = wk[j]; sk += bf_lo(w.x) * bf_lo(w.x) + bf_hi(w.x) * bf_hi(w.x) + bf_lo(w.y) * bf_lo(w.y) + bf_hi(w.y) * bf_hi(w.y) + bf_lo(w.z) * bf_lo(w.z) + bf_hi(w.z) * bf_hi(w.z) + bf_lo(w.w) * bf_lo(w.w) + bf_hi(w.w) * bf_hi(w.w); }
#pragma unroll
                for (int o = 1; o < 16; o <<= 1) { sq += __shfl_xor(sq, o); sk += __shfl_xor(sk, o); }
                const float rq = 1.f / sqrtf(sq * (1.f / 384.f) + EPS), rk = 1.f / sqrtf(sk * (1.f / 256.f) + EPS);
                if (m < NX) {
#pragma unroll
                    for (int j = 0; j < 3; ++j) { const u32x4 w = wq[j]; const f32x4 g0 = gqv[j][0], g1 = gqv[j][1]; u32x4 o;
                        o.x = cvt_pk_bf16(bf_lo(w.x) * rq * g0.x, bf_hi(w.x) * rq * g0.y); o.y = cvt_pk_bf16(bf_lo(w.y) * rq * g0.z, bf_hi(w.y) * rq * g0.w);
                        o.z = cvt_pk_bf16(bf_lo(w.z) * rq * g1.x, bf_hi(w.z) * rq * g1.y); o.w = cvt_pk_bf16(bf_lo(w.w) * rq * g1.z, bf_hi(w.w) * rq * g1.w);
                        *(u32x4*)(CQ + (size_t)m * 384 + 8 * (l16 + 16 * j)) = o; } }
#pragma unroll
                for (int j = 0; j < 2; ++j) { const u32x4 w = wk[j]; const f32x4 g0 = gkvv[j][0], g1 = gkvv[j][1]; u32x4 o;
                    o.x = cvt_pk_bf16(bf_lo(w.x) * rk * g0.x, bf_hi(w.x) * rk * g0.y); o.y = cvt_pk_bf16(bf_lo(w.y) * rk * g0.z, bf_hi(w.y) * rk * g0.w);
                    o.z = cvt_pk_bf16(bf_lo(w.z) * rk * g1.x, bf_hi(w.z) * rk * g1.y); o.w = cvt_pk_bf16(bf_lo(w.w) * rk * g1.z, bf_hi(w.w) * rk * g1.w);
                    *(u32x4*)(CKV + (size_t)m * 256 + 8 * (l16 + 16 * j)) = o; }
                *(unsigned*)(KPE + (size_t)kvrow_of(m) * 32 + 2 * l16) = cvt_pk_bf16(x1 * cs - x2 * sn, x1 * sn + x2 * cs);
            }
        }
        { const int rg = tid >> 7, ch = (tid & 127) * 8;
          float cw[4][8], cb[8];
#pragma unroll
          for (int k = 0; k < 4; ++k) { const f32x4 a = *(const f32x4*)(args.in[I_CONVW] + k * 1024 + ch), b = *(const f32x4*)(args.in[I_CONVW] + k * 1024 + ch + 4);
              cw[k][0] = a.x; cw[k][1] = a.y; cw[k][2] = a.z; cw[k][3] = a.w; cw[k][4] = b.x; cw[k][5] = b.y; cw[k][6] = b.z; cw[k][7] = b.w; }
          { const f32x4 a = *(const f32x4*)(args.in[I_CONVB] + ch), b = *(const f32x4*)(args.in[I_CONVB] + ch + 4); cb[0] = a.x; cb[1] = a.y; cb[2] = a.z; cb[3] = a.w; cb[4] = b.x; cb[5] = b.y; cb[6] = b.z; cb[7] = b.w; }
          for (int it = vcu; it < BATCH * 129; it += G) {
              const int b = it / 129, c = it % 129;
              if (c == 0 && rg > 0) continue;
              const int q0 = c == 0 ? 0 : NMETA + 64 * (c - 1) + 16 * rg;
              float w0[8], w1[8], w2[8];
#pragma unroll
              for (int j = 0; j < 8; ++j) { w0[j] = 0.f; w1[j] = 0.f; w2[j] = 0.f; }
#define SEQROW(q) ((q) < NMETA ? NX + 64 * b + (q) : b * 8192 + (q) - NMETA)
#define LDROW(dst, q) do { const u32x4 w_ = *(const u32x4*)(PRX + (size_t)SEQROW(q) * 1024 + ch); dst[0] = bf_lo(w_.x); dst[1] = bf_hi(w_.x); dst[2] = bf_lo(w_.y); dst[3] = bf_hi(w_.y); dst[4] = bf_lo(w_.z); dst[5] = bf_hi(w_.z); dst[6] = bf_lo(w_.w); dst[7] = bf_hi(w_.w); } while (0)
              if (q0 >= 3) { LDROW(w0, q0 - 3); LDROW(w1, q0 - 2); LDROW(w2, q0 - 1); }
              for (int i = 0; i < 16; ++i) { const int q = q0 + i; float cur[8]; LDROW(cur, q);
                  float o[8];
#pragma unroll
                  for (int j = 0; j < 8; ++j) o[j] = cb[j] + cw[0][j] * w0[j] + cw[1][j] * w1[j] + cw[2][j] * w2[j] + cw[3][j] * cur[j];
                  u32x4 ow; ow.x = cvt_pk_bf16(o[0], o[1]); ow.y = cvt_pk_bf16(o[2], o[3]); ow.z = cvt_pk_bf16(o[4], o[5]); ow.w = cvt_pk_bf16(o[6], o[7]);
                  *(u32x4*)(XC + (size_t)SEQROW(q) * 1024 + ch) = ow;
#pragma unroll
                  for (int j = 0; j < 8; ++j) { w0[j] = w1[j]; w1[j] = w2[j]; w2[j] = cur[j]; } }
#undef LDROW
          }
          for (int idx = gt; idx < BATCH * 48 * 128; idx += NGT) { const int b = idx / (48 * 128), r = (idx / 128) % 48, c8 = (idx & 127) * 8; u32x4 z = {0u, 0u, 0u, 0u}; *(u32x4*)(XC + (size_t)(NX + 64 * b + 16 + r) * 1024 + c8) = z; }
        }
    }
    SEAM(2);
    if (IN(3)) for (int rep_ = 0; rep_ < REP_P3; ++rep_) {
        if (rep_) xcd_barrier(bar);
        { g8::PPlain g{CQ, WUQ, 768u, 768u, 6}; g8::StaticOrder S; S.init(NX, 768, G, bx); g8::EpiQ E{QB, COS, SIN}; g8::gemm_phase(lds, wave, g, S, E); }
        { g8::PPlain g{CKV, WUKV, 512u, 512u, 4}; g8::StaticOrder S; S.init(RROWS, 1024, G, (bx + 128) % G); g8::EpiKV E{KN, VB}; g8::gemm_phase(lds, wave, g, S, E); }
        { g8::PGates g{XC, WG, 2048u, 512u, 4}; g8::StaticOrder S; S.init(RROWS, 2048, G, (bx + 136) % G); g8::EpiGates E{XC, args.in[I_BRGA], args.in[I_BRGX], R16, U16}; g8::gemm_phase(lds, wave, g, S, E); }
    }
    SEAM(3);
    if (IN(4)) for (int rep_ = 0; rep_ < REP_P4; ++rep_) {
        if (rep_) xcd_barrier(bar);
        PHASE_IDS();
        const int slot = tid >> 7, t7 = tid & 127, ch = t7 * 8;
        float kc[8]; lru_kc8(args.in[I_LAMBDA], ch, kc);
        LAS float* red = (LAS float*)lds;
        for (int it = vcu; it < BATCH * 64; it += G) {
            const int b = it >> 6, sc = it & 63, c = 4 * sc + slot;
            float h[8], A[8];
#pragma unroll
            for (int j = 0; j < 8; ++j) { h[j] = 0.f; A[j] = 1.f; }
            if (c == 0) {
#pragma unroll 4
                for (int i = 0; i < NMETA; ++i) { const size_t o = (size_t)(NX + 64 * b + i) * 1024 + ch; lru_step8(*(const h16x8*)(R16 + o), *(const h16x8*)(U16 + o), kc, h, A); } }
#pragma unroll 4
            for (int i = 0; i < 32; ++i) { const size_t o = (size_t)(b * 8192 + 32 * c + i) * 1024 + ch; lru_step8(*(const h16x8*)(R16 + o), *(const h16x8*)(U16 + o), kc, h, A); }
            float* fa = AGF + ((size_t)(b * 256 + c) * 2) * 1024 + ch;
            *(f32x4*)fa = (f32x4){A[0], A[1], A[2], A[3]}; *(f32x4*)(fa + 4) = (f32x4){A[4], A[5], A[6], A[7]};
            *(f32x4*)(fa + 1024) = (f32x4){h[0], h[1], h[2], h[3]}; *(f32x4*)(fa + 1028) = (f32x4){h[4], h[5], h[6], h[7]};
#pragma unroll
            for (int j = 0; j < 8; ++j) { red[(slot * 16 + j) * 128 + t7] = A[j]; red[(slot * 16 + 8 + j) * 128 + t7] = h[j]; }
            __syncthreads();
            if (slot == 0) { float At[8], Ht[8];
#pragma unroll
                for (int j = 0; j < 8; ++j) { At[j] = 1.f; Ht[j] = 0.f; }
#pragma unroll
                for (int q = 0; q < 4; ++q)
#pragma unroll
                    for (int j = 0; j < 8; ++j) { const float a = red[(q * 16 + j) * 128 + t7], hh = red[(q * 16 + 8 + j) * 128 + t7]; Ht[j] = a * Ht[j] + hh; At[j] *= a; }
                float* ca = AGC + ((size_t)(b * 64 + sc) * 2) * 1024 + ch;
                *(f32x4*)ca = (f32x4){At[0], At[1], At[2], At[3]}; *(f32x4*)(ca + 4) = (f32x4){At[4], At[5], At[6], At[7]};
                *(f32x4*)(ca + 1024) = (f32x4){Ht[0], Ht[1], Ht[2], Ht[3]}; *(f32x4*)(ca + 1028) = (f32x4){Ht[4], Ht[5], Ht[6], Ht[7]}; }
            __syncthreads();
        }
    }
    if (IN(4) && IN(5)) xcd_barrier(bar);
    if (IN(5)) {
        PHASE_IDS();
        {
            const int slot = tid >> 7, t7 = tid & 127, ch = t7 * 8;
            float kc[8]; lru_kc8(args.in[I_LAMBDA], ch, kc);
            for (int it = vcu; it < BATCH * 64; it += G) {
                const int b = it >> 6, sc = it & 63, c = 4 * sc + slot;
                float h[8], A[8];
#pragma unroll
                for (int j = 0; j < 8; ++j) { h[j] = 0.f; A[j] = 1.f; }
                { float Ac[8], Hc[8];
#pragma unroll
                  for (int j = 0; j < 8; ++j) { Ac[j] = 1.f; Hc[j] = 0.f; }
                  const int q1 = sc < 16 * slot + 16 ? sc : 16 * slot + 16;
#pragma unroll 4
                  for (int q = 16 * slot; q < q1; ++q) { const float* ca = AGC + ((size_t)(b * 64 + q) * 2) * 1024 + ch;
                      const f32x4 a0 = *(const f32x4*)ca, a1 = *(const f32x4*)(ca + 4), h0 = *(const f32x4*)(ca + 1024), h1 = *(const f32x4*)(ca + 1028);
                      const float av[8] = {a0.x, a0.y, a0.z, a0.w, a1.x, a1.y, a1.z, a1.w}, hv[8] = {h0.x, h0.y, h0.z, h0.w, h1.x, h1.y, h1.z, h1.w};
#pragma unroll
                      for (int j = 0; j < 8; ++j) { Hc[j] = av[j] * Hc[j] + hv[j]; Ac[j] *= av[j]; } }
                  LAS float* red = (LAS float*)lds;
                  __syncthreads();
#pragma unroll
                  for (int j = 0; j < 8; ++j) { red[(slot * 16 + j) * 128 + t7] = Ac[j]; red[(slot * 16 + 8 + j) * 128 + t7] = Hc[j]; }
                  __syncthreads();
#pragma unroll
                  for (int q = 0; q < 4; ++q)
#pragma unroll
                      for (int j = 0; j < 8; ++j) h[j] = red[(q * 16 + j) * 128 + t7] * h[j] + red[(q * 16 + 8 + j) * 128 + t7]; }
                for (int q = 0; q < slot; ++q) { const float* fa = AGF + ((size_t)(b * 256 + 4 * sc + q) * 2) * 1024 + ch;
                    const f32x4 a0 = *(const f32x4*)fa, a1 = *(const f32x4*)(fa + 4), h0 = *(const f32x4*)(fa + 1024), h1 = *(const f32x4*)(fa + 1028);
                    h[0] = a0.x * h[0] + h0.x; h[1] = a0.y * h[1] + h0.y; h[2] = a0.z * h[2] + h0.z; h[3] = a0.w * h[3] + h0.w;
                    h[4] = a1.x * h[4] + h1.x; h[5] = a1.y * h[5] + h1.y; h[6] = a1.z * h[6] + h1.z; h[7] = a1.w * h[7] + h1.w; }
                if (c == 0) {
#pragma unroll 4
                    for (int i = 0; i < NMETA; ++i) { const size_t o = (size_t)(NX + 64 * b + i) * 1024 + ch; lru_step8(*(const h16x8*)(R16 + o), *(const h16x8*)(U16 + o), kc, h, A); } }
#pragma unroll 4
                for (int i = 0; i < 32; ++i) { const size_t o = (size_t)(b * 8192 + 32 * c + i) * 1024 + ch;
                    lru_step8(__builtin_nontemporal_load((const h16x8*)(R16 + o)), __builtin_nontemporal_load((const h16x8*)(U16 + o)), kc, h, A);
                    const u32x4 gq = __builtin_nontemporal_load((const u32x4*)(GRG + o));
                    u32x4 yw; yw.x = cvt_pk_bf16(h[0] * bf_lo(gq.x), h[1] * bf_hi(gq.x)); yw.y = cvt_pk_bf16(h[2] * bf_lo(gq.y), h[3] * bf_hi(gq.y));
                    yw.z = cvt_pk_bf16(h[4] * bf_lo(gq.z), h[5] * bf_hi(gq.z)); yw.w = cvt_pk_bf16(h[6] * bf_lo(gq.w), h[7] * bf_hi(gq.w));
                    *(u32x4*)(YB + o) = yw; }
            }
        }
    }
    if (IN(5)) __syncthreads();
    int ctile = vcu;
    if (IN(5)) for (int rep_ = 0; rep_ < REP_P5; ++rep_) {
        if (rep_) xcd_barrier(bar);
        att::Seam S;
        const int nitems = BATCH * 8 * 16;
        int it = vcu;
        if (it < nitems) {
#define mkref(item_, pass_) att_mkref((item_), (pass_), QB, KN, KPE, VB, OB)
            int pass = 0; att::BlockRef cur = mkref(it, 0);
            att::attn_prime(cur, (char*)lds_raw, S, wave);
            for (;;) {
                const bool more_pass = pass == 0, more_item = it + G < nitems, last = !more_pass && !more_item;
                int itn = it, passn = 1; if (!more_pass) { passn = 0; itn = more_item ? it + G : it; }
                const att::BlockRef nxt = last ? cur : mkref(itn, passn);
                att::attn_block(cur, nxt, (char*)lds_raw, S, wave);
                if (last) break;
                cur = nxt; it = itn; pass = passn;
                if (ctile < 768 && pass == 1) { __syncthreads(); convert_tile(ctile); ctile += G; if (ctile < 768 && it == vcu) { __syncthreads(); convert_tile(ctile); ctile += G; } __syncthreads(); att::attn_prime(cur, (char*)lds_raw, S, wave); }
            }
        }
    }
#undef mkref
    if (IN(5)) { __syncthreads(); for (; ctile < 768; ctile += G) convert_tile(ctile); }
    SEAM(5);
    if (IN(6)) for (int rep_ = 0; rep_ < REP_P6; ++rep_) {
        if (rep_) xcd_barrier(bar);
        { g8::PPlain g{OB, WAO, 1024u, 1024u, 8}; g8::StaticOrder S; S.init(NX, 1024, G, bx); g8::EpiAo E{GATE, MA}; g8::gemm_phase(lds, wave, g, S, E); }
    }
    if (IN(6) && IN(7)) { asm volatile("s_waitcnt vmcnt(0)" ::: "memory"); __syncthreads(); }
    if (IN(7)) for (int rep_ = 0; rep_ < REP_P7; ++rep_) {
        if (rep_) xcd_barrier(bar);
        g8::PPlain g{YB, WRO, 2048u, 2048u, 16}; g8::StaticOrder S; S.init(NX, 1024, G, bx); g8::EpiRo E{GATE, MA, MG}; g8::gemm_phase(lds, wave, g, S, E);
    }
    SEAM(7);
    if (IN(8)) for (int rep_ = 0; rep_ < REP_P8; ++rep_) {
        if (rep_) xcd_barrier(bar);
        g8::PPlain g{MG, WOUT, 2048u, 2048u, 16}; g8::StaticOrder S; S.init(NX, 1024, G, bx); g8::EpiOut E{args.in[I_X], H2, H8, args.in[I_NFG]}; g8::gemm_phase(lds, wave, g, S, E);
    }
    SEAM(8);
    if (IN(9)) {
        PHASE_IDS();
        const int j16 = lane & 15, kq = lane >> 4;
        const int ngroups = NX / 16, per_round = G * NWAVES, nrounds = (ngroups + per_round - 1) / per_round;
        volatile LAS int* lcnt = TBL + LT_LCNT; volatile LAS int* lbase = TBL + LT_LBASE;
        for (int rd = 0; rd < nrounds; ++rd) {
            if (tid < 32) lcnt[tid] = 0;
            __syncthreads();
            const int gi = rd * per_round + vcu * NWAVES + wave; const bool active = gi < ngroups;
            int tok = 0; float rstd = 0.f; float tv[4] = {0.f, 0.f, 0.f, 0.f}; int ti[4] = {0, 0, 0, 0}; int sl[4] = {0, 0, 0, 0};
            if (active) {
                tok = gi * 16 + j16;
                const bf16_t* hrow = H2 + (size_t)tok * 1024 + kq * 8;
                const bf16_t* wh = (const bf16_t*)WRP + lane * 8;
                f32x4 acc0 = {0.f, 0.f, 0.f, 0.f}, acc1 = {0.f, 0.f, 0.f, 0.f}; float ss = 0.f;
#pragma unroll 4
                for (int c = 0; c < 32; ++c) {
                    const bf16x8 hv = *(const bf16x8*)(hrow + c * 32);
                    const bf16x8 a0h = *(const bf16x8*)(wh + c * 2048), a0l = *(const bf16x8*)(wh + c * 2048 + 512), a1h = *(const bf16x8*)(wh + c * 2048 + 1024), a1l = *(const bf16x8*)(wh + c * 2048 + 1536);
                    { const u32x4 hw_ = __builtin_bit_cast(u32x4, hv);
#pragma unroll
                      for (int q = 0; q < 4; ++q) { const float x0 = bf_lo(hw_[q]), x1 = bf_hi(hw_[q]); ss += x0 * x0; ss += x1 * x1; } }
                    acc0 = __builtin_amdgcn_mfma_f32_16x16x32_bf16(a0h, hv, acc0, 0, 0, 0); acc1 = __builtin_amdgcn_mfma_f32_16x16x32_bf16(a1h, hv, acc1, 0, 0, 0);
                    acc0 = __builtin_amdgcn_mfma_f32_16x16x32_bf16(a0l, hv, acc0, 0, 0, 0); acc1 = __builtin_amdgcn_mfma_f32_16x16x32_bf16(a1l, hv, acc1, 0, 0, 0);
                }
                ss += __shfl_xor(ss, 16); ss += __shfl_xor(ss, 32);
                rstd = 1.f / sqrtf(ss * (1.f / 1024.f) + EPS);
                float cv[8]; int ci[8];
                const f32x4 b0 = *(const f32x4*)(args.in[I_BROUTER] + 4 * kq), b1 = *(const f32x4*)(args.in[I_BROUTER] + 16 + 4 * kq);
#pragma unroll
                for (int r = 0; r < 4; ++r) { cv[r] = acc0[r] * rstd + b0[r]; ci[r] = 4 * kq + r; cv[4 + r] = acc1[r] * rstd + b1[r]; ci[4 + r] = 16 + 4 * kq + r; }
                const float NEG = -__builtin_inff();
#define TOP4_OF8() do { _Pragma("unroll") for (int s_ = 0; s_ < 4; ++s_) { float bv_ = cv[0]; int bi_ = ci[0]; \
                    _Pragma("unroll") for (int c_ = 1; c_ < 8; ++c_) { const bool bt_ = cv[c_] > bv_ || (cv[c_] == bv_ && ci[c_] < bi_); bv_ = bt_ ? cv[c_] : bv_; bi_ = bt_ ? ci[c_] : bi_; } \
                    tv[s_] = bv_; ti[s_] = bi_; _Pragma("unroll") for (int c_ = 0; c_ < 8; ++c_) if (ci[c_] == bi_) cv[c_] = NEG; } } while (0)
                TOP4_OF8();
#pragma unroll
                for (int step = 16; step <= 32; step <<= 1) {
#pragma unroll
                    for (int s = 0; s < 4; ++s) { cv[s] = tv[s]; ci[s] = ti[s]; cv[4 + s] = __shfl_xor(tv[s], step); ci[4 + s] = __shfl_xor(ti[s], step); }
                    TOP4_OF8();
                }
#undef TOP4_OF8
                { const float mx = tv[0]; float e[4], sum = 0.f;
#pragma unroll
                  for (int s = 0; s < 4; ++s) { e[s] = __builtin_amdgcn_exp2f((tv[s] - mx) * 1.4426950408889634f); sum += e[s]; }
                  const float inv = 1.f / sum;
#pragma unroll
                  for (int s = 0; s < 4; ++s) tv[s] = e[s] * inv; }
                if (kq == 0) {
#pragma unroll
                    for (int s = 0; s < 4; ++s) sl[s] = __hip_atomic_fetch_add((LAS int*)(lcnt + ti[s]), 1, __ATOMIC_RELAXED, __HIP_MEMORY_SCOPE_WORKGROUP);
                }
            }
            __syncthreads();
            if (tid < 32) lbase[tid] = (int)__hip_atomic_fetch_add(GCNT + tid, (unsigned)lcnt[tid], __ATOMIC_RELAXED, __HIP_MEMORY_SCOPE_AGENT);
            __syncthreads();
            if (active && kq == 0) {
#pragma unroll
                for (int s = 0; s < 4; ++s) { const int e = ti[s], pos = lbase[e] + sl[s];
                    ELIST[e * ECAP + pos] = tok; RSTDS[e * ECAP + pos] = rstd; GATES[e * ECAP + pos] = tv[s]; TOKSL[tok * 4 + s] = (e << 20) | pos; }
            }
            __syncthreads();
        }
    }
    SEAM(9);
    if (IN(10)) {
        build_moe_table(TBL, GCNT, wave);
        g8::PUp g{H8, WUP8, ELIST, 1024u, 1024u, 8, 124, RSTDS, args.in[I_BUP]};   g8::MoeOrder S{TBL + LT_TS, 8, G, vcu}; g8::EpiUp E{ACT}; for (int rep_ = 0; rep_ < REP_P10; ++rep_) { if (rep_) xcd_barrier(bar); g8::gemm_phase(lds, wave, g, S, E); }
    }
    SEAM(10);
    if (IN(11)) {
        build_moe_table(TBL, GCNT, wave);
        g8::PDown g{ACT, WDN8, 1024u, 1024u, 8, 123, GATES, args.in[I_BDOWN]};   g8::MoeOrder S{TBL + LT_TS, 4, G, vcu}; g8::EpiDown E{YE}; for (int rep_ = 0; rep_ < REP_P11; ++rep_) { if (rep_) xcd_barrier(bar); g8::gemm_phase(lds, wave, g, S, E); }
    }
    SEAM(11);
    if (IN(12)) for (int rep_ = 0; rep_ < REP_P12; ++rep_) {
        if (rep_) xcd_barrier(bar);
        build_moe_table(TBL, GCNT, wave);
        const int lane = lane_id_v();
        const float* gf = args.in[I_NFINAL];
        unsigned poison = 0u;
        if (MK_N_LAUNCHES == 1) poison = xb_ld(&bar.bar[XB_TMO]);
        f32x4 gfin[4];
#pragma unroll
        for (int j = 0; j < 4; ++j) gfin[j] = ((const f32x4*)gf)[64 * j + lane];
        for (int gi = gw; gi < NX / 16; gi += NGW) {
            const int m0 = gi * 16;
            const int tsw = TOKSL[m0 * 4 + lane];
            const int yrow = TBL[LT_TS + (tsw >> 20)] * 256 + (tsw & 0xfffff);
#pragma unroll 1
            for (int r = 0; r < 16; r += 2) {
                f32x4 v[2][4]; unsigned w[2][4][4];
#pragma unroll
                for (int q = 0; q < 2; ++q) { const u32x2* hr = (const u32x2*)(H2 + (size_t)(m0 + r + q) * 1024) + lane;
#pragma unroll
                    for (int j = 0; j < 4; ++j) { const u32x2 hw_ = hr[64 * j]; v[q][j] = (f32x4){bf_lo(hw_.x), bf_hi(hw_.x), bf_lo(hw_.y), bf_hi(hw_.y)}; }
#pragma unroll
                    for (int k = 0; k < 4; ++k) { const int yr_ = __shfl(yrow, 4 * (r + q) + k); const unsigned* yr = (const unsigned*)(YE + (size_t)yr_ * 1024) + lane;
#pragma unroll
                        for (int j = 0; j < 4; ++j) w[q][k][j] = yr[64 * j]; } }
#pragma unroll
                for (int q = 0; q < 2; ++q) {
#pragma unroll
                    for (int k = 0; k < 4; ++k)
#pragma unroll
                        for (int j = 0; j < 4; ++j) { const f32x2 lo = __builtin_amdgcn_cvt_pk_f32_fp8((int)w[q][k][j], false), hi = __builtin_amdgcn_cvt_pk_f32_fp8((int)w[q][k][j], true);
                            v[q][j] += (f32x4){lo.x, lo.y, hi.x, hi.y} * (1.f / Y8_SCALE); }
                    float s = 0.f;
#pragma unroll
                    for (int j = 0; j < 4; ++j) s += (v[q][j].x * v[q][j].x + v[q][j].y * v[q][j].y) + (v[q][j].z * v[q][j].z + v[q][j].w * v[q][j].w);
                    float rstd = 1.f / sqrtf(wave_sum(s) * (1.f / 1024.f) + EPS);
                    if (poison) rstd = __builtin_nanf("");
                    f32x4* orow = (f32x4*)(args.out + (size_t)(m0 + r + q) * 1024) + lane;
#pragma unroll
                    for (int j = 0; j < 4; ++j) orow[64 * j] = v[q][j] * rstd * gfin[j];
                }
            }
        }
    }
#undef IN
#undef SEAM
#undef SEQROW
}

extern "C" void kernel_launch(void* const* d_in, const int* in_sizes, int n_in, void* d_out, int out_size, void* d_ws, size_t ws_size, hipStream_t stream) {
    static int grid = 0;
    if (grid == 0) {
        if (n_in != 27 || in_sizes[0] != NX * DM || out_size != NX * DM || ws_size < WS_END) { fprintf(stderr, "kernel_launch: unexpected shapes (n_in %d, in0 %d, out %d, ws %zu)\n", n_in, n_in > 0 ? in_sizes[0] : -1, out_size, ws_size); grid = -1; return; }
        int dev = 0, cus = 0, per_cu = 0;
        if (hipGetDevice(&dev) != hipSuccess || hipDeviceGetAttribute(&cus, hipDeviceAttributeMultiprocessorCount, dev) != hipSuccess) { grid = -1; return; }
        if (hipFuncSetAttribute((const void*)mk_fwd, hipFuncAttributeMaxDynamicSharedMemorySize, LDS_BYTES) != hipSuccess) { fprintf(stderr, "kernel_launch: hipFuncSetAttribute failed\n"); grid = -1; return; }
        if (hipOccupancyMaxActiveBlocksPerMultiprocessor(&per_cu, (const void*)mk_fwd, NWAVES * 64, LDS_BYTES) != hipSuccess || per_cu < 1) fprintf(stderr, "kernel_launch: occupancy query reports %d\n", per_cu);
        (void)hipGetLastError();
        grid = cus;
    }
    if (grid < 0) return;
    if (hipMemsetAsync((char*)d_ws + WS_CTL, 0, CTL_ZERO_BYTES, stream) != hipSuccess) { fprintf(stderr, "kernel_launch: memset failed\n"); return; }
    Args a{};
    for (int i = 0; i < 27; ++i) a.in[i] = (const float*)d_in[i];
    a.out = (float*)d_out; a.ws = (unsigned char*)d_ws;
    for (int i = 0; i < 16; ++i) a.rope_inv[i] = pow(10000.0, -(double)(2 * i) / 32.0);
    if (MK_N_LAUNCHES == 1) { a.ph_lo = 0; a.ph_hi = N_PHASES; hipLaunchKernelGGL(mk_fwd, dim3(grid), dim3(NWAVES * 64), LDS_BYTES, stream, a); }
    else for (int p = 0; p < N_PHASES; ++p) { a.ph_lo = p; a.ph_hi = p + 1; hipLaunchKernelGGL(mk_fwd, dim3(grid), dim3(NWAVES * 64), LDS_BYTES, stream, a); }
    const hipError_t le = hipPeekAtLastError();
    if (le != hipSuccess) fprintf(stderr, "kernel_launch: launch failed: %s\n", hipGetErrorName(le));
}
```

```cpp
#include <hip/hip_runtime.h>
#include <hip/hip_bf16.h>
#include <cstdio>
#include <cstdint>
#include <cmath>

#ifndef REP_P0
#define REP_P0 1
#endif
#ifndef REP_P1
#define REP_P1 1
#endif
#ifndef REP_P5
#define REP_P5 1
#endif
#ifndef REP_P10
#define REP_P10 1
#endif
#ifndef REP_P11
#define REP_P11 1
#endif
#ifndef REP_P2
#define REP_P2 1
#endif
#ifndef REP_P3
#define REP_P3 1
#endif
#ifndef REP_P4
#define REP_P4 1
#endif
#ifndef REP_P6
#define REP_P6 1
#endif
#ifndef REP_P7
#define REP_P7 1
#endif
#ifndef REP_P8
#define REP_P8 1
#endif
#ifndef REP_P12
#define REP_P12 1
#endif
#ifndef MK_N_LAUNCHES
#define MK_N_LAUNCHES 1
#endif

#define LAS __attribute__((address_space(3)))
#define GAS __attribute__((address_space(1)))
typedef unsigned short bf16_t;
typedef short bf16x8 __attribute__((ext_vector_type(8)));
typedef short s16x4 __attribute__((ext_vector_type(4)));
typedef float f32x2 __attribute__((ext_vector_type(2)));
typedef float f32x4 __attribute__((ext_vector_type(4)));
typedef float f32x16 __attribute__((ext_vector_type(16)));
typedef unsigned u32x2 __attribute__((ext_vector_type(2)));
typedef unsigned u32x4 __attribute__((ext_vector_type(4)));
typedef int i32x4 __attribute__((ext_vector_type(4)));
typedef int i32x8 __attribute__((ext_vector_type(8)));
typedef _Float16 h16x2 __attribute__((ext_vector_type(2)));
typedef _Float16 h16x8 __attribute__((ext_vector_type(8)));

constexpr int BATCH = 4, SEQ = 8192, DM = 1024, NX = BATCH * SEQ;
constexpr int NMETA = 16, MBLK = 64;
constexpr int RROWS = NX + BATCH * MBLK;
constexpr int TP = MBLK + SEQ;
constexpr int TPOS = NMETA + SEQ;
constexpr int NPROJ = 4864;
constexpr int NEXP = 32, ECAP = 32768;
constexpr int PROWS = 544 * 256;
constexpr float EPS = 1e-6f;

__device__ __forceinline__ float bf_lo(unsigned w) { return __uint_as_float(w << 16); }
__device__ __forceinline__ float bf_hi(unsigned w) { return __uint_as_float(w & 0xffff0000u); }
typedef __bf16 bf16x2_t __attribute__((ext_vector_type(2)));
__device__ __forceinline__ unsigned cvt_pk_bf16(float lo, float hi) { f32x2 v = {lo, hi}; bf16x2_t b = __builtin_convertvector(v, bf16x2_t); return __builtin_bit_cast(unsigned, b); }
__device__ __forceinline__ unsigned pack_fp8x4(float a, float b, float c, float d) {
    a = fminf(fmaxf(a, -448.f), 448.f); b = fminf(fmaxf(b, -448.f), 448.f); c = fminf(fmaxf(c, -448.f), 448.f); d = fminf(fmaxf(d, -448.f), 448.f);
    int w = 0; w = __builtin_amdgcn_cvt_pk_fp8_f32(a, b, w, false); w = __builtin_amdgcn_cvt_pk_fp8_f32(c, d, w, true); return (unsigned)w;
}
__device__ __forceinline__ unsigned pack_fp8x4_nc(float a, float b, float c, float d) {
    int w = 0; w = __builtin_amdgcn_cvt_pk_fp8_f32(a, b, w, false); w = __builtin_amdgcn_cvt_pk_fp8_f32(c, d, w, true); return (unsigned)w;
}
constexpr float W8_SCALE = 64.f;
constexpr float A8_SCALE = 4.f;
constexpr float Y8_SCALE = 16.f;
__device__ __forceinline__ float sigm(float x) { return __builtin_amdgcn_rcpf(1.f + __builtin_amdgcn_exp2f(-1.4426950408889634f * x)); }
__device__ __forceinline__ float gelu_tanh(float v) { const float z = v + 0.044715f * v * v * v; return v * __builtin_amdgcn_rcpf(1.f + __builtin_amdgcn_exp2f(-2.3022082f * z)); }
__device__ __forceinline__ f32x2 sigm2_scaled(f32x2 e  ) { e.x = __builtin_amdgcn_exp2f(e.x); e.y = __builtin_amdgcn_exp2f(e.y); e += (f32x2){1.f, 1.f}; e.x = __builtin_amdgcn_rcpf(e.x); e.y = __builtin_amdgcn_rcpf(e.y); return e; }
__device__ __forceinline__ f32x2 sigm2_bias(f32x2 x, f32x2 nb  ) { const f32x2 k = {-1.4426950408889634f, -1.4426950408889634f}; return sigm2_scaled(__builtin_elementwise_fma(x, k, nb)); }
__device__ __forceinline__ f32x2 gelu_tanh2(f32x2 v) { const f32x2 c1 = {-2.3022082f * 0.044715f, -2.3022082f * 0.044715f}, c0 = {-2.3022082f, -2.3022082f};
    const f32x2 u = __builtin_elementwise_fma(v * v, c1, c0); return v * sigm2_scaled(v * u); }
__device__ __forceinline__ int kvrow_of(int m) { return m < NX ? (m >> 13) * TP + MBLK + (m & 8191) : ((m - NX) >> 6) * TP + ((m - NX) & 63); }
__device__ __forceinline__ int pos_of(int m) { return m < NX ? NMETA + (m & 8191) : ((m - NX) & 63); }
__device__ __forceinline__ int lane_id_v() { int l; asm volatile("v_mbcnt_lo_u32_b32 %0, -1, 0\n\tv_mbcnt_hi_u32_b32 %0, -1, %0" : "=v"(l)); return l; }
__device__ __forceinline__ float wave_sum(float v) {
#pragma unroll
    for (int o = 1; o < 64; o <<= 1) v += __shfl_xor(v, o);
    return v;
}

__device__ __forceinline__ void glds16_s(const void* sbase, unsigned voff, unsigned lds_dst) {
    unsigned keep;
    asm volatile("s_mov_b32 %0, m0\n\ts_mov_b32 m0, %3\n\ts_nop 0\n\tglobal_load_lds_dwordx4 %1, %2\n\ts_mov_b32 m0, %0" : "=&s"(keep) : "v"(voff), "s"(sbase), "s"(lds_dst) : "memory");
}
__device__ __forceinline__ void glds4_s(const void* sbase, unsigned voff, unsigned lds_dst) {
    unsigned keep;
    asm volatile("s_mov_b32 %0, m0\n\ts_mov_b32 m0, %3\n\ts_nop 0\n\tglobal_load_lds_dword %1, %2\n\ts_mov_b32 m0, %0" : "=&s"(keep) : "v"(voff), "s"(sbase), "s"(lds_dst) : "memory");
}
namespace g8 {
constexpr int BM = 256, BK = 64, HALF = 128, HTB = HALF * BK * 2, STAGE_BYTES = 8 * HTB, NXCD = 8, WGM = 8;
__host__ __device__ __forceinline__ int lds_byte(int r, int c) { const int st = (r >> 4) * 2 + (c >> 5), rr = r & 15, cc = c & 31, ob = rr * 64 + cc * 2; return st * 1024 + (ob ^ (((ob >> 9) & 1) << 5)); }
__host__ __device__ __forceinline__ void stage_rc(int b, int& R, int& C) { const int st = b / 1024, sb = b % 1024, swz = sb ^ (((sb >> 9) & 1) << 5); R = (st >> 1) * 16 + swz / 64; C = (st & 1) * 32 + (swz % 64) / 2; }
__host__ __device__ __forceinline__ int perm32(int rho) { const int n = rho >> 4, i = rho & 15; return 8 * (i >> 2) + 4 * n + (i & 3); }

struct Unit { int pm, pn, e, mt, rem; };

struct StaticOrder {
    int nM, nN, nwg, G, c;
    __device__ void init(int M, int N, int G_, int c_) { nM = M / BM; nN = N / BM; nwg = nM * nN; G = G_; c = c_; }
    __device__ bool next(int i, Unit& u) const {
        const long L = (long)i * G + c; if (L >= nwg) return false;
        int wgid = (int)L; { const int q = nwg / NXCD, r = nwg % NXCD, xcd = wgid % NXCD, off = wgid / NXCD; wgid = (xcd < r ? xcd * (q + 1) : r * (q + 1) + (xcd - r) * q) + off; }
        const int nig = WGM * nN, gid = wgid / nig, fm = gid * WGM, gsz = (nM - fm) < WGM ? (nM - fm) : WGM;
        u.pm = fm + ((wgid % nig) % gsz); u.pn = (wgid % nig) / gsz; u.e = 0; u.mt = 0; u.rem = 256; return true;
    }
};
struct MoeOrder {
    const volatile LAS int* ts; int npn, G, vcu;
    __device__ bool next(int i, Unit& u) const {
        const long L = (long)i * G + vcu; const int g = (int)(L / npn), pn = (int)(L % npn);
        const int el = lane_id_v() & 31;
        const volatile LAS int* tl = ts + el;
        const int lo = tl[0], hi = tl[1], cn = tl[40];
        if (g >= __builtin_amdgcn_readlane(hi, 31)) return false;
        const unsigned long long mk = __ballot(lo <= g && g < hi);
        const int e = mk ? (int)__builtin_ctzll(mk) : 0;
        u.pm = g; u.pn = pn; u.e = e; u.mt = g - __builtin_amdgcn_readlane(lo, e); u.rem = __builtin_amdgcn_readlane(cn, e) - u.mt * 256; return true;
    }
};

struct PPlain { static constexpr bool GATHER = false, FP8 = false, SIDE = false; const bf16_t* A; const bf16_t* Bt; unsigned lda2, ldb2; int nt;
    __device__ __forceinline__ const char* a_tile(const Unit& u) const { return (const char*)A + (size_t)u.pm * 256 * lda2; }
    __device__ __forceinline__ const char* b_tile(const Unit& u) const { return (const char*)Bt + (size_t)u.pn * 256 * ldb2; }
    __device__ __forceinline__ const int* a_row_ptr(const Unit&, int) const { return nullptr; } };
struct PGates { static constexpr bool GATHER = false, FP8 = false, SIDE = false; const bf16_t* A; const bf16_t* Bt; unsigned lda2, ldb2; int nt;
    __device__ __forceinline__ const char* a_tile(const Unit& u) const { return (const char*)A + (size_t)u.pm * 256 * lda2 + (size_t)(u.pn >> 1) * 512; }
    __device__ __forceinline__ const char* b_tile(const Unit& u) const { return (const char*)Bt + (size_t)u.pn * 256 * ldb2; }
    __device__ __forceinline__ const int* a_row_ptr(const Unit&, int) const { return nullptr; } };
struct PUp { static constexpr bool GATHER = true, FP8 = true, SIDE = true; const unsigned char* A; const unsigned char* Bt; const int* elist; unsigned lda2, ldb2; int nt; int s2; const float* rowv; const float* bias;
    __device__ __forceinline__ const char* a_tile(const Unit&) const { return (const char*)A; }
    __device__ __forceinline__ const char* b_tile(const Unit& u) const { return (const char*)Bt + ((size_t)u.e * 2048 + (size_t)u.pn * 256) * ldb2; }
    __device__ __forceinline__ const int* a_row_ptr(const Unit& u, int r) const { const int rc = r < u.rem ? r : u.rem - 1; return elist + u.e * ECAP + u.mt * 256 + rc; }
    __device__ __forceinline__ void side_dma(const Unit& u, unsigned lds_slot, int wid, int lane) const {
        if (wid < 4) { const int r = 64 * wid + lane; glds4_s(rowv, (unsigned)(u.e * ECAP + u.mt * 256 + (r < u.rem ? r : u.rem - 1)) * 4u, lds_slot + wid * 256); }
        else { const int i = 64 * (wid - 4) + lane; glds4_s(bias, (unsigned)(u.e * 2048 + (i < 128 ? u.pn * 128 + i : 1024 + u.pn * 128 + (i - 128))) * 4u, lds_slot + wid * 256); } } };
struct PDown { static constexpr bool GATHER = false, FP8 = true, SIDE = true; const unsigned char* A; const unsigned char* Bt; unsigned lda2, ldb2; int nt; int s2; const float* rowv; const float* bias;
    __device__ __forceinline__ const char* a_tile(const Unit& u) const { return (const char*)A + (size_t)u.pm * 256 * lda2; }
    __device__ __forceinline__ const char* b_tile(const Unit& u) const { return (const char*)Bt + ((size_t)u.e * 1024 + (size_t)u.pn * 256) * ldb2; }
    __device__ __forceinline__ const int* a_row_ptr(const Unit&, int) const { return nullptr; }
    __device__ __forceinline__ void side_dma(const Unit& u, unsigned lds_slot, int wid, int lane) const {
        if (wid < 4) { const int r = 64 * wid + lane; glds4_s(rowv, (unsigned)(u.e * ECAP + u.mt * 256 + (r < u.rem ? r : u.rem - 1)) * 4u, lds_slot + wid * 256); }
        else { const int i = 64 * (wid - 4) + lane; glds4_s(bias, (unsigned)(u.e * 1024 + u.pn * 256 + i) * 4u, lds_slot + wid * 256); } } };

template <class P, class Epi, class Sched>
__device__ __forceinline__ void gemm_phase(LAS unsigned char* lds, const int wid, const P g, const Sched& S, const Epi& E) {
    const int lane = lane_id_v(), tid = wid * 64 + lane, wr = wid >> 2, wc = wid & 3;
    const int nt = g.nt;
    int fp8_s = 127; if constexpr (P::FP8) fp8_s = g.s2;
    (void)fp8_s;
    unsigned voffA0, voffB0, CA2; int RA0;
    { int R, C; stage_rc(tid * 16, R, C); const int Rb = (R & ~31) + perm32(R & 31);
      voffA0 = (unsigned)R * g.lda2 + (unsigned)C * 2u; voffB0 = (unsigned)Rb * g.ldb2 + (unsigned)C * 2u; RA0 = R; CA2 = (unsigned)C * 2u; }
    const size_t pstepA = (size_t)64 * g.lda2, pstepB = (size_t)64 * g.ldb2;
    LAS unsigned char* idlds = lds + STAGE_BYTES + 4096 + wid * 256;
    const size_t kstep = (size_t)(BK * 2);
    const size_t hstepA = (size_t)HALF * g.lda2, hstepB = (size_t)HALF * g.ldb2;
    const unsigned ldsw = (unsigned)wid * 1024u;
    const unsigned ldsbase = (unsigned)(uintptr_t)lds + ldsw;
    const int aoff = lds_byte(wr * 64 + (lane & 15), (lane >> 4) * 8), boff = lds_byte(wc * 32 + (lane & 15), (lane >> 4) * 8);
#define G8_SA(b, h) (((b) * 2 + (h)) * HTB)
#define G8_SB(b, h) ((4 + (b) * 2 + (h)) * HTB)
#define G8_STB(bufoff, gbase) do { _Pragma("unroll") for (int _i = 0; _i < 2; ++_i) { \
        if constexpr (P::FP8) glds16_s((const char*)(gbase) + (size_t)_i * pstepB, voffB0, ldsbase + (unsigned)((bufoff) + _i * 8192)); \
        else __builtin_amdgcn_global_load_lds((const unsigned*)((const char*)(gbase) + (size_t)_i * pstepB + voffB0), (LAS unsigned*)(lds + (bufoff) + ldsw + _i * 8192), 16, 0, 0); } } while (0)
#define G8_STA(bufoff, kp, h, GO) do { _Pragma("unroll") for (int _i = 0; _i < 2; ++_i) { \
        if constexpr (P::FP8) { if constexpr (P::GATHER) glds16_s((const char*)(kp), GO[h][_i] * g.lda2 + CA2, ldsbase + (unsigned)((bufoff) + _i * 8192)); \
                                else glds16_s((const char*)(kp) + (size_t)(h) * hstepA + (size_t)_i * pstepA, voffA0, ldsbase + (unsigned)((bufoff) + _i * 8192)); } \
        else { const char* _p = P::GATHER ? ((const char*)(kp) + (GO[h][_i] * g.lda2 + CA2)) : ((const char*)(kp) + (size_t)(h) * hstepA + (size_t)_i * pstepA + voffA0); \
        __builtin_amdgcn_global_load_lds((const unsigned*)_p, (LAS unsigned*)(lds + (bufoff) + ldsw + _i * 8192), 16, 0, 0); } } } while (0)
#define G8_LDA(dst, b, h) do { _Pragma("unroll") for (int m = 0; m < 4; ++m) _Pragma("unroll") for (int k = 0; k < 2; ++k) dst[m][k] = *(const LAS bf16x8*)(lds + G8_SA(b, h) + aoff + m * 2048 + k * 1024); } while (0)
#define G8_LDB(dst, b, h) do { _Pragma("unroll") for (int n = 0; n < 2; ++n) _Pragma("unroll") for (int k = 0; k < 2; ++k) dst[n][k] = *(const LAS bf16x8*)(lds + G8_SB(b, h) + boff + n * 2048 + k * 1024); } while (0)
#define G8_MMA(ai, bj, At, Bt) do { __builtin_amdgcn_s_setprio(1); \
        if constexpr (P::FP8) { _Pragma("unroll") for (int m = 0; m < 4; ++m) _Pragma("unroll") for (int n = 0; n < 2; ++n) { \
            const i32x8 a8_ = __builtin_shufflevector(__builtin_bit_cast(i32x4, At[m][0]), __builtin_bit_cast(i32x4, At[m][1]), 0, 1, 2, 3, 4, 5, 6, 7); \
            const i32x8 b8_ = __builtin_shufflevector(__builtin_bit_cast(i32x4, Bt[n][0]), __builtin_bit_cast(i32x4, Bt[n][1]), 0, 1, 2, 3, 4, 5, 6, 7); \
            acc[ai][bj][m][n] = __builtin_amdgcn_mfma_scale_f32_16x16x128_f8f6f4(b8_, a8_, acc[ai][bj][m][n], 0, 0, 0, fp8_s, 0, fp8_s); } } \
        else { _Pragma("unroll") for (int m = 0; m < 4; ++m) _Pragma("unroll") for (int n = 0; n < 2; ++n) _Pragma("unroll") for (int k = 0; k < 2; ++k) \
            acc[ai][bj][m][n] = __builtin_amdgcn_mfma_f32_16x16x32_bf16(Bt[n][k], At[m][k], acc[ai][bj][m][n], 0, 0, 0); } \
        __builtin_amdgcn_s_setprio(0); } while (0)
#define G8_WAIT_V(n) asm volatile("s_waitcnt vmcnt(" #n ")" ::: "memory")
#define G8_WAIT_L(n) asm volatile("s_waitcnt lgkmcnt(" #n ")" ::: "memory")
#define G8_BAR __builtin_amdgcn_s_barrier()
#define G8_SCHED __builtin_amdgcn_sched_barrier(0)
    Unit cur, nxt; int ui = 0;
    if (!S.next(0, cur)) return;
    f32x4 acc[2][2][4][2];
#pragma unroll
    for (int a = 0; a < 2; ++a)
#pragma unroll
        for (int b = 0; b < 2; ++b)
#pragma unroll
            for (int m = 0; m < 4; ++m)
#pragma unroll
                for (int n = 0; n < 2; ++n) acc[a][b][m][n] = (f32x4){0.f, 0.f, 0.f, 0.f};
    if constexpr (Epi::PRELOAD) { const int l0 = lane_id_v(); E.preload(acc, cur, wr, wc, l0 & 15, l0 >> 4); }
    bf16x8 At[4][2], B0[2][2], B1[2][2];
    unsigned gc[2][2];
#pragma unroll
    for (int h = 0; h < 2; ++h)
#pragma unroll
        for (int i = 0; i < 2; ++i) gc[h][i] = P::GATHER ? (unsigned)*g.a_row_ptr(cur, h * 128 + i * 64 + RA0) : 0u;
    const unsigned sidebase = (unsigned)(uintptr_t)lds + (unsigned)STAGE_BYTES + 12288u;
    if constexpr (P::SIDE) g.side_dma(cur, sidebase, wid, lane_id_v());
    const char* cA = g.a_tile(cur); const char* cB = g.b_tile(cur);
    G8_STB(G8_SB(0, 0), cB); G8_STB(G8_SB(0, 1), cB + hstepB); G8_STA(G8_SA(0, 0), cA, 0, gc); G8_STA(G8_SA(0, 1), cA, 1, gc);
    if (wr == 1) G8_BAR;
    G8_WAIT_V(2); G8_BAR;
    G8_STB(G8_SB(1, 0), cB + kstep); G8_STA(G8_SA(1, 0), cA + kstep, 0, gc); G8_STB(G8_SB(1, 1), cB + hstepB + kstep);
    G8_WAIT_V(6); G8_BAR;
    for (;;) {
        const bool has_next = S.next(ui + 1, nxt);
        const char* nA = has_next ? g.a_tile(nxt) : cA; const char* nB = has_next ? g.b_tile(nxt) : cB;
        if constexpr (P::SIDE) { if (has_next) g.side_dma(nxt, sidebase + (unsigned)(((ui + 1) % 3) * 2048), wid, lane_id_v()); }
        if (P::GATHER && has_next) {
#pragma unroll
            for (int h = 0; h < 2; ++h)
#pragma unroll
                for (int i = 0; i < 2; ++i) __builtin_amdgcn_global_load_lds((const unsigned*)g.a_row_ptr(nxt, h * 128 + i * 64 + RA0), (LAS unsigned*)(idlds + (h * 2 + i) * 2048), 4, 0, 0);
        }
#define G8_KITER(a1, a2, b2, O2, G8_IDSWAP) do { \
            const char* a3 = (a2) + kstep; const char* b3 = (b2) + kstep; \
              \
            G8_LDB(B0, 0, 0); G8_LDB(B1, 0, 1); G8_SCHED; G8_LDA(At, 0, 0); G8_STA(G8_SA(1, 1), a1, 1, gc); G8_IDSWAP(); \
            G8_WAIT_V(8); G8_WAIT_L(0); G8_BAR; G8_MMA(0, 0, At, B0); G8_MMA(0, 1, At, B1); G8_BAR; G8_SCHED; \
              \
            G8_LDA(At, 0, 1); G8_STB(G8_SB(0, 0), b2); G8_STB(G8_SB(0, 1), (b2) + hstepB); G8_STA(G8_SA(0, 0), a2, 0, O2); \
            G8_WAIT_V(8); G8_WAIT_L(0); G8_BAR; G8_MMA(1, 0, At, B0); G8_MMA(1, 1, At, B1); G8_BAR; G8_SCHED; \
              \
            G8_LDB(B0, 1, 0); G8_LDB(B1, 1, 1); G8_SCHED; G8_LDA(At, 1, 0); G8_STA(G8_SA(0, 1), a2, 1, O2); \
            G8_WAIT_V(8); G8_WAIT_L(0); G8_BAR; G8_MMA(0, 0, At, B0); G8_MMA(0, 1, At, B1); G8_BAR; G8_SCHED; \
              \
            G8_LDA(At, 1, 1); G8_STB(G8_SB(1, 0), b3); G8_STB(G8_SB(1, 1), b3 + hstepB); G8_STA(G8_SA(1, 0), a3, 0, O2); \
            G8_WAIT_V(8); G8_WAIT_L(0); G8_BAR; G8_MMA(1, 0, At, B0); G8_MMA(1, 1, At, B1); G8_BAR; G8_SCHED; } while (0)
#define G8_SWAP_IDS() do { if (P::GATHER && last && has_next) { const unsigned ida = (unsigned)(uintptr_t)(idlds + lane_id_v() * 4); \
                asm volatile("ds_read_b32 %0, %4\n\tds_read_b32 %1, %4 offset:2048\n\tds_read_b32 %2, %4 offset:4096\n\tds_read_b32 %3, %4 offset:6144\n\ts_waitcnt lgkmcnt(0)" \
                             : "=&v"(gc[0][0]), "=&v"(gc[0][1]), "=&v"(gc[1][0]), "=&v"(gc[1][1]) : "v"(ida) : "memory"); } } while (0)
#pragma nounroll
        for (int t = 0; t < nt; t += 2) {
            const bool last = (t == nt - 2);
            const char* a1 = cA + (size_t)(t + 1) * kstep;
            const char* a2 = last ? nA : cA + (size_t)(t + 2) * kstep; const char* b2 = last ? nB : cB + (size_t)(t + 2) * kstep;
            G8_KITER(a1, a2, b2, gc, G8_SWAP_IDS);
        }
#undef G8_SWAP_IDS
#undef G8_KITER
        if (wr == 0) G8_BAR;
        { const int l2 = lane_id_v(); if constexpr (P::SIDE) E(acc, cur, wr, wc, l2 & 15, l2 >> 4, (const LAS float*)(lds + STAGE_BYTES + 12288 + (ui % 3) * 2048)); else E(acc, cur, wr, wc, l2 & 15, l2 >> 4); }
        if (!has_next) break;
#pragma unroll
        for (int a = 0; a < 2; ++a)
#pragma unroll
            for (int b = 0; b < 2; ++b)
#pragma unroll
                for (int m = 0; m < 4; ++m)
#pragma unroll
                    for (int n = 0; n < 2; ++n) acc[a][b][m][n] = (f32x4){0.f, 0.f, 0.f, 0.f};
        if constexpr (Epi::PRELOAD) { const int l0 = lane_id_v(); E.preload(acc, nxt, wr, wc, l0 & 15, l0 >> 4); }
        cur = nxt; cA = nA; cB = nB; ++ui;
        if (wr == 1) G8_BAR;
    }
    G8_WAIT_V(0);
    G8_BAR;
#undef G8_SA
#undef G8_SB
#undef G8_STB
#undef G8_STA
#undef G8_LDA
#undef G8_LDB
#undef G8_MMA
#undef G8_WAIT_V
#undef G8_WAIT_L
#undef G8_BAR
#undef G8_SCHED
}

#define EPI_ROWS_BEGIN() _Pragma("unroll") for (int ai = 0; ai < 2; ++ai) _Pragma("unroll") for (int m = 0; m < 4; ++m) { const int rr = ai * HALF + wr * 64 + m * 16 + fr;
#define EPI_ROWS_END() }
__device__ __forceinline__ u32x4 pack8(const f32x4& a, const f32x4& b) { u32x4 w; w.x = cvt_pk_bf16(a[0], a[1]); w.y = cvt_pk_bf16(a[2], a[3]); w.z = cvt_pk_bf16(b[0], b[1]); w.w = cvt_pk_bf16(b[2], b[3]); return w; }

struct EpiProj {
    static constexpr bool PRELOAD = false;
    bf16_t *PQ, *PRX, *GRG, *GATE; const float* b_gate;
    template <int ACT> __device__ __forceinline__ void tile(const f32x4 (&acc)[2][2][4][2], bf16_t* base, int ldc, int colt, int row0, int wr, int wc, int fr, int fq) const {
        const int cw = wc * 32 + 8 * fq;
        f32x4 bv[2][2];
#pragma unroll
        for (int bj = 0; bj < 2; ++bj)
#pragma unroll
            for (int n = 0; n < 2; ++n) bv[bj][n] = ACT == 2 ? *(const f32x4*)(b_gate + colt + bj * HALF + cw + 4 * n) * -1.4426950408889634f : (f32x4){0.f, 0.f, 0.f, 0.f};
        EPI_ROWS_BEGIN()
            bf16_t* rowp = base + (size_t)(row0 + rr) * ldc + colt + cw;
#pragma unroll
            for (int bj = 0; bj < 2; ++bj) { f32x4 v0 = acc[ai][bj][m][0], v1 = acc[ai][bj][m][1];
                if (ACT == 1) { const f32x2 a = gelu_tanh2((f32x2){v0[0], v0[1]}), b = gelu_tanh2((f32x2){v0[2], v0[3]}), c = gelu_tanh2((f32x2){v1[0], v1[1]}), d = gelu_tanh2((f32x2){v1[2], v1[3]});
                    v0 = (f32x4){a.x, a.y, b.x, b.y}; v1 = (f32x4){c.x, c.y, d.x, d.y}; }
                if (ACT == 2) { const f32x4 n0 = bv[bj][0], n1 = bv[bj][1];
                    const f32x2 a = sigm2_bias((f32x2){v0[0], v0[1]}, (f32x2){n0[0], n0[1]}), b = sigm2_bias((f32x2){v0[2], v0[3]}, (f32x2){n0[2], n0[3]}), c = sigm2_bias((f32x2){v1[0], v1[1]}, (f32x2){n1[0], n1[1]}), d = sigm2_bias((f32x2){v1[2], v1[3]}, (f32x2){n1[2], n1[3]});
                    v0 = (f32x4){a.x, a.y, b.x, b.y}; v1 = (f32x4){c.x, c.y, d.x, d.y}; }
                *(u32x4*)(rowp + bj * HALF) = pack8(v0, v1); }
        EPI_ROWS_END()
    }
    __device__ __forceinline__ void operator()(const f32x4 (&acc)[2][2][4][2], const Unit& u, int wr, int wc, int fr, int fq) const {
        const int pn = u.pn, row0 = u.pm * BM;
        if (pn < 3) tile<0>(acc, PQ, 768, pn * 256, row0, wr, wc, fr, fq);
        else if (pn < 7) tile<0>(acc, PRX, 1024, (pn - 3) * 256, row0, wr, wc, fr, fq);
        else if (pn < 11) tile<1>(acc, GRG, 1024, (pn - 7) * 256, row0, wr, wc, fr, fq);
        else tile<2>(acc, GATE, 2048, (pn - 11) * 256, row0, wr, wc, fr, fq);
    }
};
struct EpiQ {
    static constexpr bool PRELOAD = false;
    bf16_t* Q; const float* COS; const float* SIN;
    __device__ __forceinline__ void operator()(const f32x4 (&acc)[2][2][4][2], const Unit& u, int wr, int wc, int fr, int fq) const {
        EPI_ROWS_BEGIN()
            const int row = u.pm * BM + rr, t = NMETA + (row & 8191);
#pragma unroll
            for (int bj = 0; bj < 2; ++bj) { const int col0 = u.pn * BM + bj * HALF + wc * 32 + 8 * fq, hh = col0 / 96, off = col0 - 96 * hh;
                f32x4 v0 = acc[ai][bj][m][0], v1 = acc[ai][bj][m][1];
                if (off >= 64) { const int i0 = (off - 64) >> 1; const f32x4 c = *(const f32x4*)(COS + t * 16 + i0), s = *(const f32x4*)(SIN + t * 16 + i0);
                    const float a0 = v0[0] * c[0] - v0[1] * s[0], b0 = v0[0] * s[0] + v0[1] * c[0];
                    const float a1 = v0[2] * c[1] - v0[3] * s[1], b1 = v0[2] * s[1] + v0[3] * c[1];
                    const float a2 = v1[0] * c[2] - v1[1] * s[2], b2 = v1[0] * s[2] + v1[1] * c[2];
                    const float a3 = v1[2] * c[3] - v1[3] * s[3], b3 = v1[2] * s[3] + v1[3] * c[3];
                    v0 = (f32x4){a0, b0, a1, b1}; v1 = (f32x4){a2, b2, a3, b3}; }
                *(u32x4*)(Q + (size_t)row * 768 + col0) = pack8(v0, v1); }
        EPI_ROWS_END()
    }
};
struct EpiKV {
    static constexpr bool PRELOAD = false;
    bf16_t *KN, *V;
    __device__ __forceinline__ void operator()(const f32x4 (&acc)[2][2][4][2], const Unit& u, int wr, int wc, int fr, int fq) const {
        EPI_ROWS_BEGIN()
            const int kr = kvrow_of(u.pm * BM + rr);
#pragma unroll
            for (int bj = 0; bj < 2; ++bj) { const int col0 = u.pn * BM + bj * HALF + wc * 32 + 8 * fq, hh = col0 >> 7, j = col0 & 127;
                bf16_t* dst = (j < 64 ? KN + hh * 64 + j : V + hh * 64 + (j - 64)) + (size_t)kr * 512;
                *(u32x4*)dst = pack8(acc[ai][bj][m][0], acc[ai][bj][m][1]); }
        EPI_ROWS_END()
    }
};
struct EpiGates {
    static constexpr bool PRELOAD = false;
    const bf16_t* XC; const float *b_a, *b_x; _Float16 *R16, *U16;
    __device__ __forceinline__ void operator()(const f32x4 (&acc)[2][2][4][2], const Unit& u, int wr, int wc, int fr, int fq) const {
        const int ch = u.pn * 128 + wc * 32 + 8 * fq;
        const f32x4 ba0 = *(const f32x4*)(b_a + ch), ba1 = *(const f32x4*)(b_a + ch + 4), bx0 = *(const f32x4*)(b_x + ch), bx1 = *(const f32x4*)(b_x + ch + 4);
        u32x4 xwv[2][4];
#pragma unroll
        for (int ai = 0; ai < 2; ++ai)
#pragma unroll
            for (int m = 0; m < 4; ++m) xwv[ai][m] = *(const u32x4*)(XC + (size_t)(u.pm * BM + ai * HALF + wr * 64 + m * 16 + fr) * 1024 + ch);
        asm volatile("" ::: "memory");
        EPI_ROWS_BEGIN()
            const size_t o = (size_t)(u.pm * BM + rr) * 1024 + ch;
            const u32x4 xw = xwv[ai][m];
            const f32x4 a0 = acc[ai][0][m][0] + ba0, a1 = acc[ai][0][m][1] + ba1, x0 = acc[ai][1][m][0] + bx0, x1 = acc[ai][1][m][1] + bx1;
            float xc[8] = {bf_lo(xw.x), bf_hi(xw.x), bf_lo(xw.y), bf_hi(xw.y), bf_lo(xw.z), bf_hi(xw.z), bf_lo(xw.w), bf_hi(xw.w)};
            h16x8 rv, uv;
#pragma unroll
            for (int j = 0; j < 4; ++j) { rv[j] = (_Float16)sigm(a0[j]); rv[4 + j] = (_Float16)sigm(a1[j]); uv[j] = (_Float16)(sigm(x0[j]) * xc[j]); uv[4 + j] = (_Float16)(sigm(x1[j]) * xc[4 + j]); }
            *(h16x8*)(R16 + o) = rv; *(h16x8*)(U16 + o) = uv;
        EPI_ROWS_END()
    }
};
struct EpiAo {
    static constexpr bool PRELOAD = false;
    const bf16_t* GATE; bf16_t* MA;
    __device__ __forceinline__ void operator()(const f32x4 (&acc)[2][2][4][2], const Unit& u, int wr, int wc, int fr, int fq) const {
#pragma unroll
        for (int ai = 0; ai < 2; ++ai) { u32x4 gw[4][2];
#pragma unroll
            for (int m = 0; m < 4; ++m) { const int row = u.pm * BM + ai * HALF + wr * 64 + m * 16 + fr;
#pragma unroll
                for (int bj = 0; bj < 2; ++bj) gw[m][bj] = __builtin_nontemporal_load((const u32x4*)(GATE + (size_t)row * 2048 + u.pn * BM + bj * HALF + wc * 32 + 8 * fq)); }
            asm volatile("" ::: "memory");
#pragma unroll
            for (int m = 0; m < 4; ++m) { const int row = u.pm * BM + ai * HALF + wr * 64 + m * 16 + fr;
#pragma unroll
                for (int bj = 0; bj < 2; ++bj) { const int col0 = u.pn * BM + bj * HALF + wc * 32 + 8 * fq; const u32x4 g = gw[m][bj];
                    f32x4 v0 = acc[ai][bj][m][0], v1 = acc[ai][bj][m][1];
                    v0 *= (f32x4){bf_lo(g.x), bf_hi(g.x), bf_lo(g.y), bf_hi(g.y)}; v1 *= (f32x4){bf_lo(g.z), bf_hi(g.z), bf_lo(g.w), bf_hi(g.w)};
                    *(u32x4*)(MA + (size_t)row * 1024 + col0) = pack8(v0, v1); } } }
    }
};
struct EpiRo {
    static constexpr bool PRELOAD = false;
    const bf16_t* GATE; const bf16_t* MA; bf16_t* MG;
    __device__ __forceinline__ void operator()(const f32x4 (&acc)[2][2][4][2], const Unit& u, int wr, int wc, int fr, int fq) const {
#pragma unroll
        for (int ai = 0; ai < 2; ++ai) { u32x4 gw[4][2], mw[4][2];
#pragma unroll
            for (int m = 0; m < 4; ++m) { const int row = u.pm * BM + ai * HALF + wr * 64 + m * 16 + fr;
#pragma unroll
                for (int bj = 0; bj < 2; ++bj) { const int col0 = u.pn * BM + bj * HALF + wc * 32 + 8 * fq;
                    gw[m][bj] = __builtin_nontemporal_load((const u32x4*)(GATE + (size_t)row * 2048 + 1024 + col0)); mw[m][bj] = *(const u32x4*)(MA + (size_t)row * 1024 + col0); } }
            asm volatile("" ::: "memory");
#pragma unroll
            for (int m = 0; m < 4; ++m) { const int row = u.pm * BM + ai * HALF + wr * 64 + m * 16 + fr;
#pragma unroll
                for (int bj = 0; bj < 2; ++bj) { const int col0 = u.pn * BM + bj * HALF + wc * 32 + 8 * fq; const u32x4 g = gw[m][bj], q = mw[m][bj];
                    f32x4 v0 = acc[ai][bj][m][0], v1 = acc[ai][bj][m][1];
                    v0 = v0 * (f32x4){bf_lo(g.x), bf_hi(g.x), bf_lo(g.y), bf_hi(g.y)} + (f32x4){bf_lo(q.x), bf_hi(q.x), bf_lo(q.y), bf_hi(q.y)};
                    v1 = v1 * (f32x4){bf_lo(g.z), bf_hi(g.z), bf_lo(g.w), bf_hi(g.w)} + (f32x4){bf_lo(q.z), bf_hi(q.z), bf_lo(q.w), bf_hi(q.w)};
                    *(u32x4*)(MG + (size_t)row * 1024 + col0) = pack8(v0, v1); } } }
    }
};
struct EpiOut {
    static constexpr bool PRELOAD = true;
    const float* X; bf16_t* H2; unsigned char* H8; const float* gffn;
    __device__ __forceinline__ void preload(f32x4 (&acc)[2][2][4][2], const Unit& u, int wr, int wc, int fr, int fq) const {
        EPI_ROWS_BEGIN()
            const int row = u.pm * BM + rr;
#pragma unroll
            for (int bj = 0; bj < 2; ++bj) { const size_t o = (size_t)row * 1024 + u.pn * BM + bj * HALF + wc * 32 + 8 * fq;
                acc[ai][bj][m][0] = __builtin_nontemporal_load((const f32x4*)(X + o)); acc[ai][bj][m][1] = __builtin_nontemporal_load((const f32x4*)(X + o + 4)); }
        EPI_ROWS_END()
    }
    __device__ __forceinline__ void operator()(const f32x4 (&acc)[2][2][4][2], const Unit& u, int wr, int wc, int fr, int fq) const {
        EPI_ROWS_BEGIN()
            const int row = u.pm * BM + rr;
#pragma unroll
            for (int bj = 0; bj < 2; ++bj) { const size_t o = (size_t)row * 1024 + u.pn * BM + bj * HALF + wc * 32 + 8 * fq;
                const f32x4 v0 = acc[ai][bj][m][0], v1 = acc[ai][bj][m][1];
                *(u32x4*)(H2 + o) = pack8(v0, v1);
                const int cg_ = u.pn * BM + bj * HALF + wc * 32 + 8 * fq; const f32x4 g0 = *(const f32x4*)(gffn + cg_), g1 = *(const f32x4*)(gffn + cg_ + 4);
                u32x2 w8; w8.x = pack_fp8x4(v0[0] * g0[0], v0[1] * g0[1], v0[2] * g0[2], v0[3] * g0[3]); w8.y = pack_fp8x4(v1[0] * g1[0], v1[1] * g1[1], v1[2] * g1[2], v1[3] * g1[3]); *(u32x2*)(H8 + o) = w8; }
        EPI_ROWS_END()
    }
};
struct EpiUp {
    static constexpr bool PRELOAD = false;
    unsigned char* ACT;
    __device__ __forceinline__ void operator()(const f32x4 (&acc)[2][2][4][2], const Unit& u, int wr, int wc, int fr, int fq, const LAS float* side) const {
        const int c0 = u.pn * 128 + wc * 32 + 8 * fq, cl = wc * 32 + 8 * fq;
        const f32x4 bg0 = *(const LAS f32x4*)(side + 256 + cl), bg1 = *(const LAS f32x4*)(side + 256 + cl + 4), bl0 = *(const LAS f32x4*)(side + 384 + cl), bl1 = *(const LAS f32x4*)(side + 384 + cl + 4);
        EPI_ROWS_BEGIN()
            const float rs = side[rr];
            f32x4 g0 = acc[ai][0][m][0] * rs + bg0, g1 = acc[ai][0][m][1] * rs + bg1, l0 = acc[ai][1][m][0] * rs + bl0, l1 = acc[ai][1][m][1] * rs + bl1;
#define UP_PAIR(G_, L_, i0) do { f32x2 a2 = {fminf(G_[i0], 7.f), fminf(G_[i0 + 1], 7.f)}; f32x2 p2 = {fminf(fmaxf(L_[i0], -7.f), 7.f), fminf(fmaxf(L_[i0 + 1], -7.f), 7.f)}; \
                const f32x2 k4 = {A8_SCALE, A8_SCALE}, kc = {-1.702f * 1.4426950408889634f, -1.702f * 1.4426950408889634f}, one = {1.f, 1.f}; \
                p2 = __builtin_elementwise_fma(p2, k4, k4); f32x2 e2 = a2 * kc; e2.x = __builtin_amdgcn_exp2f(e2.x); e2.y = __builtin_amdgcn_exp2f(e2.y); e2 += one; \
                e2.x = __builtin_amdgcn_rcpf(e2.x); e2.y = __builtin_amdgcn_rcpf(e2.y); a2 = (a2 * e2) * p2; G_[i0] = a2.x; G_[i0 + 1] = a2.y; } while (0)
            UP_PAIR(g0, l0, 0); UP_PAIR(g0, l0, 2); UP_PAIR(g1, l1, 0); UP_PAIR(g1, l1, 2);
#undef UP_PAIR
            { u32x2 w8; w8.x = pack_fp8x4_nc(g0[0], g0[1], g0[2], g0[3]); w8.y = pack_fp8x4_nc(g1[0], g1[1], g1[2], g1[3]);
              *(u32x2*)(ACT + (size_t)(u.pm * BM + rr) * 1024 + c0) = w8; }
        EPI_ROWS_END()
    }
};
struct EpiDown {
    static constexpr bool PRELOAD = false;
    unsigned char* YE;
    __device__ __forceinline__ void operator()(const f32x4 (&acc)[2][2][4][2], const Unit& u, int wr, int wc, int fr, int fq, const LAS float* side) const {
        f32x4 bdv[2][2];
#pragma unroll
        for (int bj = 0; bj < 2; ++bj) { bdv[bj][0] = *(const LAS f32x4*)(side + 256 + bj * HALF + wc * 32 + 8 * fq); bdv[bj][1] = *(const LAS f32x4*)(side + 256 + bj * HALF + wc * 32 + 8 * fq + 4); }
        EPI_ROWS_BEGIN()
            const float gt = side[rr] * Y8_SCALE;
#pragma unroll
            for (int bj = 0; bj < 2; ++bj) { const int col0 = u.pn * BM + bj * HALF + wc * 32 + 8 * fq;
                const f32x4 v0 = (acc[ai][bj][m][0] + bdv[bj][0]) * gt, v1 = (acc[ai][bj][m][1] + bdv[bj][1]) * gt;
                u32x2 w8; w8.x = pack_fp8x4(v0[0], v0[1], v0[2], v0[3]); w8.y = pack_fp8x4(v1[0], v1[1], v1[2], v1[3]);
                *(u32x2*)(YE + (size_t)(u.pm * BM + rr) * 1024 + col0) = w8; }
        EPI_ROWS_END()
    }
};
}

namespace att {
constexpr int NW = 8, QBLK = 32, KVBLK = 64, QB = 256;
constexpr int LDQ = 768, LDKN = 512, LDKP = 32, LDV = 512, LDO = 512;
constexpr int SHM_K = KVBLK * 256, SHM_V = KVBLK * 64 * 2;
constexpr int LDS_BYTES = 2 * SHM_V + 2 * SHM_K + NW * 64 * 4;
constexpr float SCALE = 0.10206207261596577f;
constexpr float THR = 8.f;
#define KSWZ(row, colB) ((row) * 256 + ((colB) ^ (((row) & 7) << 4)))
#define SBAR() __builtin_amdgcn_sched_barrier(0)
__device__ __forceinline__ int v_st(int k, int c) { const int kk = (k & ~0xC) | ((k & 4) << 1) | ((k & 8) >> 1); return ((kk >> 3) * 2 + (c >> 5)) * 512 + ((kk & 7) * 32 + (c & 31)) * 2; }
__device__ __forceinline__ int v_rd_base(int lane) { return ((lane & 3) << 3) | (((lane >> 2) & 3) << 6) | (((lane >> 4) & 1) << 5) | (((lane >> 5) & 1) << 8); }
__device__ __forceinline__ int crow(int r, int hi) { return (r & 3) + 8 * (r >> 2) + 4 * hi; }
__device__ __forceinline__ unsigned cvtpk(float lo, float hi) { return cvt_pk_bf16(lo, hi); }
__device__ __forceinline__ bf16x8 load8(const bf16_t* p) { return *reinterpret_cast<const bf16x8*>(p); }
__device__ __forceinline__ void mask_tile(f32x16& p0, f32x16& p1, int dq) {
    const float NEG = -__builtin_inff();
#pragma unroll
    for (int r = 0; r < 16; ++r) { const int c = (r & 3) + 8 * (r >> 2); if (c > dq) p0[r] = NEG; if (c + 32 > dq) p1[r] = NEG; }
}
__device__ __forceinline__ void mask_meta(f32x16& p0, f32x16& p1) {
    const float NEG = -__builtin_inff();
#pragma unroll
    for (int r = 8; r < 16; ++r) p0[r] = NEG;
#pragma unroll
    for (int r = 0; r < 16; ++r) p1[r] = NEG;
}
__device__ __forceinline__ void partialSM(f32x16& p0, f32x16& p1, float& m_reg, float& mn, float& alpha) {
    float pmax = p0[0];
#pragma unroll
    for (int r = 1; r < 16; ++r) pmax = fmaxf(pmax, p0[r]);
#pragma unroll
    for (int r = 0; r < 16; ++r) pmax = fmaxf(pmax, p1[r]);
    { auto rr = __builtin_amdgcn_permlane32_swap(__float_as_uint(pmax), __float_as_uint(pmax), false, false);
      pmax = fmaxf(__uint_as_float(rr[0]), __uint_as_float(rr[1])); }
    constexpr float C2 = 1.4426950408889634f * SCALE;
    if (__builtin_expect(__all((pmax - m_reg) * SCALE <= THR), 1)) { mn = m_reg; alpha = 1.f; }
    else { mn = fmaxf(m_reg, pmax); alpha = __builtin_amdgcn_exp2f((m_reg - mn) * C2); m_reg = mn; }
    const float mnL = -mn * C2;
    { const f32x2 c2v = {C2, C2}, mlv = {mnL, mnL};
#pragma unroll
      for (int r = 0; r < 16; r += 2) { f32x2 a = {p0[r], p0[r + 1]}, b = {p1[r], p1[r + 1]}; a = __builtin_elementwise_fma(a, c2v, mlv); b = __builtin_elementwise_fma(b, c2v, mlv);
          p0[r] = a.x; p0[r + 1] = a.y; p1[r] = b.x; p1[r + 1] = b.y; } }
#pragma unroll
    for (int r = 0; r < 16; ++r) p0[r] = __builtin_amdgcn_exp2f(p0[r]);
}
__device__ __forceinline__ void finishSM(f32x16& p0, f32x16& p1, float alpha, float& l_reg, bf16x8& pa0, bf16x8& pa1, bf16x8& pa2, bf16x8& pa3) {
#pragma unroll
    for (int r = 0; r < 16; ++r) p1[r] = __builtin_amdgcn_exp2f(p1[r]);
    float ps;
    { f32x2 s2 = {0.f, 0.f}, t2 = {0.f, 0.f};
#pragma unroll
      for (int r = 0; r < 16; r += 2) { s2 += (f32x2){p0[r], p0[r + 1]}; t2 += (f32x2){p1[r], p1[r + 1]}; }
      s2 += t2; ps = s2.x + s2.y; }
    { auto rr = __builtin_amdgcn_permlane32_swap(__float_as_uint(ps), __float_as_uint(ps), false, false);
      ps = __uint_as_float(rr[0]) + __uint_as_float(rr[1]); }
    l_reg = l_reg * alpha + ps;
#define PK4(P, B_, OUT) do { unsigned a0 = cvtpk(P[B_+0], P[B_+1]), a1 = cvtpk(P[B_+2], P[B_+3]);                          \
        unsigned b0 = cvtpk(P[B_+4], P[B_+5]), b1 = cvtpk(P[B_+6], P[B_+7]);                                             \
        auto r0 = __builtin_amdgcn_permlane32_swap(a0, b0, false, false); auto r1 = __builtin_amdgcn_permlane32_swap(a1, b1, false, false); \
        u32x4 w = {r0[0], r1[0], r0[1], r1[1]}; OUT = *reinterpret_cast<bf16x8*>(&w); } while (0)
    PK4(p0, 0, pa0); PK4(p0, 8, pa1); PK4(p1, 0, pa2); PK4(p1, 8, pa3);
#undef PK4
}
template <int KB>
__device__ __forceinline__ void qkt(f32x16& p0, f32x16& p1, const char* K_lds, int r32, int hi, const bf16x8* qr) {
    p0 = f32x16{}; p1 = f32x16{};
    const char* kb[4];
#pragma unroll
    for (int dd = 0; dd < 4; ++dd) kb[dd] = K_lds + KB * SHM_K + KSWZ(r32, (dd * 16 + hi * 8) * 2);
#pragma unroll
    for (int d0 = 0; d0 < 6; ++d0) { const char* a = kb[d0 & 3] + (d0 >> 2) * 128;
        bf16x8 b0 = *reinterpret_cast<const bf16x8*>(a);
        bf16x8 b1 = *reinterpret_cast<const bf16x8*>(a + 32 * 256);
        p0 = __builtin_amdgcn_mfma_f32_32x32x16_bf16(b0, qr[d0], p0, 0, 0, 0);
        p1 = __builtin_amdgcn_mfma_f32_32x32x16_bf16(b1, qr[d0], p1, 0, 0, 0); }
}
template <int VB>
__device__ __forceinline__ void pv_tile(f32x16* o, int vb0, bf16x8 pa0, bf16x8 pa1, bf16x8 pa2, bf16x8 pa3) {
#define TRRD(dst, off) asm volatile("ds_read_b64_tr_b16 %0, %1 offset:%2" : "=&v"(dst) : "v"(vb0), "i"(off) : "memory")
#define PV_D0(d0) do { s16x4 l0, l1, l2, l3, h0, h1, h2, h3; constexpr int b_ = VB * SHM_V + (d0) * 512;     \
        TRRD(l0, b_); TRRD(h0, b_ + 1024); TRRD(l1, b_ + 2048); TRRD(h1, b_ + 3072); TRRD(l2, b_ + 4096); TRRD(h2, b_ + 5120); TRRD(l3, b_ + 6144); TRRD(h3, b_ + 7168); \
        asm volatile("s_waitcnt lgkmcnt(0)" ::: "memory"); SBAR();   \
        o[d0] = __builtin_amdgcn_mfma_f32_32x32x16_bf16(pa0, (bf16x8){l0[0], l0[1], l0[2], l0[3], h0[0], h0[1], h0[2], h0[3]}, o[d0], 0, 0, 0);   \
        o[d0] = __builtin_amdgcn_mfma_f32_32x32x16_bf16(pa1, (bf16x8){l1[0], l1[1], l1[2], l1[3], h1[0], h1[1], h1[2], h1[3]}, o[d0], 0, 0, 0);   \
        o[d0] = __builtin_amdgcn_mfma_f32_32x32x16_bf16(pa2, (bf16x8){l2[0], l2[1], l2[2], l2[3], h2[0], h2[1], h2[2], h2[3]}, o[d0], 0, 0, 0);   \
        o[d0] = __builtin_amdgcn_mfma_f32_32x32x16_bf16(pa3, (bf16x8){l3[0], l3[1], l3[2], l3[3], h3[0], h3[1], h3[2], h3[3]}, o[d0], 0, 0, 0); } while (0)
    PV_D0(0); PV_D0(1);
#undef PV_D0
#undef TRRD
}
struct BlockRef { const bf16_t* Q; const bf16_t* KN; const bf16_t* KPE; const bf16_t* V; bf16_t* O; int P0; };
struct Seam { bf16x8 qr[6]; bf16x8 st_v[2], st_kn[2], st_kp[2]; };
#define VMW() asm volatile("s_waitcnt vmcnt(0)" ::: "memory")
#define VMWN(n) asm volatile("s_waitcnt vmcnt(%0)" :: "i"(n) : "memory")
#define VMW_KEEP1() asm volatile("s_waitcnt vmcnt(3)" ::: "memory")
#define SLOAD(ref, k0, X) do { S.st_v[X] = load8((ref).V + (size_t)((k0) + vr) * LDV + vc8); S.st_kn[X] = load8((ref).KN + (size_t)((k0) + vr) * LDKN + vc8); \
                            S.st_kp[X] = load8((ref).KPE + (size_t)((k0) + pr) * LDKP + pc8); } while (0)
#define SWRITE_K(bf, X) do { *(bf16x8*)(K_lds + (bf) * SHM_K + kws) = S.st_kn[X]; *(bf16x8*)(K_lds + (bf) * SHM_K + kpws) = S.st_kp[X]; } while (0)
#define SWRITE_V(bf, X) do { *(bf16x8*)(V_lds + (bf) * SHM_V + vst) = S.st_v[X]; } while (0)
__device__ __forceinline__ void attn_prime(const BlockRef& cur, char* lds, Seam& S, const int wid) {
    const int lane = lane_id_v(), tid = wid * 64 + lane, r32 = lane & 31, hi = lane >> 5;
    const int vr = tid >> 3, vc8 = (tid & 7) * 8, pr = (tid >> 2) & 63, pc8 = (tid & 3) * 8;
    const int kws = KSWZ(vr, vc8 * 2), kpws = KSWZ(pr, (64 + pc8) * 2); char* K_lds = lds + 2 * SHM_V;
#pragma unroll
    for (int d0 = 0; d0 < 6; ++d0) S.qr[d0] = load8(cur.Q + (size_t)(wid * QBLK + r32) * LDQ + d0 * 16 + hi * 8);
    SLOAD(cur, 0, 0); VMW(); SWRITE_K(0, 0);
    __syncthreads();
}
__device__ __forceinline__ void attn_block(const BlockRef& cur, const BlockRef& nxt, char* lds, Seam& S, const int wid) {
    const int lane = lane_id_v(), tid = wid * 64 + lane, r32 = lane & 31, hi = lane >> 5;
    const int NT = (cur.P0 + QB - 1) / KVBLK + 1;
    const int qlo = cur.P0 + wid * QBLK, qm = qlo + r32 - 4 * hi;
    char* V_lds = lds; char* K_lds = lds + 2 * SHM_V;
    float* ws = (float*)(lds + 2 * SHM_V + 2 * SHM_K) + wid * 64; float* li_l = ws, * al_l = ws + 32;
    float m_reg = -1e30f, l_reg = 0; f32x16 o[2] = {};
    const int vr = tid >> 3, vc8 = (tid & 7) * 8, pr = (tid >> 2) & 63, pc8 = (tid & 3) * 8;
    const int vst = v_st(vr, vc8), kws = KSWZ(vr, vc8 * 2), kpws = KSWZ(pr, (64 + pc8) * 2);
    const int vb0 = (int)(uintptr_t)V_lds + v_rd_base(lane);
#define RESC(a) do { if (__any((a) < 1.f)) { if (hi == 0) al_l[r32] = (a); asm volatile("s_waitcnt lgkmcnt(0)" ::: "memory");              \
                     _Pragma("unroll") for (int d_ = 0; d_ < 2; ++d_) _Pragma("unroll") for (int r = 0; r < 16; ++r) o[d_][r] *= al_l[crow(r, hi)]; } } while (0)
#define KBASE(t) ((t) * KVBLK)
#define MASKT(P0_, P1_, t) do { const int kb_ = KBASE(t); if ((t) == 0) mask_meta(P0_, P1_); else if (kb_ + KVBLK - 1 > qlo) mask_tile(P0_, P1_, qm - kb_); } while (0)
    constexpr int NQL = 6;
#define SEAM_K0() do { VMWN(NQL); SWRITE_K(0, 0); SBAR(); } while (0)
    f32x16 pA0, pA1, pB0, pB1; float mnA, mnB, alA, alB; bf16x8 pa0, pa1, pa2, pa3;
    SWRITE_V(0, 0); SBAR();
    SLOAD(cur, KBASE(1), 1); SBAR(); SLOAD(cur, KBASE(2), 0);
    SBAR(); qkt<0>(pA0, pA1, K_lds, r32, hi, S.qr);
    MASKT(pA0, pA1, 0); partialSM(pA0, pA1, m_reg, mnA, alA);
    VMW_KEEP1(); SWRITE_V(1, 1); SWRITE_K(1, 1);
    __syncthreads();
#define HALF_STEP(PX0, PX1, mnX, alX, PY0, PY1, alY, t, KB, VB, SB, XS, XL, LOADS, WRITES) do {                                              \
        SBAR(); qkt<KB>(PX0, PX1, K_lds, r32, hi, S.qr);                                                           \
        finishSM(PY0, PY1, alY, l_reg, pa0, pa1, pa2, pa3); SBAR();                                                           \
        if (LOADS) { SLOAD(cur, KBASE((t) + 2), XL); SBAR(); }                                               \
        pv_tile<VB>(o, vb0, pa0, pa1, pa2, pa3); MASKT(PX0, PX1, (t)); partialSM(PX0, PX1, m_reg, mnX, alX);                  \
        __syncthreads();                                                                                                      \
        if (WRITES) { if (LOADS) VMW_KEEP1(); else VMW(); SWRITE_V(SB, XS); SWRITE_K(SB, XS); }                                                                          \
        RESC(alX); __syncthreads(); } while (0)
    int t = 1;
    for (; t + 3 < NT; t += 2) {
        HALF_STEP(pB0, pB1, mnB, alB, pA0, pA1, alA, t, 1, 0, 0, 0, 1, true, true);
        HALF_STEP(pA0, pA1, mnA, alA, pB0, pB1, alB, t + 1, 0, 1, 1, 1, 0, true, true);
    }
    HALF_STEP(pB0, pB1, mnB, alB, pA0, pA1, alA, t, 1, 0, 0, 0, 1, false, true);
    HALF_STEP(pA0, pA1, mnA, alA, pB0, pB1, alB, t + 1, 0, 1, 1, 1, 0, false, false);
    SLOAD(nxt, 0, 0); SBAR();
#pragma unroll
    for (int d0 = 0; d0 < 6; ++d0) S.qr[d0] = load8(nxt.Q + (size_t)(wid * QBLK + r32) * LDQ + d0 * 16 + hi * 8);
    SBAR();
    finishSM(pA0, pA1, alA, l_reg, pa0, pa1, pa2, pa3); SBAR();
    pv_tile<0>(o, vb0, pa0, pa1, pa2, pa3);
    SBAR(); SEAM_K0();
    if (hi == 0) li_l[r32] = l_reg; asm volatile("s_waitcnt lgkmcnt(0)" ::: "memory");
    float rli[16];
#pragma unroll
    for (int r = 0; r < 16; ++r) rli[r] = __builtin_amdgcn_rcpf(li_l[crow(r, hi)]);
    bf16_t* Ow = cur.O + (size_t)(wid * QBLK) * LDO;
#pragma unroll
    for (int r = 0; r < 16; ++r) { const int orow = crow(r, hi);
#pragma unroll
        for (int d0 = 0; d0 < 2; ++d0) { const float v = o[d0][r] * rli[r];
            const float vn = __shfl_xor(v, 1);
            if ((r32 & 1) == 0) *(unsigned*)(Ow + (size_t)orow * LDO + d0 * 32 + r32) = cvtpk(v, vn); } }
    __syncthreads();
#undef RESC
#undef KBASE
#undef MASKT
#undef SEAM_K0
#undef HALF_STEP
}
#undef VMW_KEEP1
#undef VMW
#undef VMWN
#undef SLOAD
#undef SWRITE_K
#undef SWRITE_V
#undef KSWZ
#undef SBAR
}

constexpr int NWAVES = 8;
constexpr int N_PHASES = 13;
constexpr size_t MiB = 1u << 20;
constexpr size_t WS_CTL = 0, CTL_ZERO_BYTES = 64 * 1024;
constexpr size_t WS_WRP  = 1 * MiB;
constexpr size_t WS_WUQ  = 2 * MiB;
constexpr size_t WS_WUKV = 3 * MiB;
constexpr size_t WS_WG   = 4 * MiB;
constexpr size_t WS_WAO  = 5 * MiB;
constexpr size_t WS_WRO  = 6 * MiB;
constexpr size_t WS_WOUT = 8 * MiB;
constexpr size_t WS_WIN  = 10 * MiB;
constexpr size_t WS_WUP  = 20 * MiB;
constexpr size_t WS_WDN  = 148 * MiB;
constexpr size_t WS_ACT  = 212 * MiB;
constexpr size_t WS_GATE = 212 * MiB;
constexpr size_t WS_GRG  = 341 * MiB;
constexpr size_t WS_XN   = 406 * MiB;
constexpr size_t WS_XC   = WS_XN, WS_MA = WS_XN;
constexpr size_t WS_YE   = 484 * MiB;
constexpr size_t WS_PQ   = 484 * MiB;
constexpr size_t WS_Y    = 484 * MiB;
constexpr size_t WS_PRX  = 533 * MiB;
constexpr size_t WS_R16  = 598 * MiB;
constexpr size_t WS_MG   = 598 * MiB;
constexpr size_t WS_U16  = 663 * MiB;
constexpr size_t WS_CQ   = 728 * MiB;
constexpr size_t WS_H2   = 756 * MiB;
constexpr size_t WS_HB   = 884 * MiB;
constexpr size_t WS_Q    = 756 * MiB;
constexpr size_t WS_KN   = 804 * MiB;
constexpr size_t WS_V    = 837 * MiB;
constexpr size_t WS_O    = 870 * MiB;
constexpr size_t WS_CKV  = 902 * MiB;
constexpr size_t WS_KPE  = 919 * MiB;
constexpr size_t WS_ROPE = 922 * MiB;
constexpr size_t WS_AGF  = 924 * MiB;
constexpr size_t WS_AGC  = 932 * MiB;
constexpr size_t WS_ELIST = 948 * MiB;
constexpr size_t WS_RSTDS = 952 * MiB;
constexpr size_t WS_GATES = 956 * MiB;
constexpr size_t WS_TOKSL = 960 * MiB;
constexpr size_t WS_END   = 1024 * MiB;
constexpr int CW_BAR = 1024;
constexpr int CW_CNT = 8192;
constexpr int RING_BYTES = 131072;
constexpr int LDSCTL_OFF = RING_BYTES, MISC_OFF = LDSCTL_OFF + 64;
constexpr int LDS_BYTES = 151552;
constexpr int LT_TS = 64;
constexpr int LT_LCNT = 160, LT_LBASE = 192;

#define XB_TMO      128
#define XB_XCNT(j)  (256  + 64 * (j))
#define XB_XSUB(j)  (1280 + 64 * (j))
#define XB_XGEN(j)  (2304 + 64 * (j))
#define XB_TOP      3328
#define XB_TOPGEN   3392
#define XCD_BAR_WORDS 3456
#define XB_SPIN_CAP (1u << 18)
__device__ __forceinline__ unsigned xb_ld(unsigned* p)              { return __hip_atomic_load(p, __ATOMIC_RELAXED, __HIP_MEMORY_SCOPE_AGENT); }
__device__ __forceinline__ unsigned xb_add(unsigned* p, unsigned v) { return __hip_atomic_fetch_add(p, v, __ATOMIC_RELAXED, __HIP_MEMORY_SCOPE_AGENT); }
__device__ __forceinline__ unsigned xb_xcc_id() { return (unsigned)__builtin_amdgcn_s_getreg((3 << 11) | 20) & 0xFu; }
#define XB_SPIN(cond, bar) do { unsigned _sp = 0; while (cond) { __builtin_amdgcn_s_sleep(1); \
    if ((++_sp & 255u) == 0u) { if (xb_ld(&(bar)[XB_TMO])) break; if (_sp > XB_SPIN_CAP) { atomicAdd(&(bar)[XB_TMO], 1u); break; } } } } while (0)
struct XcdBarrier { unsigned* bar; unsigned x; volatile LAS unsigned* st; int wid; };
__device__ __forceinline__ XcdBarrier xcd_barrier_post(unsigned* bar, volatile LAS unsigned* st, const int wid) {
    XcdBarrier b; b.bar = bar; b.x = xb_xcc_id(); b.st = st; b.wid = wid;
    if (wid == 0 && lane_id_v() == 0) (void)xb_add(&bar[XB_XCNT(b.x)], 1u);
    return b;
}
__device__ __forceinline__ void xcd_barrier_complete(unsigned* bar, unsigned x, unsigned& nloc, unsigned& nx) {
    const unsigned G = gridDim.x * gridDim.y * gridDim.z;
    unsigned sum, cnt, mine, sp = 0u;
    for (;;) {
        sum = 0u; cnt = 0u; mine = 0u;
#pragma unroll
        for (unsigned j = 0; j < 16; ++j) { const unsigned c = xb_ld(&bar[XB_XCNT(j)]); sum += c; cnt += (c > 0u) ? 1u : 0u; mine = (j == x) ? c : mine; }
        if (sum == G) break;
        __builtin_amdgcn_s_sleep(1);
        if ((++sp & 255u) == 0u) { if (xb_ld(&bar[XB_TMO])) break; if (sp > XB_SPIN_CAP) { atomicAdd(&bar[XB_TMO], 1u); break; } }
    }
    nloc = mine > 0u ? mine : 1u; nx = cnt > 0u ? cnt : 1u;
}
__device__ __forceinline__ void xcd_barrier(const XcdBarrier& b) {
    asm volatile("s_waitcnt vmcnt(0)" ::: "memory");
    __syncthreads();
    if (b.wid == 0 && lane_id_v() == 0) {
        unsigned* bar = b.bar;
        __builtin_amdgcn_s_waitcnt(0);
        unsigned nloc = b.st[0], nx = b.st[1];
        if (nloc == 0u) { xcd_barrier_complete(bar, b.x, nloc, nx); b.st[0] = nloc; b.st[1] = nx; }
        const unsigned old = xb_add(&bar[XB_XSUB(b.x)], 1u);
        const unsigned gen = old / nloc;
        if (old + 1u == (gen + 1u) * nloc) {
            __builtin_amdgcn_fence(__ATOMIC_RELEASE, "agent");
            asm volatile("s_waitcnt vmcnt(0)" ::: "memory");
            const unsigned og = xb_add(&bar[XB_TOP], 1u);
            const unsigned tg = og / nx;
            if (og + 1u == (tg + 1u) * nx) xb_add(&bar[XB_TOPGEN], 1u);
            else XB_SPIN(xb_ld(&bar[XB_TOPGEN]) == tg, bar);
            __builtin_amdgcn_fence(__ATOMIC_ACQUIRE, "agent");
            xb_add(&bar[XB_XGEN(b.x)], 1u);
            asm volatile("s_waitcnt vmcnt(0)" ::: "memory");
        } else {
            XB_SPIN(xb_ld(&bar[XB_XGEN(b.x)]) == gen, bar);
            __builtin_amdgcn_fence(__ATOMIC_ACQUIRE, "agent");
            asm volatile("s_waitcnt vmcnt(0)" ::: "memory");
        }
    }
    __syncthreads();
}

struct Args {
    const float* in[27]; float* out; unsigned char* ws; double rope_inv[16]; int ph_lo, ph_hi;
};
enum { I_X = 0, I_META, I_NMG, I_WIN, I_BGATE, I_QNG, I_WUQ, I_KVNG, I_WUKV, I_WAO, I_CONVW, I_CONVB, I_WRGA, I_BRGA, I_WRGX, I_BRGX, I_LAMBDA, I_WRO, I_WOUT, I_NFG, I_WROUTER, I_BROUTER, I_WUP, I_BUP, I_WDOWN, I_BDOWN, I_NFINAL };

struct TMap { const float* W; int ldw; bf16_t* WT; int ldt; int nblk; int mode; const float* ks; };
__device__ __forceinline__ int tmap_col(int mode, int np) {
    if (mode == 0) return np;
    if (mode == 1) return np < 672 ? np : (np < 768 ? -1 : np - 96);
    if (mode == 2) { const int h = np / 96, o = np - 96 * h; if (o < 64) return np; const int p = o - 64; return 96 * h + 64 + (p & 1) * 16 + (p >> 1); }
    const int pn = np >> 8, w = np & 255; return w < 128 ? 128 * pn + w : 1024 + 128 * pn + (w - 128);
}
__device__ __forceinline__ void transpose_item(const TMap& mp, LAS float* scr, int item, int lane) {
    const int kb = item / mp.nblk, nb = item % mp.nblk, k0 = 64 * kb, n0 = 32 * nb;
    const int sc = tmap_col(mp.mode, n0 + (lane & 31));
#pragma unroll 8
    for (int i = 0; i < 32; ++i) { const int kk = 2 * i + (lane >> 5);
        float v = sc >= 0 ? mp.W[(size_t)(k0 + kk) * mp.ldw + sc] : 0.f;
        if (mp.ks) v *= mp.ks[k0 + kk];
        scr[kk * 33 + (lane & 31)] = v; }
    asm volatile("s_waitcnt lgkmcnt(0)" ::: "memory");
    const int c = lane & 7;
#pragma unroll
    for (int j = 0; j < 4; ++j) { const int n = (lane >> 3) + 8 * j; const LAS float* s = scr + (8 * c) * 33 + n;
        u32x4 o; o.x = cvt_pk_bf16(s[0 * 33], s[1 * 33]); o.y = cvt_pk_bf16(s[2 * 33], s[3 * 33]); o.z = cvt_pk_bf16(s[4 * 33], s[5 * 33]); o.w = cvt_pk_bf16(s[6 * 33], s[7 * 33]);
        *(u32x4*)(mp.WT + (size_t)(n0 + n) * mp.ldt + k0 + 8 * c) = o; }
    asm volatile("s_waitcnt lgkmcnt(0)" ::: "memory");
}
__device__ __forceinline__ void transpose_item2(const TMap& mp, LAS unsigned* scr, int item, int lane) {
    const int nblk = mp.nblk >> 2;
    const int kb = item / nblk, nb = item % nblk, k0 = 32 * kb, n0 = 128 * nb;
    const int nl = 4 * (lane & 31), hw = lane >> 5;
    const int sc = tmap_col(mp.mode, n0 + nl);
#pragma unroll
    for (int i = 0; i < 8; ++i) { const int k = k0 + 4 * i + 2 * hw;
        f32x4 a = {0.f, 0.f, 0.f, 0.f}, b = {0.f, 0.f, 0.f, 0.f};
        if (sc >= 0) { a = __builtin_nontemporal_load((const f32x4*)(mp.W + (size_t)k * mp.ldw + sc)); b = __builtin_nontemporal_load((const f32x4*)(mp.W + (size_t)(k + 1) * mp.ldw + sc)); }
        if (mp.ks) { a *= mp.ks[k]; b *= mp.ks[k + 1]; }
        const int kp = 2 * i + hw;
        scr[(nl + 0) * 17 + kp] = cvt_pk_bf16(a.x, b.x); scr[(nl + 1) * 17 + kp] = cvt_pk_bf16(a.y, b.y);
        scr[(nl + 2) * 17 + kp] = cvt_pk_bf16(a.z, b.z); scr[(nl + 3) * 17 + kp] = cvt_pk_bf16(a.w, b.w); }
    asm volatile("s_waitcnt lgkmcnt(0)" ::: "memory");
    const int c = lane & 3;
#pragma unroll
    for (int j = 0; j < 8; ++j) { const int n = (lane >> 2) + 16 * j; const LAS unsigned* sp = scr + n * 17 + 4 * c;
        u32x4 o; o.x = sp[0]; o.y = sp[1]; o.z = sp[2]; o.w = sp[3];
        *(u32x4*)(mp.WT + (size_t)(n0 + n) * mp.ldt + k0 + 8 * c) = o; }
    asm volatile("s_waitcnt lgkmcnt(0)" ::: "memory");
}
__device__ __forceinline__ void transpose_item8(const TMap& mp, LAS unsigned* scr, int item, int lane) {
    const int nblk = mp.nblk >> 2;
    const int kb = item / nblk, nb = item % nblk, k0 = 64 * kb, n0 = 128 * nb;
    const int nl = 4 * (lane & 31), hw = lane >> 5;
    const int sc = tmap_col(mp.mode, n0 + nl);
#pragma unroll
    for (int i = 0; i < 8; ++i) { const int k = k0 + 8 * i + 4 * hw;
        f32x4 r[4];
#pragma unroll
        for (int q = 0; q < 4; ++q) { r[q] = *(const f32x4*)(mp.W + (size_t)(k + q) * mp.ldw + sc); r[q] *= (mp.ks ? mp.ks[k + q] : 1.f) * W8_SCALE; }
        const int kq = 2 * i + hw;
#pragma unroll
        for (int j = 0; j < 4; ++j) scr[(nl + j) * 17 + kq] = pack_fp8x4(r[0][j], r[1][j], r[2][j], r[3][j]); }
    asm volatile("s_waitcnt lgkmcnt(0)" ::: "memory");
    const int c = lane & 3;
    unsigned char* WT8 = (unsigned char*)mp.WT;
#pragma unroll
    for (int j = 0; j < 8; ++j) { const int n = (lane >> 2) + 16 * j; const LAS unsigned* sp = scr + n * 17 + 4 * c;
        u32x4 o; o.x = sp[0]; o.y = sp[1]; o.z = sp[2]; o.w = sp[3];
        *(u32x4*)(WT8 + (size_t)(n0 + n) * mp.ldt + k0 + 16 * c) = o; }
    asm volatile("s_waitcnt lgkmcnt(0)" ::: "memory");
}
__device__ __forceinline__ void xpose8_block(const float* W, int ldw, int mode, int n0, int k0, unsigned char* dst  , LAS unsigned char* lds, int wave, int lane) {
    LAS unsigned* tile = (LAS unsigned*)lds;
    int sc[4];
#pragma unroll
    for (int j = 0; j < 4; ++j) sc[j] = tmap_col(mode, n0 + 256 * j + 4 * lane);
    const unsigned xo = (unsigned)(lane & 15) << 1;
    f32x4 XA[4][4], XB[4][4];
#define X8_LOAD(X_, qd) do { _Pragma("unroll") for (int r = 0; r < 4; ++r) _Pragma("unroll") for (int j = 0; j < 4; ++j) \
        X_[r][j] = __builtin_nontemporal_load((const f32x4*)(W + (size_t)(k0 + 64 * ((qd) >> 1) + 8 * wave + 4 * ((qd) & 1) + r) * ldw + sc[j])); } while (0)
#define X8_CVT(X_, qd) do { const unsigned kd = (unsigned)(16 * ((qd) >> 1) + 2 * wave + ((qd) & 1)); _Pragma("unroll") for (int j = 0; j < 4; ++j) _Pragma("unroll") for (int c = 0; c < 4; ++c) \
        tile[(256 * j + 4 * lane + c) * 32 + (kd ^ xo)] = pack_fp8x4(X_[0][j][c] * W8_SCALE, X_[1][j][c] * W8_SCALE, X_[2][j][c] * W8_SCALE, X_[3][j][c] * W8_SCALE); } while (0)
    X8_LOAD(XA, 0); X8_LOAD(XB, 1); __builtin_amdgcn_sched_barrier(0);
    X8_CVT(XA, 0); __builtin_amdgcn_sched_barrier(0); X8_LOAD(XA, 2); __builtin_amdgcn_sched_barrier(0);
    X8_CVT(XB, 1); __builtin_amdgcn_sched_barrier(0); X8_LOAD(XB, 3); __builtin_amdgcn_sched_barrier(0);
    X8_CVT(XA, 2); __builtin_amdgcn_sched_barrier(0); X8_CVT(XB, 3);
#undef X8_LOAD
#undef X8_CVT
    __syncthreads();
    const int t = wave * 64 + lane;
#pragma unroll 4
    for (int i = 0; i < 16; ++i) { const int id = t + 512 * i, row = id >> 3, q = id & 7; const unsigned xr = (unsigned)((row >> 2) & 15) << 1;
        const u32x2 a = *(const LAS u32x2*)(tile + row * 32 + ((4u * q) ^ xr)), b = *(const LAS u32x2*)(tile + row * 32 + ((4u * q + 2u) ^ xr));
        u32x4 o; o.x = a.x; o.y = a.y; o.z = b.x; o.w = b.y;
        *(u32x4*)(dst + (size_t)row * 1024 + 16 * q) = o; }
    __syncthreads();
}
__device__ __forceinline__ void rms_row_to_bf16(const float* xrow, const float* gain, bf16_t* orow, int lane) {
    const f32x4* xr = (const f32x4*)xrow + lane; const f32x4* gr = (const f32x4*)gain + lane;
    f32x4 v[4]; float s = 0.f;
#pragma unroll
    for (int j = 0; j < 4; ++j) { v[j] = xr[64 * j]; s += (v[j].x * v[j].x + v[j].y * v[j].y) + (v[j].z * v[j].z + v[j].w * v[j].w); }
    const float rstd = 1.f / sqrtf(wave_sum(s) * (1.f / 1024.f) + EPS);
    u32x2* o8 = (u32x2*)orow + lane;
#pragma unroll
    for (int j = 0; j < 4; ++j) { const f32x4 g = gr[64 * j]; u32x2 w; w.x = cvt_pk_bf16(v[j].x * rstd * g.x, v[j].y * rstd * g.y); w.y = cvt_pk_bf16(v[j].z * rstd * g.z, v[j].w * rstd * g.w); o8[64 * j] = w; }
}

__device__ __forceinline__ void build_moe_table(volatile LAS int* tbl, const unsigned* gcnt, const int wid) {
    const int t_ = wid * 64 + lane_id_v();
    __syncthreads();
    if (t_ < 32) tbl[LT_TS + 40 + t_] = (int)__hip_atomic_load(gcnt + t_, __ATOMIC_RELAXED, __HIP_MEMORY_SCOPE_AGENT);
    __syncthreads();
    if (t_ == 0) { int acc = 0; for (int e = 0; e < 32; ++e) { tbl[LT_TS + e] = acc; acc += (tbl[LT_TS + 40 + e] + 255) >> 8; } tbl[LT_TS + 32] = acc; }
    __syncthreads();
}

__device__ __forceinline__ att::BlockRef att_mkref(int item, int pass, bf16_t* QB, bf16_t* KN, bf16_t* KPE, bf16_t* VB, bf16_t* OB) {
    const int bh = item >> 4, x = item & 15, qb = pass ? 31 - x : x, b = bh >> 3, h = bh & 7;
    att::BlockRef r; r.Q = QB + ((size_t)b * 8192 + (size_t)qb * 256) * 768 + h * 96; r.KN = KN + (size_t)b * TP * 512 + h * 64; r.KPE = KPE + (size_t)b * TP * 32;
    r.V = VB + (size_t)b * TP * 512 + h * 64; r.O = OB + ((size_t)b * 8192 + (size_t)qb * 256) * 512 + h * 64; r.P0 = MBLK + 256 * qb; return r;
}
__device__ __forceinline__ void lru_step8(const h16x8 r, const h16x8 u, const float (&kc)[8], float (&h)[8], float (&A)[8]) {
#pragma unroll
    for (int j = 0; j < 8; ++j) { const float a = __builtin_amdgcn_exp2f((float)r[j] * kc[j]); const float b = __builtin_amdgcn_sqrtf(fmaxf(1.f - a * a, 0.f)) * (float)u[j]; h[j] = a * h[j] + b; A[j] *= a; }
}
__device__ __forceinline__ void lru_kc8(const float* lam, int ch, float (&kc)[8]) {
    const f32x4 l0 = *(const f32x4*)(lam + ch), l1 = *(const f32x4*)(lam + ch + 4); const float l[8] = {l0.x, l0.y, l0.z, l0.w, l1.x, l1.y, l1.z, l1.w};
#pragma unroll
    for (int j = 0; j < 8; ++j) { const float x = -l[j]; const float sp = x > 15.f ? x : log1pf(expf(x)); kc[j] = -8.f * sp * 1.4426950408889634f; }
}
__global__ void __launch_bounds__(NWAVES * 64, 2) mk_fwd(Args args) {
    extern __shared__ __attribute__((aligned(16))) unsigned char lds_raw[];
    LAS unsigned char* lds = (LAS unsigned char*)lds_raw;
    volatile LAS unsigned* MISC = (volatile LAS unsigned*)(lds + MISC_OFF);
    volatile LAS int* TBL = (volatile LAS int*)(lds + MISC_OFF);
    const int wave = __builtin_amdgcn_readfirstlane((int)threadIdx.x >> 6);
    const int G = gridDim.x; const int bx = blockIdx.x; const int vcu = (G % 8 == 0) ? (bx % 8) * (G / 8) + bx / 8 : bx;
    unsigned char* ws = args.ws;
    unsigned* ctl = (unsigned*)(ws + WS_CTL);
    for (int u = (int)threadIdx.x; u < (LDS_BYTES - LDSCTL_OFF) / 4; u += NWAVES * 64) ((LAS unsigned*)(lds + LDSCTL_OFF))[u] = 0u;
    __syncthreads();
    XcdBarrier bar; bar.bar = ctl + CW_BAR; bar.x = 0; bar.st = nullptr; bar.wid = wave;
    if (MK_N_LAUNCHES == 1) bar = xcd_barrier_post(ctl + CW_BAR, MISC, wave);
    const int lo = args.ph_lo, hi = args.ph_hi;
#define IN(k) (lo <= (k) && (k) < hi)
#define SEAM(k) do { if (IN(k) && IN((k) + 1)) xcd_barrier(bar); } while (0)
    bf16_t* WIN = (bf16_t*)(ws + WS_WIN); bf16_t* WUQ = (bf16_t*)(ws + WS_WUQ); bf16_t* WUKV = (bf16_t*)(ws + WS_WUKV); bf16_t* WG = (bf16_t*)(ws + WS_WG);
    bf16_t* WAO = (bf16_t*)(ws + WS_WAO); bf16_t* WRO = (bf16_t*)(ws + WS_WRO); bf16_t* WOUT = (bf16_t*)(ws + WS_WOUT); unsigned char* WUP8 = ws + WS_WUP; unsigned char* WDN8 = ws + WS_WDN;
    float* WRP = (float*)(ws + WS_WRP);
    bf16_t* XN = (bf16_t*)(ws + WS_XN); bf16_t* XC = (bf16_t*)(ws + WS_XC); bf16_t* MA = (bf16_t*)(ws + WS_MA);
    bf16_t* PQ = (bf16_t*)(ws + WS_PQ); bf16_t* PRX = (bf16_t*)(ws + WS_PRX); bf16_t* GRG = (bf16_t*)(ws + WS_GRG); bf16_t* GATE = (bf16_t*)(ws + WS_GATE);
    bf16_t* CQ = (bf16_t*)(ws + WS_CQ); bf16_t* CKV = (bf16_t*)(ws + WS_CKV); bf16_t* KPE = (bf16_t*)(ws + WS_KPE);
    float* COS = (float*)(ws + WS_ROPE); float* SIN = COS + TPOS * 16;
    bf16_t* QB = (bf16_t*)(ws + WS_Q); bf16_t* KN = (bf16_t*)(ws + WS_KN); bf16_t* VB = (bf16_t*)(ws + WS_V); bf16_t* OB = (bf16_t*)(ws + WS_O);
    _Float16* R16 = (_Float16*)(ws + WS_R16); _Float16* U16 = (_Float16*)(ws + WS_U16);
    float* AGF = (float*)(ws + WS_AGF); float* AGC = (float*)(ws + WS_AGC);
    bf16_t* YB = (bf16_t*)(ws + WS_Y); bf16_t* MG = (bf16_t*)(ws + WS_MG);
    bf16_t* H2 = (bf16_t*)(ws + WS_H2); unsigned char* H8 = ws + WS_HB;
    int* ELIST = (int*)(ws + WS_ELIST); float* RSTDS = (float*)(ws + WS_RSTDS); float* GATES = (float*)(ws + WS_GATES); int* TOKSL = (int*)(ws + WS_TOKSL);
    unsigned char* ACT = ws + WS_ACT; unsigned char* YE = ws + WS_YE;
    unsigned* GCNT = ctl + CW_CNT;
    const int gw = vcu * NWAVES + wave, NGW = G * NWAVES;
    const int NGT = G * NWAVES * 64;
#define PHASE_IDS() const int lane = lane_id_v(); const int tid = wave * 64 + lane; const int gt = vcu * (NWAVES * 64) + tid; (void)gt; (void)tid; (void)lane

    auto convert_tile = [&](const int it) {
        const int lane = lane_id_v();
        {
            if (it < 512) { const int e = it >> 4, kb = (it >> 1) & 7, nb = it & 1;
                xpose8_block(args.in[I_WUP] + (size_t)e * 1024 * 2048, 2048, 3, 1024 * nb, 128 * kb, WUP8 + (size_t)e * 2048 * 1024 + (size_t)(1024 * nb) * 1024 + 128 * kb, lds, wave, lane); }
            else { const int q = it - 512, e = q >> 3, kb = q & 7;
                xpose8_block(args.in[I_WDOWN] + (size_t)e * 1024 * 1024, 1024, 0, 0, 128 * kb, WDN8 + (size_t)e * 1024 * 1024 + 128 * kb, lds, wave, lane); }
        }
    };
    if (IN(0)) for (int rep_ = 0; rep_ < REP_P0; ++rep_) {
        if (rep_) xcd_barrier(bar);
        PHASE_IDS();
        LAS float* scr = (LAS float*)(lds + wave * 16384);
        {
            constexpr int I_1 = 32 * 38, I_3 = 8 * 8, I_4 = 16 * 8, I_5 = 32 * 8, I_6 = 32 * 8;
            constexpr int NITEMS = I_1 + I_3 + I_4 + I_5 + I_6;
            for (int it = gw; it < NITEMS; it += NGW) {
                int r = it; TMap mp;
                if (r < I_1) { mp = TMap{args.in[I_WIN], 4768, WIN, 1024, 152, 1, nullptr}; }
                else if ((r -= I_1) < I_3) { mp = TMap{args.in[I_WUKV], 1024, WUKV, 256, 32, 0, nullptr}; }
                else if ((r -= I_3) < I_4) { mp = TMap{args.in[I_WAO], 1024, WAO, 512, 32, 0, nullptr}; }
                else if ((r -= I_4) < I_5) { mp = TMap{args.in[I_WRO], 1024, WRO, 1024, 32, 0, nullptr}; }
                else { r -= I_5; mp = TMap{args.in[I_WOUT], 1024, WOUT, 1024, 32, 0, nullptr}; }
                transpose_item2(mp, (LAS unsigned*)scr, r, lane);
            }
            { const TMap mq = TMap{args.in[I_WUQ], 768, WUQ, 384, 24, 2, nullptr};
              for (int it = gw; it < 6 * 24; it += NGW) transpose_item(mq, scr, it, lane); }
        }
        __syncthreads();
        for (int idx = gt; idx < 8 * 256 * 256; idx += NGT) { const int b = idx >> 16, np = (idx >> 8) & 255, kp = idx & 255;
            float v = 0.f; if ((kp >> 7) == (b & 1)) { const int i = kp & 127; v = np < 128 ? args.in[I_WRGA][(b * 128 + i) * 128 + np] : args.in[I_WRGX][(b * 128 + i) * 128 + (np - 128)]; }
            WG[idx] = (bf16_t)(cvt_pk_bf16(v, 0.f) & 0xffffu); }
        for (int idx = gt; idx < 32768; idx += NGT) { const int k = idx >> 5, e = idx & 31; const float w = args.in[I_NFG][k] * args.in[I_WROUTER][k * 32 + e];
            const unsigned hb = cvt_pk_bf16(w, 0.f) & 0xffffu; const float hf = __uint_as_float(hb << 16); const unsigned lb = cvt_pk_bf16(w - hf, 0.f) & 0xffffu;
            const int pos = ((((k >> 5) * 2 + (e >> 4)) * 2) * 64 + ((((k >> 3) & 3) << 4) | (e & 15))) * 8 + (k & 7);
            ((unsigned short*)WRP)[pos] = (unsigned short)hb; ((unsigned short*)WRP)[pos + 512] = (unsigned short)lb; }
        for (int idx = gt; idx < TPOS * 16; idx += NGT) { const int t = idx >> 4, i = idx & 15; const double ang = (double)t * args.rope_inv[i] * 0.15915494309189535; const float rev = (float)(ang - floor(ang));
            COS[idx] = __builtin_amdgcn_cosf(rev); SIN[idx] = __builtin_amdgcn_sinf(rev); }
        { const f32x4* gr = (const f32x4*)args.in[I_NMG] + lane; f32x4 gn4[4];
#pragma unroll
          for (int j = 0; j < 4; ++j) gn4[j] = gr[64 * j];
          for (int m4 = gw * 4; m4 < RROWS; m4 += NGW * 4) {
              const int i4 = (m4 - NX) & 63;
              if (m4 >= NX && i4 >= NMETA) { const u32x2 z = {0u, 0u};
#pragma unroll
                  for (int r = 0; r < 4; ++r) { u32x2* o8 = (u32x2*)(XN + (size_t)(m4 + r) * 1024) + lane;
#pragma unroll
                      for (int j = 0; j < 4; ++j) o8[64 * j] = z; }
                  continue; }
              const float* src = m4 < NX ? args.in[I_X] + (size_t)m4 * 1024 : args.in[I_META] + (size_t)i4 * 1024;
              f32x4 v[4][4]; float ss[4];
#pragma unroll
              for (int r = 0; r < 4; ++r) { const f32x4* xr = (const f32x4*)(src + (size_t)r * 1024) + lane;
#pragma unroll
                  for (int j = 0; j < 4; ++j) v[r][j] = __builtin_nontemporal_load(xr + 64 * j); }
#pragma unroll
              for (int r = 0; r < 4; ++r) { float a = 0.f;
#pragma unroll
                  for (int j = 0; j < 4; ++j) a += (v[r][j].x * v[r][j].x + v[r][j].y * v[r][j].y) + (v[r][j].z * v[r][j].z + v[r][j].w * v[r][j].w);
                  ss[r] = a; }
#pragma unroll
              for (int o = 1; o < 64; o <<= 1) {
#pragma unroll
                  for (int r = 0; r < 4; ++r) ss[r] += __shfl_xor(ss[r], o); }
#pragma unroll
              for (int r = 0; r < 4; ++r) { const float rstd = 1.f / sqrtf(ss[r] * (1.f / 1024.f) + EPS); u32x2* o8 = (u32x2*)(XN + (size_t)(m4 + r) * 1024) + lane;
#pragma unroll
                  for (int j = 0; j < 4; ++j) { const f32x4 g = gn4[j]; u32x2 w; w.x = cvt_pk_bf16(v[r][j].x * rstd * g.x, v[r][j].y * rstd * g.y); w.y = cvt_pk_bf16(v[r][j].z * rstd * g.z, v[r][j].w * rstd * g.w); o8[64 * j] = w; } }
          }
        }
    }
    SEAM(0);
    if (IN(1)) {
        g8::PPlain g{XN, WIN, 2048u, 2048u, 16}; g8::StaticOrder S; S.init(RROWS, NPROJ, G, bx);
        g8::EpiProj E{PQ, PRX, GRG, GATE, args.in[I_BGATE]};
        for (int rep_ = 0; rep_ < REP_P1; ++rep_) { if (rep_) xcd_barrier(bar); g8::gemm_phase(lds, wave, g, S, E); }
    }
    SEAM(1);
    if (IN(2)) for (int rep_ = 0; rep_ < REP_P2; ++rep_) {
        if (rep_) xcd_barrier(bar);
        PHASE_IDS();
        const float* gq = args.in[I_QNG]; const float* gkv = args.in[I_KVNG];
        {
            const int l16 = lane & 15, rsub = lane >> 4;
            f32x4 gqv[3][2], gkvv[2][2];
#pragma unroll
            for (int j = 0; j < 3; ++j) { gqv[j][0] = *(const f32x4*)(gq + 8 * (l16 + 16 * j)); gqv[j][1] = *(const f32x4*)(gq + 8 * (l16 + 16 * j) + 4); }
#pragma unroll
            for (int j = 0; j < 2; ++j) { gkvv[j][0] = *(const f32x4*)(gkv + 8 * (l16 + 16 * j)); gkvv[j][1] = *(const f32x4*)(gkv + 8 * (l16 + 16 * j) + 4); }
            for (int gi = gw; gi < RROWS / 4; gi += NGW) {
                const int m = 4 * gi + rsub; const bf16_t* prow = PQ + (size_t)m * 768;
                u32x4 wq[3], wk[2];
#pragma unroll
                for (int j = 0; j < 3; ++j) wq[j] = *(const u32x4*)(prow + 8 * (l16 + 16 * j));
#pragma unroll
                for (int j = 0; j < 2; ++j) wk[j] = *(const u32x4*)(prow + 384 + 8 * (l16 + 16 * j));
                const float x1 = __uint_as_float((unsigned)prow[640 + l16] << 16), x2 = __uint_as_float((unsigned)prow[656 + l16] << 16);
                const int t = pos_of(m);
                const float cs = COS[t * 16 + l16], sn = SIN[t * 16 + l16];
                float sq = 0.f, sk = 0.f;
#pragma unroll
                for (int j = 0; j < 3; ++j) { const u32x4 w = wq[j]; sq += bf_lo(w.x) * bf_lo(w.x) + bf_hi(w.x) * bf_hi(w.x) + bf_lo(w.y) * bf_lo(w.y) + bf_hi(w.y) * bf_hi(w.y) + bf_lo(w.z) * bf_lo(w.z) + bf_hi(w.z) * bf_hi(w.z) + bf_lo(w.w) * bf_lo(w.w) + bf_hi(w.w) * bf_hi(w.w); }
#pragma unroll
                for (int j = 0; j < 2; ++j) { const u32x4 w = wk[j]; sk += bf_lo(w.x) * bf_lo(w.x) + bf_hi(w.x) * bf_hi(w.x) + bf_lo(w.y) * bf_lo(w.y) + bf_hi(w.y) * bf_hi(w.y) + bf_lo(w.z) * bf_lo(w.z) + bf_hi(w.z) * bf_hi(w.z) + bf_lo(w.w) * bf_lo(w.w) + bf_hi(w.w) * bf_hi(w.w); }
#pragma unroll
                for (int o = 1; o < 16; o <<= 1) { sq += __shfl_xor(sq, o); sk += __shfl_xor(sk, o); }
                const float rq = 1.f / sqrtf(sq * (1.f / 384.f) + EPS), rk = 1.f / sqrtf(sk * (1.f / 256.f) + EPS);
                if (m < NX) {
#pragma unroll
                    for (int j = 0; j < 3; ++j) { const u32x4 w = wq[j]; const f32x4 g0 = gqv[j][0], g1 = gqv[j][1]; u32x4 o;
                        o.x = cvt_pk_bf16(bf_lo(w.x) * rq * g0.x, bf_hi(w.x) * rq * g0.y); o.y = cvt_pk_bf16(bf_lo(w.y) * rq * g0.z, bf_hi(w.y) * rq * g0.w);
                        o.z = cvt_pk_bf16(bf_lo(w.z) * rq * g1.x, bf_hi(w.z) * rq * g1.y); o.w = cvt_pk_bf16(bf_lo(w.w) * rq * g1.z, bf_hi(w.w) * rq * g1.w);
                        *(u32x4*)(CQ + (size_t)m * 384 + 8 * (l16 + 16 * j)) = o; } }
#pragma unroll
                for (int j = 0; j < 2; ++j) { const u32x4 w = wk[j]; const f32x4 g0 = gkvv[j][0], g1 = gkvv[j][1]; u32x4 o;
                    o.x = cvt_pk_bf16(bf_lo(w.x) * rk * g0.x, bf_hi(w.x) * rk * g0.y); o.y = cvt_pk_bf16(bf_lo(w.y) * rk * g0.z, bf_hi(w.y) * rk * g0.w);
                    o.z = cvt_pk_bf16(bf_lo(w.z) * rk * g1.x, bf_hi(w.z) * rk * g1.y); o.w = cvt_pk_bf16(bf_lo(w.w) * rk * g1.z, bf_hi(w.w) * rk * g1.w);
                    *(u32x4*)(CKV + (size_t)m * 256 + 8 * (l16 + 16 * j)) = o; }
                *(unsigned*)(KPE + (size_t)kvrow_of(m) * 32 + 2 * l16) = cvt_pk_bf16(x1 * cs - x2 * sn, x1 * sn + x2 * cs);
            }
        }
        { const int rg = tid >> 7, ch = (tid & 127) * 8;
          float cw[4][8], cb[8];
#pragma unroll
          for (int k = 0; k < 4; ++k) { const f32x4 a = *(const f32x4*)(args.in[I_CONVW] + k * 1024 + ch), b = *(const f32x4*)(args.in[I_CONVW] + k * 1024 + ch + 4);
              cw[k][0] = a.x; cw[k][1] = a.y; cw[k][2] = a.z; cw[k][3] = a.w; cw[k][4] = b.x; cw[k][5] = b.y; cw[k][6] = b.z; cw[k][7] = b.w; }
          { const f32x4 a = *(const f32x4*)(args.in[I_CONVB] + ch), b = *(const f32x4*)(args.in[I_CONVB] + ch + 4); cb[0] = a.x; cb[1] = a.y; cb[2] = a.z; cb[3] = a.w; cb[4] = b.x; cb[5] = b.y; cb[6] = b.z; cb[7] = b.w; }
          for (int it = vcu; it < BATCH * 129; it += G) {
              const int b = it / 129, c = it % 129;
              if (c == 0 && rg > 0) continue;
              const int q0 = c == 0 ? 0 : NMETA + 64 * (c - 1) + 16 * rg;
              float w0[8], w1[8], w2[8];
#pragma unroll
              for (int j = 0; j < 8; ++j) { w0[j] = 0.f; w1[j] = 0.f; w2[j] = 0.f; }
#define SEQROW(q) ((q) < NMETA ? NX + 64 * b + (q) : b * 8192 + (q) - NMETA)
#define LDROW(dst, q) do { const u32x4 w_ = *(const u32x4*)(PRX + (size_t)SEQROW(q) * 1024 + ch); dst[0] = bf_lo(w_.x); dst[1] = bf_hi(w_.x); dst[2] = bf_lo(w_.y); dst[3] = bf_hi(w_.y); dst[4] = bf_lo(w_.z); dst[5] = bf_hi(w_.z); dst[6] = bf_lo(w_.w); dst[7] = bf_hi(w_.w); } while (0)
              if (q0 >= 3) { LDROW(w0, q0 - 3); LDROW(w1, q0 - 2); LDROW(w2, q0 - 1); }
              for (int i = 0; i < 16; ++i) { const int q = q0 + i; float cur[8]; LDROW(cur, q);
                  float o[8];
#pragma unroll
                  for (int j = 0; j < 8; ++j) o[j] = cb[j] + cw[0][j] * w0[j] + cw[1][j] * w1[j] + cw[2][j] * w2[j] + cw[3][j] * cur[j];
                  u32x4 ow; ow.x = cvt_pk_bf16(o[0], o[1]); ow.y = cvt_pk_bf16(o[2], o[3]); ow.z = cvt_pk_bf16(o[4], o[5]); ow.w = cvt_pk_bf16(o[6], o[7]);
                  *(u32x4*)(XC + (size_t)SEQROW(q) * 1024 + ch) = ow;
#pragma unroll
                  for (int j = 0; j < 8; ++j) { w0[j] = w1[j]; w1[j] = w2[j]; w2[j] = cur[j]; } }
#undef LDROW
          }
          for (int idx = gt; idx < BATCH * 48 * 128; idx += NGT) { const int b = idx / (48 * 128), r = (idx / 128) % 48, c8 = (idx & 127) * 8; u32x4 z = {0u, 0u, 0u, 0u}; *(u32x4*)(XC + (size_t)(NX + 64 * b + 16 + r) * 1024 + c8) = z; }
        }
    }
    SEAM(2);
    if (IN(3)) for (int rep_ = 0; rep_ < REP_P3; ++rep_) {
        if (rep_) xcd_barrier(bar);
        { g8::PPlain g{CQ, WUQ, 768u, 768u, 6}; g8::StaticOrder S; S.init(NX, 768, G, bx); g8::EpiQ E{QB, COS, SIN}; g8::gemm_phase(lds, wave, g, S, E); }
        { g8::PPlain g{CKV, WUKV, 512u, 512u, 4}; g8::StaticOrder S; S.init(RROWS, 1024, G, (bx + 128) % G); g8::EpiKV E{KN, VB}; g8::gemm_phase(lds, wave, g, S, E); }
        { g8::PGates g{XC, WG, 2048u, 512u, 4}; g8::StaticOrder S; S.init(RROWS, 2048, G, (bx + 136) % G); g8::EpiGates E{XC, args.in[I_BRGA], args.in[I_BRGX], R16, U16}; g8::gemm_phase(lds, wave, g, S, E); }
    }
    SEAM(3);
    if (IN(4)) for (int rep_ = 0; rep_ < REP_P4; ++rep_) {
        if (rep_) xcd_barrier(bar);
        PHASE_IDS();
        const int slot = tid >> 7, t7 = tid & 127, ch = t7 * 8;
        float kc[8]; lru_kc8(args.in[I_LAMBDA], ch, kc);
        LAS float* red = (LAS float*)lds;
        for (int it = vcu; it < BATCH * 64; it += G) {
            const int b = it >> 6, sc = it & 63, c = 4 * sc + slot;
            float h[8], A[8];
#pragma unroll
            for (int j = 0; j < 8; ++j) { h[j] = 0.f; A[j] = 1.f; }
            if (c == 0) {
#pragma unroll 4
                for (int i = 0; i < NMETA; ++i) { const size_t o = (size_t)(NX + 64 * b + i) * 1024 + ch; lru_step8(*(const h16x8*)(R16 + o), *(const h16x8*)(U16 + o), kc, h, A); } }
#pragma unroll 4
            for (int i = 0; i < 32; ++i) { const size_t o = (size_t)(b * 8192 + 32 * c + i) * 1024 + ch; lru_step8(*(const h16x8*)(R16 + o), *(const h16x8*)(U16 + o), kc, h, A); }
            float* fa = AGF + ((size_t)(b * 256 + c) * 2) * 1024 + ch;
            *(f32x4*)fa = (f32x4){A[0], A[1], A[2], A[3]}; *(f32x4*)(fa + 4) = (f32x4){A[4], A[5], A[6], A[7]};
            *(f32x4*)(fa + 1024) = (f32x4){h[0], h[1], h[2], h[3]}; *(f32x4*)(fa + 1028) = (f32x4){h[4], h[5], h[6], h[7]};
#pragma unroll
            for (int j = 0; j < 8; ++j) { red[(slot * 16 + j) * 128 + t7] = A[j]; red[(slot * 16 + 8 + j) * 128 + t7] = h[j]; }
            __syncthreads();
            if (slot == 0) { float At[8], Ht[8];
#pragma unroll
                for (int j = 0; j < 8; ++j) { At[j] = 1.f; Ht[j] = 0.f; }
#pragma unroll
                for (int q = 0; q < 4; ++q)
#pragma unroll
                    for (int j = 0; j < 8; ++j) { const float a = red[(q * 16 + j) * 128 + t7], hh = red[(q * 16 + 8 + j) * 128 + t7]; Ht[j] = a * Ht[j] + hh; At[j] *= a; }
                float* ca = AGC + ((size_t)(b * 64 + sc) * 2) * 1024 + ch;
                *(f32x4*)ca = (f32x4){At[0], At[1], At[2], At[3]}; *(f32x4*)(ca + 4) = (f32x4){At[4], At[5], At[6], At[7]};
                *(f32x4*)(ca + 1024) = (f32x4){Ht[0], Ht[1], Ht[2], Ht[3]}; *(f32x4*)(ca + 1028) = (f32x4){Ht[4], Ht[5], Ht[6], Ht[7]}; }
            __syncthreads();
        }
    }
    if (IN(4) && IN(5)) xcd_barrier(bar);
    if (IN(5)) {
        PHASE_IDS();
        {
            const int slot = tid >> 7, t7 = tid & 127, ch = t7 * 8;
            float kc[8]; lru_kc8(args.in[I_LAMBDA], ch, kc);
            for (int it = vcu; it < BATCH * 64; it += G) {
                const int b = it >> 6, sc = it & 63, c = 4 * sc + slot;
                float h[8], A[8];
#pragma unroll
                for (int j = 0; j < 8; ++j) { h[j] = 0.f; A[j] = 1.f; }
                { float Ac[8], Hc[8];
#pragma unroll
                  for (int j = 0; j < 8; ++j) { Ac[j] = 1.f; Hc[j] = 0.f; }
                  const int q1 = sc < 16 * slot + 16 ? sc : 16 * slot + 16;
#pragma unroll 4
                  for (int q = 16 * slot; q < q1; ++q) { const float* ca = AGC + ((size_t)(b * 64 + q) * 2) * 1024 + ch;
                      const f32x4 a0 = *(const f32x4*)ca, a1 = *(const f32x4*)(ca + 4), h0 = *(const f32x4*)(ca + 1024), h1 = *(const f32x4*)(ca + 1028);
                      const float av[8] = {a0.x, a0.y, a0.z, a0.w, a1.x, a1.y, a1.z, a1.w}, hv[8] = {h0.x, h0.y, h0.z, h0.w, h1.x, h1.y, h1.z, h1.w};
#pragma unroll
                      for (int j = 0; j < 8; ++j) { Hc[j] = av[j] * Hc[j] + hv[j]; Ac[j] *= av[j]; } }
                  LAS float* red = (LAS float*)lds;
                  __syncthreads();
#pragma unroll
                  for (int j = 0; j < 8; ++j) { red[(slot * 16 + j) * 128 + t7] = Ac[j]; red[(slot * 16 + 8 + j) * 128 + t7] = Hc[j]; }
                  __syncthreads();
#pragma unroll
                  for (int q = 0; q < 4; ++q)
#pragma unroll
                      for (int j = 0; j < 8; ++j) h[j] = red[(q * 16 + j) * 128 + t7] * h[j] + red[(q * 16 + 8 + j) * 128 + t7]; }
                for (int q = 0; q < slot; ++q) { const float* fa = AGF + ((size_t)(b * 256 + 4 * sc + q) * 2) * 1024 + ch;
                    const f32x4 a0 = *(const f32x4*)fa, a1 = *(const f32x4*)(fa + 4), h0 = *(const f32x4*)(fa + 1024), h1 = *(const f32x4*)(fa + 1028);
                    h[0] = a0.x * h[0] + h0.x; h[1] = a0.y * h[1] + h0.y; h[2] = a0.z * h[2] + h0.z; h[3] = a0.w * h[3] + h0.w;
                    h[4] = a1.x * h[4] + h1.x; h[5] = a1.y * h[5] + h1.y; h[6] = a1.z * h[6] + h1.z; h[7] = a1.w * h[7] + h1.w; }
                if (c == 0) {
#pragma unroll 4
                    for (int i = 0; i < NMETA; ++i) { const size_t o = (size_t)(NX + 64 * b + i) * 1024 + ch; lru_step8(*(const h16x8*)(R16 + o), *(const h16x8*)(U16 + o), kc, h, A); } }
#pragma unroll 4
                for (int i = 0; i < 32; ++i) { const size_t o = (size_t)(b * 8192 + 32 * c + i) * 1024 + ch;
                    lru_step8(__builtin_nontemporal_load((const h16x8*)(R16 + o)), __builtin_nontemporal_load((const h16x8*)(U16 + o)), kc, h, A);
                    const u32x4 gq = __builtin_nontemporal_load((const u32x4*)(GRG + o));
                    u32x4 yw; yw.x = cvt_pk_bf16(h[0] * bf_lo(gq.x), h[1] * bf_hi(gq.x)); yw.y = cvt_pk_bf16(h[2] * bf_lo(gq.y), h[3] * bf_hi(gq.y));
                    yw.z = cvt_pk_bf16(h[4] * bf_lo(gq.z), h[5] * bf_hi(gq.z)); yw.w = cvt_pk_bf16(h[6] * bf_lo(gq.w), h[7] * bf_hi(gq.w));
                    *(u32x4*)(YB + o) = yw; }
            }
        }
    }
    if (IN(5)) __syncthreads();
    int ctile = vcu;
    if (IN(5)) for (int rep_ = 0; rep_ < REP_P5; ++rep_) {
        if (rep_) xcd_barrier(bar);
        att::Seam S;
        const int nitems = BATCH * 8 * 16;
        int it = vcu;
        if (it < nitems) {
#define mkref(item_, pass_) att_mkref((item_), (pass_), QB, KN, KPE, VB, OB)
            int pass = 0; att::BlockRef cur = mkref(it, 0);
            att::attn_prime(cur, (char*)lds_raw, S, wave);
            for (;;) {
                const bool more_pass = pass == 0, more_item = it + G < nitems, last = !more_pass && !more_item;
                int itn = it, passn = 1; if (!more_pass) { passn = 0; itn = more_item ? it + G : it; }
                const att::BlockRef nxt = last ? cur : mkref(itn, passn);
                att::attn_block(cur, nxt, (char*)lds_raw, S, wave);
                if (last) break;
                cur = nxt; it = itn; pass = passn;
                if (ctile < 768 && pass == 1) { __syncthreads(); convert_tile(ctile); ctile += G; if (ctile < 768 && it == vcu) { __syncthreads(); convert_tile(ctile); ctile += G; } __syncthreads(); att::attn_prime(cur, (char*)lds_raw, S, wave); }
            }
        }
    }
#undef mkref
    if (IN(5)) { __syncthreads(); for (; ctile < 768; ctile += G) convert_tile(ctile); }
    SEAM(5);
    if (IN(6)) for (int rep_ = 0; rep_ < REP_P6; ++rep_) {
        if (rep_) xcd_barrier(bar);
        { g8::PPlain g{OB, WAO, 1024u, 1024u, 8}; g8::StaticOrder S; S.init(NX, 1024, G, bx); g8::EpiAo E{GATE, MA}; g8::gemm_phase(lds, wave, g, S, E); }
    }
    if (IN(6) && IN(7)) { asm volatile("s_waitcnt vmcnt(0)" ::: "memory"); __syncthreads(); }
    if (IN(7)) for (int rep_ = 0; rep_ < REP_P7; ++rep_) {
        if (rep_) xcd_barrier(bar);
        g8::PPlain g{YB, WRO, 2048u, 2048u, 16}; g8::StaticOrder S; S.init(NX, 1024, G, bx); g8::EpiRo E{GATE, MA, MG}; g8::gemm_phase(lds, wave, g, S, E);
    }
    SEAM(7);
    if (IN(8)) for (int rep_ = 0; rep_ < REP_P8; ++rep_) {
        if (rep_) xcd_barrier(bar);
        g8::PPlain g{MG, WOUT, 2048u, 2048u, 16}; g8::StaticOrder S; S.init(NX, 1024, G, bx); g8::EpiOut E{args.in[I_X], H2, H8, args.in[I_NFG]}; g8::gemm_phase(lds, wave, g, S, E);
    }
    SEAM(8);
    if (IN(9)) {
        PHASE_IDS();
        const int j16 = lane & 15, kq = lane >> 4;
        const int ngroups = NX / 16, per_round = G * NWAVES, nrounds = (ngroups + per_round - 1) / per_round;
        volatile LAS int* lcnt = TBL + LT_LCNT; volatile LAS int* lbase = TBL + LT_LBASE;
        for (int rd = 0; rd < nrounds; ++rd) {
            if (tid < 32) lcnt[tid] = 0;
            __syncthreads();
            const int gi = rd * per_round + vcu * NWAVES + wave; const bool active = gi < ngroups;
            int tok = 0; float rstd = 0.f; float tv[4] = {0.f, 0.f, 0.f, 0.f}; int ti[4] = {0, 0, 0, 0}; int sl[4] = {0, 0, 0, 0};
            if (active) {
                tok = gi * 16 + j16;
                const bf16_t* hrow = H2 + (size_t)tok * 1024 + kq * 8;
                const bf16_t* wh = (const bf16_t*)WRP + lane * 8;
                f32x4 acc0 = {0.f, 0.f, 0.f, 0.f}, acc1 = {0.f, 0.f, 0.f, 0.f}; float ss = 0.f;
#pragma unroll 4
                for (int c = 0; c < 32; ++c) {
                    const bf16x8 hv = *(const bf16x8*)(hrow + c * 32);
                    const bf16x8 a0h = *(const bf16x8*)(wh + c * 2048), a0l = *(const bf16x8*)(wh + c * 2048 + 512), a1h = *(const bf16x8*)(wh + c * 2048 + 1024), a1l = *(const bf16x8*)(wh + c * 2048 + 1536);
                    { const u32x4 hw_ = __builtin_bit_cast(u32x4, hv);
#pragma unroll
                      for (int q = 0; q < 4; ++q) { const float x0 = bf_lo(hw_[q]), x1 = bf_hi(hw_[q]); ss += x0 * x0; ss += x1 * x1; } }
                    acc0 = __builtin_amdgcn_mfma_f32_16x16x32_bf16(a0h, hv, acc0, 0, 0, 0); acc1 = __builtin_amdgcn_mfma_f32_16x16x32_bf16(a1h, hv, acc1, 0, 0, 0);
                    acc0 = __builtin_amdgcn_mfma_f32_16x16x32_bf16(a0l, hv, acc0, 0, 0, 0); acc1 = __builtin_amdgcn_mfma_f32_16x16x32_bf16(a1l, hv, acc1, 0, 0, 0);
                }
                ss += __shfl_xor(ss, 16); ss += __shfl_xor(ss, 32);
                rstd = 1.f / sqrtf(ss * (1.f / 1024.f) + EPS);
                float cv[8]; int ci[8];
                const f32x4 b0 = *(const f32x4*)(args.in[I_BROUTER] + 4 * kq), b1 = *(const f32x4*)(args.in[I_BROUTER] + 16 + 4 * kq);
#pragma unroll
                for (int r = 0; r < 4; ++r) { cv[r] = acc0[r] * rstd + b0[r]; ci[r] = 4 * kq + r; cv[4 + r] = acc1[r] * rstd + b1[r]; ci[4 + r] = 16 + 4 * kq + r; }
                const float NEG = -__builtin_inff();
#define TOP4_OF8() do { _Pragma("unroll") for (int s_ = 0; s_ < 4; ++s_) { float bv_ = cv[0]; int bi_ = ci[0]; \
                    _Pragma("unroll") for (int c_ = 1; c_ < 8; ++c_) { const bool bt_ = cv[c_] > bv_ || (cv[c_] == bv_ && ci[c_] < bi_); bv_ = bt_ ? cv[c_] : bv_; bi_ = bt_ ? ci[c_] : bi_; } \
                    tv[s_] = bv_; ti[s_] = bi_; _Pragma("unroll") for (int c_ = 0; c_ < 8; ++c_) if (ci[c_] == bi_) cv[c_] = NEG; } } while (0)
                TOP4_OF8();
#pragma unroll
                for (int step = 16; step <= 32; step <<= 1) {
#pragma unroll
                    for (int s = 0; s < 4; ++s) { cv[s] = tv[s]; ci[s] = ti[s]; cv[4 + s] = __shfl_xor(tv[s], step); ci[4 + s] = __shfl_xor(ti[s], step); }
                    TOP4_OF8();
                }
#undef TOP4_OF8
                { const float mx = tv[0]; float e[4], sum = 0.f;
#pragma unroll
                  for (int s = 0; s < 4; ++s) { e[s] = __builtin_amdgcn_exp2f((tv[s] - mx) * 1.4426950408889634f); sum += e[s]; }
                  const float inv = 1.f / sum;
#pragma unroll
                  for (int s = 0; s < 4; ++s) tv[s] = e[s] * inv; }
                if (kq == 0) {
#pragma unroll
                    for (int s = 0; s < 4; ++s) sl[s] = __hip_atomic_fetch_add((LAS int*)(lcnt + ti[s]), 1, __ATOMIC_RELAXED, __HIP_MEMORY_SCOPE_WORKGROUP);
                }
            }
            __syncthreads();
            if (tid < 32) lbase[tid] = (int)__hip_atomic_fetch_add(GCNT + tid, (unsigned)lcnt[tid], __ATOMIC_RELAXED, __HIP_MEMORY_SCOPE_AGENT);
            __syncthreads();
            if (active && kq == 0) {
#pragma unroll
                for (int s = 0; s < 4; ++s) { const int e = ti[s], pos = lbase[e] + sl[s];
                    ELIST[e * ECAP + pos] = tok; RSTDS[e * ECAP + pos] = rstd; GATES[e * ECAP + pos] = tv[s]; TOKSL[tok * 4 + s] = (e << 20) | pos; }
            }
            __syncthreads();
        }
    }
    SEAM(9);
    if (IN(10)) {
        build_moe_table(TBL, GCNT, wave);
        g8::PUp g{H8, WUP8, ELIST, 1024u, 1024u, 8, 124, RSTDS, args.in[I_BUP]};   g8::MoeOrder S{TBL + LT_TS, 8, G, vcu}; g8::EpiUp E{ACT}; for (int rep_ = 0; rep_ < REP_P10; ++rep_) { if (rep_) xcd_barrier(bar); g8::gemm_phase(lds, wave, g, S, E); }
    }
    SEAM(10);
    if (IN(11)) {
        build_moe_table(TBL, GCNT, wave);
        g8::PDown g{ACT, WDN8, 1024u, 1024u, 8, 123, GATES, args.in[I_BDOWN]};   g8::MoeOrder S{TBL + LT_TS, 4, G, vcu}; g8::EpiDown E{YE}; for (int rep_ = 0; rep_ < REP_P11; ++rep_) { if (rep_) xcd_barrier(bar); g8::gemm_phase(lds, wave, g, S, E); }
    }
    SEAM(11);
    if (IN(12)) for (int rep_ = 0; rep_ < REP_P12; ++rep_) {
        if (rep_) xcd_barrier(bar);
        build_moe_table(TBL, GCNT, wave);
        const int lane = lane_id_v();
        const float* gf = args.in[I_NFINAL];
        unsigned poison = 0u;
        if (MK_N_LAUNCHES == 1) poison = xb_ld(&bar.bar[XB_TMO]);
        f32x4 gfin[4];
#pragma unroll
        for (int j = 0; j < 4; ++j) gfin[j] = ((const f32x4*)gf)[64 * j + lane];
        for (int gi = gw; gi < NX / 16; gi += NGW) {
            const int m0 = gi * 16;
            const int tsw = TOKSL[m0 * 4 + lane];
            const int yrow = TBL[LT_TS + (tsw >> 20)] * 256 + (tsw & 0xfffff);
#pragma unroll 1
            for (int r = 0; r < 16; r += 2) {
                f32x4 v[2][4]; unsigned w[2][4][4];
#pragma unroll
                for (int q = 0; q < 2; ++q) { const u32x2* hr = (const u32x2*)(H2 + (size_t)(m0 + r + q) * 1024) + lane;
#pragma unroll
                    for (int j = 0; j < 4; ++j) { const u32x2 hw_ = hr[64 * j]; v[q][j] = (f32x4){bf_lo(hw_.x), bf_hi(hw_.x), bf_lo(hw_.y), bf_hi(hw_.y)}; }
#pragma unroll
                    for (int k = 0; k < 4; ++k) { const int yr_ = __shfl(yrow, 4 * (r + q) + k); const unsigned* yr = (const unsigned*)(YE + (size_t)yr_ * 1024) + lane;
#pragma unroll
                        for (int j = 0; j < 4; ++j) w[q][k][j] = yr[64 * j]; } }
#pragma unroll
                for (int q = 0; q < 2; ++q) {
#pragma unroll
                    for (int k = 0; k < 4; ++k)
#pragma unroll
                        for (int j = 0; j < 4; ++j) { const f32x2 lo = __builtin_amdgcn_cvt_pk_f32_fp8((int)w[q][k][j], false), hi = __builtin_amdgcn_cvt_pk_f32_fp8((int)w[q][k][j], true);
                            v[q][j] += (f32x4){lo.x, lo.y, hi.x, hi.y} * (1.f / Y8_SCALE); }
                    float s = 0.f;
#pragma unroll
                    for (int j = 0; j < 4; ++j) s += (v[q][j].x * v[q][j].x + v[q][j].y * v[q][j].y) + (v[q][j].z * v[q][j].z + v[q][j].w * v[q][j].w);
                    float rstd = 1.f / sqrtf(wave_sum(s) * (1.f / 1024.f) + EPS);
                    if (poison) rstd = __builtin_nanf("");
                    f32x4* orow = (f32x4*)(args.out + (size_t)(m0 + r + q) * 1024) + lane;
#pragma unroll
                    for (int j = 0; j < 4; ++j) orow[64 * j] = v[q][j] * rstd * gfin[j];
                }
            }
        }
    }
#undef IN
#undef SEAM
#undef SEQROW
}

extern "C" void kernel_launch(void* const* d_in, const int* in_sizes, int n_in, void* d_out, int out_size, void* d_ws, size_t ws_size, hipStream_t stream) {
    static int grid = 0;
    if (grid == 0) {
        if (n_in != 27 || in_sizes[0] != NX * DM || out_size != NX * DM || ws_size < WS_END) { fprintf(stderr, "kernel_launch: unexpected shapes (n_in %d, in0 %d, out %d, ws %zu)\n", n_in, n_in > 0 ? in_sizes[0] : -1, out_size, ws_size); grid = -1; return; }
        int dev = 0, cus = 0, per_cu = 0;
        if (hipGetDevice(&dev) != hipSuccess || hipDeviceGetAttribute(&cus, hipDeviceAttributeMultiprocessorCount, dev) != hipSuccess) { grid = -1; return; }
        if (hipFuncSetAttribute((const void*)mk_fwd, hipFuncAttributeMaxDynamicSharedMemorySize, LDS_BYTES) != hipSuccess) { fprintf(stderr, "kernel_launch: hipFuncSetAttribute failed\n"); grid = -1; return; }
        if (hipOccupancyMaxActiveBlocksPerMultiprocessor(&per_cu, (const void*)mk_fwd, NWAVES * 64, LDS_BYTES) != hipSuccess || per_cu < 1) fprintf(stderr, "kernel_launch: occupancy query reports %d\n", per_cu);
        (void)hipGetLastError();
        grid = cus;
    }
    if (grid < 0) return;
    if (hipMemsetAsync((char*)d_ws + WS_CTL, 0, CTL_ZERO_BYTES, stream) != hipSuccess) { fprintf(stderr, "kernel_launch: memset failed\n"); return; }
    Args a{};
    for (int i = 0; i < 27; ++i) a.in[i] = (const float*)d_in[i];
    a.out = (float*)d_out; a.ws = (unsigned char*)d_ws;
    for (int i = 0; i < 16; ++i) a.rope_inv[i] = pow(10000.0, -(double)(2 * i) / 32.0);
    if (MK_N_LAUNCHES == 1) { a.ph_lo = 0; a.ph_hi = N_PHASES; hipLaunchKernelGGL(mk_fwd, dim3(grid), dim3(NWAVES * 64), LDS_BYTES, stream, a); }
    else for (int p = 0; p < N_PHASES; ++p) { a.ph_lo = p; a.ph_hi = p + 1; hipLaunchKernelGGL(mk_fwd, dim3(grid), dim3(NWAVES * 64), LDS_BYTES, stream, a); }
    const hipError_t le = hipPeekAtLastError();
    if (le != hipSuccess) fprintf(stderr, "kernel_launch: launch failed: %s\n", hipGetErrorName(le));
}
```

```cpp
#include <hip/hip_runtime.h>
#include <hip/hip_bf16.h>
#include <cstdio>
#include <cstdint>
#include <cmath>

#ifndef REP_P0
#define REP_P0 1
#endif
#ifndef REP_P1
#define REP_P1 1
#endif
#ifndef REP_P5
#define REP_P5 1
#endif
#ifndef REP_P10
#define REP_P10 1
#endif
#ifndef REP_P11
#define REP_P11 1
#endif
#ifndef REP_P2
#define REP_P2 1
#endif
#ifndef REP_P3
#define REP_P3 1
#endif
#ifndef REP_P4
#define REP_P4 1
#endif
#ifndef REP_P6
#define REP_P6 1
#endif
#ifndef REP_P7
#define REP_P7 1
#endif
#ifndef REP_P8
#define REP_P8 1
#endif
#ifndef REP_P12
#define REP_P12 1
#endif
#ifndef MK_N_LAUNCHES
#define MK_N_LAUNCHES 1
#endif

#define LAS __attribute__((address_space(3)))
#define GAS __attribute__((address_space(1)))
typedef unsigned short bf16_t;
typedef short bf16x8 __attribute__((ext_vector_type(8)));
typedef short s16x4 __attribute__((ext_vector_type(4)));
typedef float f32x2 __attribute__((ext_vector_type(2)));
typedef float f32x4 __attribute__((ext_vector_type(4)));
typedef float f32x16 __attribute__((ext_vector_type(16)));
typedef unsigned u32x2 __attribute__((ext_vector_type(2)));
typedef unsigned u32x4 __attribute__((ext_vector_type(4)));
typedef int i32x4 __attribute__((ext_vector_type(4)));
typedef int i32x8 __attribute__((ext_vector_type(8)));
typedef _Float16 h16x2 __attribute__((ext_vector_type(2)));
typedef _Float16 h16x8 __attribute__((ext_vector_type(8)));

constexpr int BATCH = 4, SEQ = 8192, DM = 1024, NX = BATCH * SEQ;
constexpr int NMETA = 16, MBLK = 64;
constexpr int RROWS = NX + BATCH * MBLK;
constexpr int TP = MBLK + SEQ;
constexpr int TPOS = NMETA + SEQ;
constexpr int NPROJ = 4864;
constexpr int NEXP = 32, ECAP = 32768;
constexpr int PROWS = 544 * 256;
constexpr float EPS = 1e-6f;

__device__ __forceinline__ float bf_lo(unsigned w) { return __uint_as_float(w << 16); }
__device__ __forceinline__ float bf_hi(unsigned w) { return __uint_as_float(w & 0xffff0000u); }
typedef __bf16 bf16x2_t __attribute__((ext_vector_type(2)));
__device__ __forceinline__ unsigned cvt_pk_bf16(float lo, float hi) { f32x2 v = {lo, hi}; bf16x2_t b = __builtin_convertvector(v, bf16x2_t); return __builtin_bit_cast(unsigned, b); }
__device__ __forceinline__ unsigned pack_fp8x4(float a, float b, float c, float d) {
    a = fminf(fmaxf(a, -448.f), 448.f); b = fminf(fmaxf(b, -448.f), 448.f); c = fminf(fmaxf(c, -448.f), 448.f); d = fminf(fmaxf(d, -448.f), 448.f);
    int w = 0; w = __builtin_amdgcn_cvt_pk_fp8_f32(a, b, w, false); w = __builtin_amdgcn_cvt_pk_fp8_f32(c, d, w, true); return (unsigned)w;
}
__device__ __forceinline__ unsigned pack_fp8x4_nc(float a, float b, float c, float d) {
    int w = 0; w = __builtin_amdgcn_cvt_pk_fp8_f32(a, b, w, false); w = __builtin_amdgcn_cvt_pk_fp8_f32(c, d, w, true); return (unsigned)w;
}
constexpr float W8_SCALE = 64.f;
constexpr float A8_SCALE = 4.f;
constexpr float Y8_SCALE = 16.f;
__device__ __forceinline__ float sigm(float x) { return __builtin_amdgcn_rcpf(1.f + __builtin_amdgcn_exp2f(-1.4426950408889634f * x)); }
__device__ __forceinline__ float gelu_tanh(float v) { const float z = v + 0.044715f * v * v * v; return v * __builtin_amdgcn_rcpf(1.f + __builtin_amdgcn_exp2f(-2.3022082f * z)); }
__device__ __forceinline__ f32x2 sigm2_scaled(f32x2 e  ) { e.x = __builtin_amdgcn_exp2f(e.x); e.y = __builtin_amdgcn_exp2f(e.y); e += (f32x2){1.f, 1.f}; e.x = __builtin_amdgcn_rcpf(e.x); e.y = __builtin_amdgcn_rcpf(e.y); return e; }
__device__ __forceinline__ f32x2 sigm2_bias(f32x2 x, f32x2 nb  ) { const f32x2 k = {-1.4426950408889634f, -1.4426950408889634f}; return sigm2_scaled(__builtin_elementwise_fma(x, k, nb)); }
__device__ __forceinline__ f32x2 gelu_tanh2(f32x2 v) { const f32x2 c1 = {-2.3022082f * 0.044715f, -2.3022082f * 0.044715f}, c0 = {-2.3022082f, -2.3022082f};
    const f32x2 u = __builtin_elementwise_fma(v * v, c1, c0); return v * sigm2_scaled(v * u); }
__device__ __forceinline__ int kvrow_of(int m) { return m < NX ? (m >> 13) * TP + MBLK + (m & 8191) : ((m - NX) >> 6) * TP + ((m - NX) & 63); }
__device__ __forceinline__ int pos_of(int m) { return m < NX ? NMETA + (m & 8191) : ((m - NX) & 63); }
__device__ __forceinline__ int lane_id_v() { int l; asm volatile("v_mbcnt_lo_u32_b32 %0, -1, 0\n\tv_mbcnt_hi_u32_b32 %0, -1, %0" : "=v"(l)); return l; }
__device__ __forceinline__ float wave_sum(float v) {
#pragma unroll
    for (int o = 1; o < 64; o <<= 1) v += __shfl_xor(v, o);
    return v;
}

__device__ __forceinline__ void glds16_s(const void* sbase, unsigned voff, unsigned lds_dst) {
    unsigned keep;
    asm volatile("s_mov_b32 %0, m0\n\ts_mov_b32 m0, %3\n\ts_nop 0\n\tglobal_load_lds_dwordx4 %1, %2\n\ts_mov_b32 m0, %0" : "=&s"(keep) : "v"(voff), "s"(sbase), "s"(lds_dst) : "memory");
}
__device__ __forceinline__ void glds4_s(const void* sbase, unsigned voff, unsigned lds_dst) {
    unsigned keep;
    asm volatile("s_mov_b32 %0, m0\n\ts_mov_b32 m0, %3\n\ts_nop 0\n\tglobal_load_lds_dword %1, %2\n\ts_mov_b32 m0, %0" : "=&s"(keep) : "v"(voff), "s"(sbase), "s"(lds_dst) : "memory");
}
namespace g8 {
constexpr int BM = 256, BK = 64, HALF = 128, HTB = HALF * BK * 2, STAGE_BYTES = 8 * HTB, NXCD = 8, WGM = 8;
__host__ __device__ __forceinline__ int lds_byte(int r, int c) { const int st = (r >> 4) * 2 + (c >> 5), rr = r & 15, cc = c & 31, ob = rr * 64 + cc * 2; return st * 1024 + (ob ^ (((ob >> 9) & 1) << 5)); }
__host__ __device__ __forceinline__ void stage_rc(int b, int& R, int& C) { const int st = b / 1024, sb = b % 1024, swz = sb ^ (((sb >> 9) & 1) << 5); R = (st >> 1) * 16 + swz / 64; C = (st & 1) * 32 + (swz % 64) / 2; }
__host__ __device__ __forceinline__ int perm32(int rho) { const int n = rho >> 4, i = rho & 15; return 8 * (i >> 2) + 4 * n + (i & 3); }

struct Unit { int pm, pn, e, mt, rem; };

struct StaticOrder {
    int nM, nN, nwg, G, c;
    __device__ void init(int M, int N, int G_, int c_) { nM = M / BM; nN = N / BM; nwg = nM * nN; G = G_; c = c_; }
    __device__ bool next(int i, Unit& u) const {
        const long L = (long)i * G + c; if (L >= nwg) return false;
        int wgid = (int)L; { const int q = nwg / NXCD, r = nwg % NXCD, xcd = wgid % NXCD, off = wgid / NXCD; wgid = (xcd < r ? xcd * (q + 1) : r * (q + 1) + (xcd - r) * q) + off; }
        const int nig = WGM * nN, gid = wgid / nig, fm = gid * WGM, gsz = (nM - fm) < WGM ? (nM - fm) : WGM;
        u.pm = fm + ((wgid % nig) % gsz); u.pn = (wgid % nig) / gsz; u.e = 0; u.mt = 0; u.rem = 256; return true;
    }
};
struct MoeOrder {
    const volatile LAS int* ts; int npn, G, vcu;
    __device__ bool next(int i, Unit& u) const {
        const long L = (long)i * G + vcu; const int g = (int)(L / npn), pn = (int)(L % npn);
        const int el = lane_id_v() & 31;
        const volatile LAS int* tl = ts + el;
        const int lo = tl[0], hi = tl[1], cn = tl[40];
        if (g >= __builtin_amdgcn_readlane(hi, 31)) return false;
        const unsigned long long mk = __ballot(lo <= g && g < hi);
        const int e = mk ? (int)__builtin_ctzll(mk) : 0;
        u.pm = g; u.pn = pn; u.e = e; u.mt = g - __builtin_amdgcn_readlane(lo, e); u.rem = __builtin_amdgcn_readlane(cn, e) - u.mt * 256; return true;
    }
};

struct PPlain { static constexpr bool GATHER = false, FP8 = false, SIDE = false; const bf16_t* A; const bf16_t* Bt; unsigned lda2, ldb2; int nt;
    __device__ __forceinline__ const char* a_tile(const Unit& u) const { return (const char*)A + (size_t)u.pm * 256 * lda2; }
    __device__ __forceinline__ const char* b_tile(const Unit& u) const { return (const char*)Bt + (size_t)u.pn * 256 * ldb2; }
    __device__ __forceinline__ const int* a_row_ptr(const Unit&, int) const { return nullptr; } };
struct PGates { static constexpr bool GATHER = false, FP8 = false, SIDE = false; const bf16_t* A; const bf16_t* Bt; unsigned lda2, ldb2; int nt;
    __device__ __forceinline__ const char* a_tile(const Unit& u) const { return (const char*)A + (size_t)u.pm * 256 * lda2 + (size_t)(u.pn >> 1) * 512; }
    __device__ __forceinline__ const char* b_tile(const Unit& u) const { return (const char*)Bt + (size_t)u.pn * 256 * ldb2; }
    __device__ __forceinline__ const int* a_row_ptr(const Unit&, int) const { return nullptr; } };
struct PUp { static constexpr bool GATHER = true, FP8 = true, SIDE = true; const unsigned char* A; const unsigned char* Bt; const int* elist; unsigned lda2, ldb2; int nt; int s2; const float* rowv; const float* bias;
    __device__ __forceinline__ const char* a_tile(const Unit&) const { return (const char*)A; }
    __device__ __forceinline__ const char* b_tile(const Unit& u) const { return (const char*)Bt + ((size_t)u.e * 2048 + (size_t)u.pn * 256) * ldb2; }
    __device__ __forceinline__ const int* a_row_ptr(const Unit& u, int r) const { const int rc = r < u.rem ? r : u.rem - 1; return elist + u.e * ECAP + u.mt * 256 + rc; }
    __device__ __forceinline__ void side_dma(const Unit& u, unsigned lds_slot, int wid, int lane) const {
        if (wid < 4) { const int r = 64 * wid + lane; glds4_s(rowv, (unsigned)(u.e * ECAP + u.mt * 256 + (r < u.rem ? r : u.rem - 1)) * 4u, lds_slot + wid * 256); }
        else { const int i = 64 * (wid - 4) + lane; glds4_s(bias, (unsigned)(u.e * 2048 + (i < 128 ? u.pn * 128 + i : 1024 + u.pn * 128 + (i - 128))) * 4u, lds_slot + wid * 256); } } };
struct PDown { static constexpr bool GATHER = false, FP8 = true, SIDE = true; const unsigned char* A; const unsigned char* Bt; unsigned lda2, ldb2; int nt; int s2; const float* rowv; const float* bias;
    __device__ __forceinline__ const char* a_tile(const Unit& u) const { return (const char*)A + (size_t)u.pm * 256 * lda2; }
    __device__ __forceinline__ const char* b_tile(const Unit& u) const { return (const char*)Bt + ((size_t)u.e * 1024 + (size_t)u.pn * 256) * ldb2; }
    __device__ __forceinline__ const int* a_row_ptr(const Unit&, int) const { return nullptr; }
    __device__ __forceinline__ void side_dma(const Unit& u, unsigned lds_slot, int wid, int lane) const {
        if (wid < 4) { const int r = 64 * wid + lane; glds4_s(rowv, (unsigned)(u.e * ECAP + u.mt * 256 + (r < u.rem ? r : u.rem - 1)) * 4u, lds_slot + wid * 256); }
        else { const int i = 64 * (wid - 4) + lane; glds4_s(bias, (unsigned)(u.e * 1024 + u.pn * 256 + i) * 4u, lds_slot + wid * 256); } } };

template <class P, class Epi, class Sched>
__device__ __forceinline__ void gemm_phase(LAS unsigned char* lds, const int wid, const P g, const Sched& S, const Epi& E) {
    const int lane = lane_id_v(), tid = wid * 64 + lane, wr = wid >> 2, wc = wid & 3;
    const int nt = g.nt;
    int fp8_s = 127; if constexpr (P::FP8) fp8_s = g.s2;
    (void)fp8_s;
    unsigned voffA0, voffB0, CA2; int RA0;
    { int R, C; stage_rc(tid * 16, R, C); const int Rb = (R & ~31) + perm32(R & 31);
      voffA0 = (unsigned)R * g.lda2 + (unsigned)C * 2u; voffB0 = (unsigned)Rb * g.ldb2 + (unsigned)C * 2u; RA0 = R; CA2 = (unsigned)C * 2u; }
    const size_t pstepA = (size_t)64 * g.lda2, pstepB = (size_t)64 * g.ldb2;
    LAS unsigned char* idlds = lds + STAGE_BYTES + 4096 + wid * 256;
    const size_t kstep = (size_t)(BK * 2);
    const size_t hstepA = (size_t)HALF * g.lda2, hstepB = (size_t)HALF * g.ldb2;
    const unsigned ldsw = (unsigned)wid * 1024u;
    const unsigned ldsbase = (unsigned)(uintptr_t)lds + ldsw;
    const int aoff = lds_byte(wr * 64 + (lane & 15), (lane >> 4) * 8), boff = lds_byte(wc * 32 + (lane & 15), (lane >> 4) * 8);
#define G8_SA(b, h) (((b) * 2 + (h)) * HTB)
#define G8_SB(b, h) ((4 + (b) * 2 + (h)) * HTB)
#define G8_STB(bufoff, gbase) do { _Pragma("unroll") for (int _i = 0; _i < 2; ++_i) { \
        if constexpr (P::FP8) glds16_s((const char*)(gbase) + (size_t)_i * pstepB, voffB0, ldsbase + (unsigned)((bufoff) + _i * 8192)); \
        else __builtin_amdgcn_global_load_lds((const unsigned*)((const char*)(gbase) + (size_t)_i * pstepB + voffB0), (LAS unsigned*)(lds + (bufoff) + ldsw + _i * 8192), 16, 0, 0); } } while (0)
#define G8_STA(bufoff, kp, h, GO) do { _Pragma("unroll") for (int _i = 0; _i < 2; ++_i) { \
        if constexpr (P::FP8) { if constexpr (P::GATHER) glds16_s((const char*)(kp), GO[h][_i] * g.lda2 + CA2, ldsbase + (unsigned)((bufoff) + _i * 8192)); \
                                else glds16_s((const char*)(kp) + (size_t)(h) * hstepA + (size_t)_i * pstepA, voffA0, ldsbase + (unsigned)((bufoff) + _i * 8192)); } \
        else { const char* _p = P::GATHER ? ((const char*)(kp) + (GO[h][_i] * g.lda2 + CA2)) : ((const char*)(kp) + (size_t)(h) * hstepA + (size_t)_i * pstepA + voffA0); \
        __builtin_amdgcn_global_load_lds((const unsigned*)_p, (LAS unsigned*)(lds + (bufoff) + ldsw + _i * 8192), 16, 0, 0); } } } while (0)
#define G8_LDA(dst, b, h) do { _Pragma("unroll") for (int m = 0; m < 4; ++m) _Pragma("unroll") for (int k = 0; k < 2; ++k) dst[m][k] = *(const LAS bf16x8*)(lds + G8_SA(b, h) + aoff + m * 2048 + k * 1024); } while (0)
#define G8_LDB(dst, b, h) do { _Pragma("unroll") for (int n = 0; n < 2; ++n) _Pragma("unroll") for (int k = 0; k < 2; ++k) dst[n][k] = *(const LAS bf16x8*)(lds + G8_SB(b, h) + boff + n * 2048 + k * 1024); } while (0)
#define G8_MMA(ai, bj, At, Bt) do { __builtin_amdgcn_s_setprio(1); \
        if constexpr (P::FP8) { _Pragma("unroll") for (int m = 0; m < 4; ++m) _Pragma("unroll") for (int n = 0; n < 2; ++n) { \
            const i32x8 a8_ = __builtin_shufflevector(__builtin_bit_cast(i32x4, At[m][0]), __builtin_bit_cast(i32x4, At[m][1]), 0, 1, 2, 3, 4, 5, 6, 7); \
            const i32x8 b8_ = __builtin_shufflevector(__builtin_bit_cast(i32x4, Bt[n][0]), __builtin_bit_cast(i32x4, Bt[n][1]), 0, 1, 2, 3, 4, 5, 6, 7); \
            acc[ai][bj][m][n] = __builtin_amdgcn_mfma_scale_f32_16x16x128_f8f6f4(b8_, a8_, acc[ai][bj][m][n], 0, 0, 0, fp8_s, 0, fp8_s); } } \
        else { _Pragma("unroll") for (int m = 0; m < 4; ++m) _Pragma("unroll") for (int n = 0; n < 2; ++n) _Pragma("unroll") for (int k = 0; k < 2; ++k) \
            acc[ai][bj][m][n] = __builtin_amdgcn_mfma_f32_16x16x32_bf16(Bt[n][k], At[m][k], acc[ai][bj][m][n], 0, 0, 0); } \
        __builtin_amdgcn_s_setprio(0); } while (0)
#define G8_WAIT_V(n) asm volatile("s_waitcnt vmcnt(" #n ")" ::: "memory")
#define G8_WAIT_L(n) asm volatile("s_waitcnt lgkmcnt(" #n ")" ::: "memory")
#define G8_BAR __builtin_amdgcn_s_barrier()
#define G8_SCHED __builtin_amdgcn_sched_barrier(0)
    Unit cur, nxt; int ui = 0;
    if (!S.next(0, cur)) return;
    f32x4 acc[2][2][4][2];
#pragma unroll
    for (int a = 0; a < 2; ++a)
#pragma unroll
        for (int b = 0; b < 2; ++b)
#pragma unroll
            for (int m = 0; m < 4; ++m)
#pragma unroll
                for (int n = 0; n < 2; ++n) acc[a][b][m][n] = (f32x4){0.f, 0.f, 0.f, 0.f};
    if constexpr (Epi::PRELOAD) { const int l0 = lane_id_v(); E.preload(acc, cur, wr, wc, l0 & 15, l0 >> 4); }
    bf16x8 At[4][2], B0[2][2], B1[2][2];
    unsigned gc[2][2];
#pragma unroll
    for (int h = 0; h < 2; ++h)
#pragma unroll
        for (int i = 0; i < 2; ++i) gc[h][i] = P::GATHER ? (unsigned)*g.a_row_ptr(cur, h * 128 + i * 64 + RA0) : 0u;
    const unsigned sidebase = (unsigned)(uintptr_t)lds + (unsigned)STAGE_BYTES + 12288u;
    if constexpr (P::SIDE) g.side_dma(cur, sidebase, wid, lane_id_v());
    const char* cA = g.a_tile(cur); const char* cB = g.b_tile(cur);
    G8_STB(G8_SB(0, 0), cB); G8_STB(G8_SB(0, 1), cB + hstepB); G8_STA(G8_SA(0, 0), cA, 0, gc); G8_STA(G8_SA(0, 1), cA, 1, gc);
    if (wr == 1) G8_BAR;
    G8_WAIT_V(2); G8_BAR;
    G8_STB(G8_SB(1, 0), cB + kstep); G8_STA(G8_SA(1, 0), cA + kstep, 0, gc); G8_STB(G8_SB(1, 1), cB + hstepB + kstep);
    G8_WAIT_V(6); G8_BAR;
    for (;;) {
        const bool has_next = S.next(ui + 1, nxt);
        const char* nA = has_next ? g.a_tile(nxt) : cA; const char* nB = has_next ? g.b_tile(nxt) : cB;
        if constexpr (P::SIDE) { if (has_next) g.side_dma(nxt, sidebase + (unsigned)(((ui + 1) % 3) * 2048), wid, lane_id_v()); }
        if (P::GATHER && has_next) {
#pragma unroll
            for (int h = 0; h < 2; ++h)
#pragma unroll
                for (int i = 0; i < 2; ++i) __builtin_amdgcn_global_load_lds((const unsigned*)g.a_row_ptr(nxt, h * 128 + i * 64 + RA0), (LAS unsigned*)(idlds + (h * 2 + i) * 2048), 4, 0, 0);
        }
#define G8_KITER(a1, a2, b2, O2, G8_IDSWAP) do { \
            const char* a3 = (a2) + kstep; const char* b3 = (b2) + kstep; \
              \
            G8_LDB(B0, 0, 0); G8_LDB(B1, 0, 1); G8_SCHED; G8_LDA(At, 0, 0); G8_STA(G8_SA(1, 1), a1, 1, gc); G8_IDSWAP(); \
            G8_WAIT_V(8); G8_WAIT_L(0); G8_BAR; G8_MMA(0, 0, At, B0); G8_MMA(0, 1, At, B1); G8_BAR; G8_SCHED; \
              \
            G8_LDA(At, 0, 1); G8_STB(G8_SB(0, 0), b2); G8_STB(G8_SB(0, 1), (b2) + hstepB); G8_STA(G8_SA(0, 0), a2, 0, O2); \
            G8_WAIT_V(8); G8_WAIT_L(0); G8_BAR; G8_MMA(1, 0, At, B0); G8_MMA(1, 1, At, B1); G8_BAR; G8_SCHED; \
              \
            G8_LDB(B0, 1, 0); G8_LDB(B1, 1, 1); G8_SCHED; G8_LDA(At, 1, 0); G8_STA(G8_SA(0, 1), a2, 1, O2); \
            G8_WAIT_V(8); G8_WAIT_L(0); G8_BAR; G8_MMA(0, 0, At, B0); G8_MMA(0, 1, At, B1); G8_BAR; G8_SCHED; \
              \
            G8_LDA(At, 1, 1); G8_STB(G8_SB(1, 0), b3); G8_STB(G8_SB(1, 1), b3 + hstepB); G8_STA(G8_SA(1, 0), a3, 0, O2); \
            G8_WAIT_V(8); G8_WAIT_L(0); G8_BAR; G8_MMA(1, 0, At, B0); G8_MMA(1, 1, At, B1); G8_BAR; G8_SCHED; } while (0)
#define G8_SWAP_IDS() do { if (P::GATHER && last && has_next) { const unsigned ida = (unsigned)(uintptr_t)(idlds + lane_id_v() * 4); \
                asm volatile("ds_read_b32 %0, %4\n\tds_read_b32 %1, %4 offset:2048\n\tds_read_b32 %2, %4 offset:4096\n\tds_read_b32 %3, %4 offset:6144\n\ts_waitcnt lgkmcnt(0)" \
                             : "=&v"(gc[0][0]), "=&v"(gc[0][1]), "=&v"(gc[1][0]), "=&v"(gc[1][1]) : "v"(ida) : "memory"); } } while (0)
#pragma nounroll
        for (int t = 0; t < nt; t += 2) {
            const bool last = (t == nt - 2);
            const char* a1 = cA + (size_t)(t + 1) * kstep;
            const char* a2 = last ? nA : cA + (size_t)(t + 2) * kstep; const char* b2 = last ? nB : cB + (size_t)(t + 2) * kstep;
            G8_KITER(a1, a2, b2, gc, G8_SWAP_IDS);
        }
#undef G8_SWAP_IDS
#undef G8_KITER
        if (wr == 0) G8_BAR;
        { const int l2 = lane_id_v(); if constexpr (P::SIDE) E(acc, cur, wr, wc, l2 & 15, l2 >> 4, (const LAS float*)(lds + STAGE_BYTES + 12288 + (ui % 3) * 2048)); else E(acc, cur, wr, wc, l2 & 15, l2 >> 4); }
        if (!has_next) break;
#pragma unroll
        for (int a = 0; a < 2; ++a)
#pragma unroll
            for (int b = 0; b < 2; ++b)
#pragma unroll
                for (int m = 0; m < 4; ++m)
#pragma unroll
                    for (int n = 0; n < 2; ++n) acc[a][b][m][n] = (f32x4){0.f, 0.f, 0.f, 0.f};
        if constexpr (Epi::PRELOAD) { const int l0 = lane_id_v(); E.preload(acc, nxt, wr, wc, l0 & 15, l0 >> 4); }
        cur = nxt; cA = nA; cB = nB; ++ui;
        if (wr == 1) G8_BAR;
    }
    G8_WAIT_V(0);
    G8_BAR;
#undef G8_SA
#undef G8_SB
#undef G8_STB
#undef G8_STA
#undef G8_LDA
#undef G8_LDB
#undef G8_MMA
#undef G8_WAIT_V
#undef G8_WAIT_L
#undef G8_BAR
#undef G8_SCHED
}

#define EPI_ROWS_BEGIN() _Pragma("unroll") for (int ai = 0; ai < 2; ++ai) _Pragma("unroll") for (int m = 0; m < 4; ++m) { const int rr = ai * HALF + wr * 64 + m * 16 + fr;
#define EPI_ROWS_END() }
__device__ __forceinline__ u32x4 pack8(const f32x4& a, const f32x4& b) { u32x4 w; w.x = cvt_pk_bf16(a[0], a[1]); w.y = cvt_pk_bf16(a[2], a[3]); w.z = cvt_pk_bf16(b[0], b[1]); w.w = cvt_pk_bf16(b[2], b[3]); return w; }

struct EpiProj {
    static constexpr bool PRELOAD = false;
    bf16_t *PQ, *PRX, *GRG, *GATE; const float* b_gate;
    template <int ACT> __device__ __forceinline__ void tile(const f32x4 (&acc)[2][2][4][2], bf16_t* base, int ldc, int colt, int row0, int wr, int wc, int fr, int fq) const {
        const int cw = wc * 32 + 8 * fq;
        f32x4 bv[2][2];
#pragma unroll
        for (int bj = 0; bj < 2; ++bj)
#pragma unroll
            for (int n = 0; n < 2; ++n) bv[bj][n] = ACT == 2 ? *(const f32x4*)(b_gate + colt + bj * HALF + cw + 4 * n) * -1.4426950408889634f : (f32x4){0.f, 0.f, 0.f, 0.f};
        EPI_ROWS_BEGIN()
            bf16_t* rowp = base + (size_t)(row0 + rr) * ldc + colt + cw;
#pragma unroll
            for (int bj = 0; bj < 2; ++bj) { f32x4 v0 = acc[ai][bj][m][0], v1 = acc[ai][bj][m][1];
                if (ACT == 1) { const f32x2 a = gelu_tanh2((f32x2){v0[0], v0[1]}), b = gelu_tanh2((f32x2){v0[2], v0[3]}), c = gelu_tanh2((f32x2){v1[0], v1[1]}), d = gelu_tanh2((f32x2){v1[2], v1[3]});
                    v0 = (f32x4){a.x, a.y, b.x, b.y}; v1 = (f32x4){c.x, c.y, d.x, d.y}; }
                if (ACT == 2) { const f32x4 n0 = bv[bj][0], n1 = bv[bj][1];
                    const f32x2 a = sigm2_bias((f32x2){v0[0], v0[1]}, (f32x2){n0[0], n0[1]}), b = sigm2_bias((f32x2){v0[2], v0[3]}, (f32x2){n0[2], n0[3]}), c = sigm2_bias((f32x2){v1[0], v1[1]}, (f32x2){n1[0], n1[1]}), d = sigm2_bias((f32x2){v1[2], v1[3]}, (f32x2){n1[2], n1[3]});
                    v0 = (f32x4){a.x, a.y, b.x, b.y}; v1 = (f32x4){c.x, c.y, d.x, d.y}; }
                *(u32x4*)(rowp + bj * HALF) = pack8(v0, v1); }
        EPI_ROWS_END()
    }
    __device__ __forceinline__ void operator()(const f32x4 (&acc)[2][2][4][2], const Unit& u, int wr, int wc, int fr, int fq) const {
        const int pn = u.pn, row0 = u.pm * BM;
        if (pn < 3) tile<0>(acc, PQ, 768, pn * 256, row0, wr, wc, fr, fq);
        else if (pn < 7) tile<0>(acc, PRX, 1024, (pn - 3) * 256, row0, wr, wc, fr, fq);
        else if (pn < 11) tile<1>(acc, GRG, 1024, (pn - 7) * 256, row0, wr, wc, fr, fq);
        else tile<2>(acc, GATE, 2048, (pn - 11) * 256, row0, wr, wc, fr, fq);
    }
};
struct EpiQ {
    static constexpr bool PRELOAD = false;
    bf16_t* Q; const float* COS; const float* SIN;
    __device__ __forceinline__ void operator()(const f32x4 (&acc)[2][2][4][2], const Unit& u, int wr, int wc, int fr, int fq) const {
        EPI_ROWS_BEGIN()
            const int row = u.pm * BM + rr, t = NMETA + (row & 8191);
#pragma unroll
            for (int bj = 0; bj < 2; ++bj) { const int col0 = u.pn * BM + bj * HALF + wc * 32 + 8 * fq, hh = col0 / 96, off = col0 - 96 * hh;
                f32x4 v0 = acc[ai][bj][m][0], v1 = acc[ai][bj][m][1];
                if (off >= 64) { const int i0 = (off - 64) >> 1; const f32x4 c = *(const f32x4*)(COS + t * 16 + i0), s = *(const f32x4*)(SIN + t * 16 + i0);
                    const float a0 = v0[0] * c[0] - v0[1] * s[0], b0 = v0[0] * s[0] + v0[1] * c[0];
                    const float a1 = v0[2] * c[1] - v0[3] * s[1], b1 = v0[2] * s[1] + v0[3] * c[1];
                    const float a2 = v1[0] * c[2] - v1[1] * s[2], b2 = v1[0] * s[2] + v1[1] * c[2];
                    const float a3 = v1[2] * c[3] - v1[3] * s[3], b3 = v1[2] * s[3] + v1[3] * c[3];
                    v0 = (f32x4){a0, b0, a1, b1}; v1 = (f32x4){a2, b2, a3, b3}; }
                *(u32x4*)(Q + (size_t)row * 768 + col0) = pack8(v0, v1); }
        EPI_ROWS_END()
    }
};
struct EpiKV {
    static constexpr bool PRELOAD = false;
    bf16_t *KN, *V;
    __device__ __forceinline__ void operator()(const f32x4 (&acc)[2][2][4][2], const Unit& u, int wr, int wc, int fr, int fq) const {
        EPI_ROWS_BEGIN()
            const int kr = kvrow_of(u.pm * BM + rr);
#pragma unroll
            for (int bj = 0; bj < 2; ++bj) { const int col0 = u.pn * BM + bj * HALF + wc * 32 + 8 * fq, hh = col0 >> 7, j = col0 & 127;
                bf16_t* dst = (j < 64 ? KN + hh * 64 + j : V + hh * 64 + (j - 64)) + (size_t)kr * 512;
                *(u32x4*)dst = pack8(acc[ai][bj][m][0], acc[ai][bj][m][1]); }
        EPI_ROWS_END()
    }
};
struct EpiGates {
    static constexpr bool PRELOAD = false;
    const bf16_t* XC; const float *b_a, *b_x; _Float16 *R16, *U16;
    __device__ __forceinline__ void operator()(const f32x4 (&acc)[2][2][4][2], const Unit& u, int wr, int wc, int fr, int fq) const {
        const int ch = u.pn * 128 + wc * 32 + 8 * fq;
        const f32x4 ba0 = *(const f32x4*)(b_a + ch), ba1 = *(const f32x4*)(b_a + ch + 4), bx0 = *(const f32x4*)(b_x + ch), bx1 = *(const f32x4*)(b_x + ch + 4);
        u32x4 xwv[2][4];
#pragma unroll
        for (int ai = 0; ai < 2; ++ai)
#pragma unroll
            for (int m = 0; m < 4; ++m) xwv[ai][m] = *(const u32x4*)(XC + (size_t)(u.pm * BM + ai * HALF + wr * 64 + m * 16 + fr) * 1024 + ch);
        asm volatile("" ::: "memory");
        EPI_ROWS_BEGIN()
            const size_t o = (size_t)(u.pm * BM + rr) * 1024 + ch;
            const u32x4 xw = xwv[ai][m];
            const f32x4 a0 = acc[ai][0][m][0] + ba0, a1 = acc[ai][0][m][1] + ba1, x0 = acc[ai][1][m][0] + bx0, x1 = acc[ai][1][m][1] + bx1;
            float xc[8] = {bf_lo(xw.x), bf_hi(xw.x), bf_lo(xw.y), bf_hi(xw.y), bf_lo(xw.z), bf_hi(xw.z), bf_lo(xw.w), bf_hi(xw.w)};
            h16x8 rv, uv;
#pragma unroll
            for (int j = 0; j < 4; ++j) { rv[j] = (_Float16)sigm(a0[j]); rv[4 + j] = (_Float16)sigm(a1[j]); uv[j] = (_Float16)(sigm(x0[j]) * xc[j]); uv[4 + j] = (_Float16)(sigm(x1[j]) * xc[4 + j]); }
            *(h16x8*)(R16 + o) = rv; *(h16x8*)(U16 + o) = uv;
        EPI_ROWS_END()
    }
};
struct EpiAo {
    static constexpr bool PRELOAD = false;
    const bf16_t* GATE; bf16_t* MA;
    __device__ __forceinline__ void operator()(const f32x4 (&acc)[2][2][4][2], const Unit& u, int wr, int wc, int fr, int fq) const {
#pragma unroll
        for (int ai = 0; ai < 2; ++ai) { u32x4 gw[4][2];
#pragma unroll
            for (int m = 0; m < 4; ++m) { const int row = u.pm * BM + ai * HALF + wr * 64 + m * 16 + fr;
#pragma unroll
                for (int bj = 0; bj < 2; ++bj) gw[m][bj] = __builtin_nontemporal_load((const u32x4*)(GATE + (size_t)row * 2048 + u.pn * BM + bj * HALF + wc * 32 + 8 * fq)); }
            asm volatile("" ::: "memory");
#pragma unroll
            for (int m = 0; m < 4; ++m) { const int row = u.pm * BM + ai * HALF + wr * 64 + m * 16 + fr;
#pragma unroll
                for (int bj = 0; bj < 2; ++bj) { const int col0 = u.pn * BM + bj * HALF + wc * 32 + 8 * fq; const u32x4 g = gw[m][bj];
                    f32x4 v0 = acc[ai][bj][m][0], v1 = acc[ai][bj][m][1];
                    v0 *= (f32x4){bf_lo(g.x), bf_hi(g.x), bf_lo(g.y), bf_hi(g.y)}; v1 *= (f32x4){bf_lo(g.z), bf_hi(g.z), bf_lo(g.w), bf_hi(g.w)};
                    *(u32x4*)(MA + (size_t)row * 1024 + col0) = pack8(v0, v1); } } }
    }
};
struct EpiRo {
    static constexpr bool PRELOAD = false;
    const bf16_t* GATE; const bf16_t* MA; bf16_t* MG;
    __device__ __forceinline__ void operator()(const f32x4 (&acc)[2][2][4][2], const Unit& u, int wr, int wc, int fr, int fq) const {
#pragma unroll
        for (int ai = 0; ai < 2; ++ai) { u32x4 gw[4][2], mw[4][2];
#pragma unroll
            for (int m = 0; m < 4; ++m) { const int row = u.pm * BM + ai * HALF + wr * 64 + m * 16 + fr;
#pragma unroll
                for (int bj = 0; bj < 2; ++bj) { const int col0 = u.pn * BM + bj * HALF + wc * 32 + 8 * fq;
                    gw[m][bj] = __builtin_nontemporal_load((const u32x4*)(GATE + (size_t)row * 2048 + 1024 + col0)); mw[m][bj] = *(const u32x4*)(MA + (size_t)row * 1024 + col0); } }
            asm volatile("" ::: "memory");
#pragma unroll
            for (int m = 0; m < 4; ++m) { const int row = u.pm * BM + ai * HALF + wr * 64 + m * 16 + fr;
#pragma unroll
                for (int bj = 0; bj < 2; ++bj) { const int col0 = u.pn * BM + bj * HALF + wc * 32 + 8 * fq; const u32x4 g = gw[m][bj], q = mw[m][bj];
                    f32x4 v0 = acc[ai][bj][m][0], v1 = acc[ai][bj][m][1];
                    v0 = v0 * (f32x4){bf_lo(g.x), bf_hi(g.x), bf_lo(g.y), bf_hi(g.y)} + (f32x4){bf_lo(q.x), bf_hi(q.x), bf_lo(q.y), bf_hi(q.y)};
                    v1 = v1 * (f32x4){bf_lo(g.z), bf_hi(g.z), bf_lo(g.w), bf_hi(g.w)} + (f32x4){bf_lo(q.z), bf_hi(q.z), bf_lo(q.w), bf_hi(q.w)};
                    *(u32x4*)(MG + (size_t)row * 1024 + col0) = pack8(v0, v1); } } }
    }
};
struct EpiOut {
    static constexpr bool PRELOAD = true;
    const float* X; bf16_t* H2; unsigned char* H8; const float* gffn;
    __device__ __forceinline__ void preload(f32x4 (&acc)[2][2][4][2], const Unit& u, int wr, int wc, int fr, int fq) const {
        EPI_ROWS_BEGIN()
            const int row = u.pm * BM + rr;
#pragma unroll
            for (int bj = 0; bj < 2; ++bj) { const size_t o = (size_t)row * 1024 + u.pn * BM + bj * HALF + wc * 32 + 8 * fq;
                acc[ai][bj][m][0] = __builtin_nontemporal_load((const f32x4*)(X + o)); acc[ai][bj][m][1] = __builtin_nontemporal_load((const f32x4*)(X + o + 4)); }
        EPI_ROWS_END()
    }
    __device__ __forceinline__ void operator()(const f32x4 (&acc)[2][2][4][2], const Unit& u, int wr, int wc, int fr, int fq) const {
        EPI_ROWS_BEGIN()
            const int row = u.pm * BM + rr;
#pragma unroll
            for (int bj = 0; bj < 2; ++bj) { const size_t o = (size_t)row * 1024 + u.pn * BM + bj * HALF + wc * 32 + 8 * fq;
                const f32x4 v0 = acc[ai][bj][m][0], v1 = acc[ai][bj][m][1];
                *(u32x4*)(H2 + o) = pack8(v0, v1);
                const int cg_ = u.pn * BM + bj * HALF + wc * 32 + 8 * fq; const f32x4 g0 = *(const f32x4*)(gffn + cg_), g1 = *(const f32x4*)(gffn + cg_ + 4);
                u32x2 w8; w8.x = pack_fp8x4(v0[0] * g0[0], v0[1] * g0[1], v0[2] * g0[2], v0[3] * g0[3]); w8.y = pack_fp8x4(v1[0] * g1[0], v1[1] * g1[1], v1[2] * g1[2], v1[3] * g1[3]); *(u32x2*)(H8 + o) = w8; }
        EPI_ROWS_END()
    }
};
struct EpiUp {
    static constexpr bool PRELOAD = false;
    unsigned char* ACT;
    __device__ __forceinline__ void operator()(const f32x4 (&acc)[2][2][4][2], const Unit& u, int wr, int wc, int fr, int fq, const LAS float* side) const {
        const int c0 = u.pn * 128 + wc * 32 + 8 * fq, cl = wc * 32 + 8 * fq;
        const f32x4 bg0 = *(const LAS f32x4*)(side + 256 + cl), bg1 = *(const LAS f32x4*)(side + 256 + cl + 4), bl0 = *(const LAS f32x4*)(side + 384 + cl), bl1 = *(const LAS f32x4*)(side + 384 + cl + 4);
        EPI_ROWS_BEGIN()
            const float rs = side[rr];
            f32x4 g0 = acc[ai][0][m][0] * rs + bg0, g1 = acc[ai][0][m][1] * rs + bg1, l0 = acc[ai][1][m][0] * rs + bl0, l1 = acc[ai][1][m][1] * rs + bl1;
#define UP_PAIR(G_, L_, i0) do { f32x2 a2 = {fminf(G_[i0], 7.f), fminf(G_[i0 + 1], 7.f)}; f32x2 p2 = {fminf(fmaxf(L_[i0], -7.f), 7.f), fminf(fmaxf(L_[i0 + 1], -7.f), 7.f)}; \
                const f32x2 k4 = {A8_SCALE, A8_SCALE}, kc = {-1.702f * 1.4426950408889634f, -1.702f * 1.4426950408889634f}, one = {1.f, 1.f}; \
                p2 = __builtin_elementwise_fma(p2, k4, k4); f32x2 e2 = a2 * kc; e2.x = __builtin_amdgcn_exp2f(e2.x); e2.y = __builtin_amdgcn_exp2f(e2.y); e2 += one; \
                e2.x = __builtin_amdgcn_rcpf(e2.x); e2.y = __builtin_amdgcn_rcpf(e2.y); a2 = (a2 * e2) * p2; G_[i0] = a2.x; G_[i0 + 1] = a2.y; } while (0)
            UP_PAIR(g0, l0, 0); UP_PAIR(g0, l0, 2); UP_PAIR(g1, l1, 0); UP_PAIR(g1, l1, 2);
#undef UP_PAIR
            { u32x2 w8; w8.x = pack_fp8x4_nc(g0[0], g0[1], g0[2], g0[3]); w8.y = pack_fp8x4_nc(g1[0], g1[1], g1[2], g1[3]);
              *(u32x2*)(ACT + (size_t)(u.pm * BM + rr) * 1024 + c0) = w8; }
        EPI_ROWS_END()
    }
};
struct EpiDown {
    static constexpr bool PRELOAD = false;
    unsigned char* YE;
    __device__ __forceinline__ void operator()(const f32x4 (&acc)[2][2][4][2], const Unit& u, int wr, int wc, int fr, int fq, const LAS float* side) const {
        f32x4 bdv[2][2];
#pragma unroll
        for (int bj = 0; bj < 2; ++bj) { bdv[bj][0] = *(const LAS f32x4*)(side + 256 + bj * HALF + wc * 32 + 8 * fq); bdv[bj][1] = *(const LAS f32x4*)(side + 256 + bj * HALF + wc * 32 + 8 * fq + 4); }
        EPI_ROWS_BEGIN()
            const float gt = side[rr] * Y8_SCALE;
#pragma unroll
            for (int bj = 0; bj < 2; ++bj) { const int col0 = u.pn * BM + bj * HALF + wc * 32 + 8 * fq;
                const f32x4 v0 = (acc[ai][bj][m][0] + bdv[bj][0]) * gt, v1 = (acc[ai][bj][m][1] + bdv[bj][1]) * gt;
                u32x2 w8; w8.x = pack_fp8x4(v0[0], v0[1], v0[2], v0[3]); w8.y = pack_fp8x4(v1[0], v1[1], v1[2], v1[3]);
                *(u32x2*)(YE + (size_t)(u.pm * BM + rr) * 1024 + col0) = w8; }
        EPI_ROWS_END()
    }
};
}

namespace att {
constexpr int NW = 8, QBLK = 32, KVBLK = 64, QB = 256;
constexpr int LDQ = 768, LDKN = 512, LDKP = 32, LDV = 512, LDO = 512;
constexpr int SHM_K = KVBLK * 256, SHM_V = KVBLK * 64 * 2;
constexpr int LDS_BYTES = 2 * SHM_V + 2 * SHM_K + NW * 64 * 4;
constexpr float SCALE = 0.10206207261596577f;
constexpr float THR = 8.f;
#define KSWZ(row, colB) ((row) * 256 + ((colB) ^ (((row) & 7) << 4)))
#define SBAR() __builtin_amdgcn_sched_barrier(0)
__device__ __forceinline__ int v_st(int k, int c) { const int kk = (k & ~0xC) | ((k & 4) << 1) | ((k & 8) >> 1); return ((kk >> 3) * 2 + (c >> 5)) * 512 + ((kk & 7) * 32 + (c & 31)) * 2; }
__device__ __forceinline__ int v_rd_base(int lane) { return ((lane & 3) << 3) | (((lane >> 2) & 3) << 6) | (((lane >> 4) & 1) << 5) | (((lane >> 5) & 1) << 8); }
__device__ __forceinline__ int crow(int r, int hi) { return (r & 3) + 8 * (r >> 2) + 4 * hi; }
__device__ __forceinline__ unsigned cvtpk(float lo, float hi) { return cvt_pk_bf16(lo, hi); }
__device__ __forceinline__ bf16x8 load8(const bf16_t* p) { return *reinterpret_cast<const bf16x8*>(p); }
__device__ __forceinline__ void mask_tile(f32x16& p0, f32x16& p1, int dq) {
    const float NEG = -__builtin_inff();
#pragma unroll
    for (int r = 0; r < 16; ++r) { const int c = (r & 3) + 8 * (r >> 2); if (c > dq) p0[r] = NEG; if (c + 32 > dq) p1[r] = NEG; }
}
__device__ __forceinline__ void mask_meta(f32x16& p0, f32x16& p1) {
    const float NEG = -__builtin_inff();
#pragma unroll
    for (int r = 8; r < 16; ++r) p0[r] = NEG;
#pragma unroll
    for (int r = 0; r < 16; ++r) p1[r] = NEG;
}
__device__ __forceinline__ void partialSM(f32x16& p0, f32x16& p1, float& m_reg, float& mn, float& alpha) {
    float pmax = p0[0];
#pragma unroll
    for (int r = 1; r < 16; ++r) pmax = fmaxf(pmax, p0[r]);
#pragma unroll
    for (int r = 0; r < 16; ++r) pmax = fmaxf(pmax, p1[r]);
    { auto rr = __builtin_amdgcn_permlane32_swap(__float_as_uint(pmax), __float_as_uint(pmax), false, false);
      pmax = fmaxf(__uint_as_float(rr[0]), __uint_as_float(rr[1])); }
    constexpr float C2 = 1.4426950408889634f * SCALE;
    if (__builtin_expect(__all((pmax - m_reg) * SCALE <= THR), 1)) { mn = m_reg; alpha = 1.f; }
    else { mn = fmaxf(m_reg, pmax); alpha = __builtin_amdgcn_exp2f((m_reg - mn) * C2); m_reg = mn; }
    const float mnL = -mn * C2;
    { const f32x2 c2v = {C2, C2}, mlv = {mnL, mnL};
#pragma unroll
      for (int r = 0; r < 16; r += 2) { f32x2 a = {p0[r], p0[r + 1]}, b = {p1[r], p1[r + 1]}; a = __builtin_elementwise_fma(a, c2v, mlv); b = __builtin_elementwise_fma(b, c2v, mlv);
          p0[r] = a.x; p0[r + 1] = a.y; p1[r] = b.x; p1[r + 1] = b.y; } }
#pragma unroll
    for (int r = 0; r < 16; ++r) p0[r] = __builtin_amdgcn_exp2f(p0[r]);
}
__device__ __forceinline__ void finishSM(f32x16& p0, f32x16& p1, float alpha, float& l_reg, bf16x8& pa0, bf16x8& pa1, bf16x8& pa2, bf16x8& pa3) {
#pragma unroll
    for (int r = 0; r < 16; ++r) p1[r] = __builtin_amdgcn_exp2f(p1[r]);
    float ps;
    { f32x2 s2 = {0.f, 0.f}, t2 = {0.f, 0.f};
#pragma unroll
      for (int r = 0; r < 16; r += 2) { s2 += (f32x2){p0[r], p0[r + 1]}; t2 += (f32x2){p1[r], p1[r + 1]}; }
      s2 += t2; ps = s2.x + s2.y; }
    { auto rr = __builtin_amdgcn_permlane32_swap(__float_as_uint(ps), __float_as_uint(ps), false, false);
      ps = __uint_as_float(rr[0]) + __uint_as_float(rr[1]); }
    l_reg = l_reg * alpha + ps;
#define PK4(P, B_, OUT) do { unsigned a0 = cvtpk(P[B_+0], P[B_+1]), a1 = cvtpk(P[B_+2], P[B_+3]);                          \
        unsigned b0 = cvtpk(P[B_+4], P[B_+5]), b1 = cvtpk(P[B_+6], P[B_+7]);                                             \
        auto r0 = __builtin_amdgcn_permlane32_swap(a0, b0, false, false); auto r1 = __builtin_amdgcn_permlane32_swap(a1, b1, false, false); \
        u32x4 w = {r0[0], r1[0], r0[1], r1[1]}; OUT = *reinterpret_cast<bf16x8*>(&w); } while (0)
    PK4(p0, 0, pa0); PK4(p0, 8, pa1); PK4(p1, 0, pa2); PK4(p1, 8, pa3);
#undef PK4
}
template <int KB>
__device__ __forceinline__ void qkt(f32x16& p0, f32x16& p1, const char* K_lds, int r32, int hi, const bf16x8* qr) {
    p0 = f32x16{}; p1 = f32x16{};
    const char* kb[4];
#pragma unroll
    for (int dd = 0; dd < 4; ++dd) kb[dd] = K_lds + KB * SHM_K + KSWZ(r32, (dd * 16 + hi * 8) * 2);
#pragma unroll
    for (int d0 = 0; d0 < 6; ++d0) { const char* a = kb[d0 & 3] + (d0 >> 2) * 128;
        bf16x8 b0 = *reinterpret_cast<const bf16x8*>(a);
        bf16x8 b1 = *reinterpret_cast<const bf16x8*>(a + 32 * 256);
        p0 = __builtin_amdgcn_mfma_f32_32x32x16_bf16(b0, qr[d0], p0, 0, 0, 0);
        p1 = __builtin_amdgcn_mfma_f32_32x32x16_bf16(b1, qr[d0], p1, 0, 0, 0); }
}
template <int VB>
__device__ __forceinline__ void pv_tile(f32x16* o, int vb0, bf16x8 pa0, bf16x8 pa1, bf16x8 pa2, bf16x8 pa3) {
#define TRRD(dst, off) asm volatile("ds_read_b64_tr_b16 %0, %1 offset:%2" : "=&v"(dst) : "v"(vb0), "i"(off) : "memory")
#define V8_(l_, h_) (bf16x8){l_[0], l_[1], l_[2], l_[3], h_[0], h_[1], h_[2], h_[3]}
    { s16x4 a0, a1, a2, a3, b0, b1, b2, b3, c0, c1, c2, c3, e0, e1, e2, e3; constexpr int b_ = VB * SHM_V;
      TRRD(a0, b_); TRRD(b0, b_ + 1024); TRRD(a1, b_ + 2048); TRRD(b1, b_ + 3072); TRRD(a2, b_ + 4096); TRRD(b2, b_ + 5120); TRRD(a3, b_ + 6144); TRRD(b3, b_ + 7168);
      TRRD(c0, b_ + 512); TRRD(e0, b_ + 512 + 1024); TRRD(c1, b_ + 512 + 2048); TRRD(e1, b_ + 512 + 3072); TRRD(c2, b_ + 512 + 4096); TRRD(e2, b_ + 512 + 5120); TRRD(c3, b_ + 512 + 6144); TRRD(e3, b_ + 512 + 7168);
      asm volatile("s_waitcnt lgkmcnt(8)" ::: "memory"); SBAR();
      o[0] = __builtin_amdgcn_mfma_f32_32x32x16_bf16(pa0, V8_(a0, b0), o[0], 0, 0, 0);
      o[0] = __builtin_amdgcn_mfma_f32_32x32x16_bf16(pa1, V8_(a1, b1), o[0], 0, 0, 0);
      asm volatile("s_waitcnt lgkmcnt(0)" ::: "memory"); SBAR();
      o[1] = __builtin_amdgcn_mfma_f32_32x32x16_bf16(pa0, V8_(c0, e0), o[1], 0, 0, 0);
      o[0] = __builtin_amdgcn_mfma_f32_32x32x16_bf16(pa2, V8_(a2, b2), o[0], 0, 0, 0);
      o[1] = __builtin_amdgcn_mfma_f32_32x32x16_bf16(pa1, V8_(c1, e1), o[1], 0, 0, 0);
      o[0] = __builtin_amdgcn_mfma_f32_32x32x16_bf16(pa3, V8_(a3, b3), o[0], 0, 0, 0);
      o[1] = __builtin_amdgcn_mfma_f32_32x32x16_bf16(pa2, V8_(c2, e2), o[1], 0, 0, 0);
      o[1] = __builtin_amdgcn_mfma_f32_32x32x16_bf16(pa3, V8_(c3, e3), o[1], 0, 0, 0); }
#undef V8_
#define PV_D0(d0) do {} while (0)
#undef PV_D0
#undef TRRD
}
struct BlockRef { const bf16_t* Q; const bf16_t* KN; const bf16_t* KPE; const bf16_t* V; bf16_t* O; int P0; };
struct Seam { bf16x8 qr[6]; bf16x8 st_v[2], st_kn[2], st_kp[2]; };
#define VMW() asm volatile("s_waitcnt vmcnt(0)" ::: "memory")
#define VMWN(n) asm volatile("s_waitcnt vmcnt(%0)" :: "i"(n) : "memory")
#define VMW_KEEP1() asm volatile("s_waitcnt vmcnt(3)" ::: "memory")
#define SLOAD(ref, k0, X) do { S.st_v[X] = load8((ref).V + (size_t)((k0) + vr) * LDV + vc8); S.st_kn[X] = load8((ref).KN + (size_t)((k0) + vr) * LDKN + vc8); \
                            S.st_kp[X] = load8((ref).KPE + (size_t)((k0) + pr) * LDKP + pc8); } while (0)
#define SWRITE_K(bf, X) do { *(bf16x8*)(K_lds + (bf) * SHM_K + kws) = S.st_kn[X]; *(bf16x8*)(K_lds + (bf) * SHM_K + kpws) = S.st_kp[X]; } while (0)
#define SWRITE_V(bf, X) do { *(bf16x8*)(V_lds + (bf) * SHM_V + vst) = S.st_v[X]; } while (0)
__device__ __forceinline__ void attn_prime(const BlockRef& cur, char* lds, Seam& S, const int wid) {
    const int lane = lane_id_v(), tid = wid * 64 + lane, r32 = lane & 31, hi = lane >> 5;
    const int vr = tid >> 3, vc8 = (tid & 7) * 8, pr = (tid >> 2) & 63, pc8 = (tid & 3) * 8;
    const int kws = KSWZ(vr, vc8 * 2), kpws = KSWZ(pr, (64 + pc8) * 2); char* K_lds = lds + 2 * SHM_V;
#pragma unroll
    for (int d0 = 0; d0 < 6; ++d0) S.qr[d0] = load8(cur.Q + (size_t)(wid * QBLK + r32) * LDQ + d0 * 16 + hi * 8);
    SLOAD(cur, 0, 0); VMW(); SWRITE_K(0, 0);
    __syncthreads();
}
__device__ __forceinline__ void attn_block(const BlockRef& cur, const BlockRef& nxt, char* lds, Seam& S, const int wid) {
    const int lane = lane_id_v(), tid = wid * 64 + lane, r32 = lane & 31, hi = lane >> 5;
    const int NT = (cur.P0 + QB - 1) / KVBLK + 1;
    const int qlo = cur.P0 + wid * QBLK, qm = qlo + r32 - 4 * hi;
    char* V_lds = lds; char* K_lds = lds + 2 * SHM_V;
    float* ws = (float*)(lds + 2 * SHM_V + 2 * SHM_K) + wid * 64; float* li_l = ws, * al_l = ws + 32;
    float m_reg = -1e30f, l_reg = 0; f32x16 o[2] = {};
    const int vr = tid >> 3, vc8 = (tid & 7) * 8, pr = (tid >> 2) & 63, pc8 = (tid & 3) * 8;
    const int vst = v_st(vr, vc8), kws = KSWZ(vr, vc8 * 2), kpws = KSWZ(pr, (64 + pc8) * 2);
    const int vb0 = (int)(uintptr_t)V_lds + v_rd_base(lane);
#define RESC(a) do { if (__any((a) < 1.f)) { if (hi == 0) al_l[r32] = (a); asm volatile("s_waitcnt lgkmcnt(0)" ::: "memory");              \
                     _Pragma("unroll") for (int d_ = 0; d_ < 2; ++d_) _Pragma("unroll") for (int r = 0; r < 16; ++r) o[d_][r] *= al_l[crow(r, hi)]; } } while (0)
#define KBASE(t) ((t) * KVBLK)
#define MASKT(P0_, P1_, t) do { const int kb_ = KBASE(t); if ((t) == 0) mask_meta(P0_, P1_); else if (kb_ + KVBLK - 1 > qlo) mask_tile(P0_, P1_, qm - kb_); } while (0)
    constexpr int NQL = 6;
#define SEAM_K0() do { VMWN(NQL); SWRITE_K(0, 0); SBAR(); } while (0)
    f32x16 pA0, pA1, pB0, pB1; float mnA, mnB, alA, alB; bf16x8 pa0, pa1, pa2, pa3;
    SWRITE_V(0, 0); SBAR();
    SLOAD(cur, KBASE(1), 1); SBAR(); SLOAD(cur, KBASE(2), 0);
    SBAR(); qkt<0>(pA0, pA1, K_lds, r32, hi, S.qr);
    MASKT(pA0, pA1, 0); partialSM(pA0, pA1, m_reg, mnA, alA);
    VMW_KEEP1(); SWRITE_V(1, 1); SWRITE_K(1, 1);
    __syncthreads();
#define HALF_STEP(PX0, PX1, mnX, alX, PY0, PY1, alY, t, KB, VB, SB, XS, XL, LOADS, WRITES) do {                                              \
        SBAR(); qkt<KB>(PX0, PX1, K_lds, r32, hi, S.qr);                                                           \
        finishSM(PY0, PY1, alY, l_reg, pa0, pa1, pa2, pa3); SBAR();                                                           \
        if (LOADS) { SLOAD(cur, KBASE((t) + 2), XL); SBAR(); }                                               \
        pv_tile<VB>(o, vb0, pa0, pa1, pa2, pa3); MASKT(PX0, PX1, (t)); partialSM(PX0, PX1, m_reg, mnX, alX);                  \
        __syncthreads();                                                                                                      \
        if (WRITES) { if (LOADS) VMW_KEEP1(); else VMW(); SWRITE_V(SB, XS); SWRITE_K(SB, XS); }                                                                          \
        RESC(alX); __syncthreads(); } while (0)
    int t = 1;
    for (; t + 3 < NT; t += 2) {
        HALF_STEP(pB0, pB1, mnB, alB, pA0, pA1, alA, t, 1, 0, 0, 0, 1, true, true);
        HALF_STEP(pA0, pA1, mnA, alA, pB0, pB1, alB, t + 1, 0, 1, 1, 1, 0, true, true);
    }
    HALF_STEP(pB0, pB1, mnB, alB, pA0, pA1, alA, t, 1, 0, 0, 0, 1, false, true);
    HALF_STEP(pA0, pA1, mnA, alA, pB0, pB1, alB, t + 1, 0, 1, 1, 1, 0, false, false);
    SLOAD(nxt, 0, 0); SBAR();
#pragma unroll
    for (int d0 = 0; d0 < 6; ++d0) S.qr[d0] = load8(nxt.Q + (size_t)(wid * QBLK + r32) * LDQ + d0 * 16 + hi * 8);
    SBAR();
    finishSM(pA0, pA1, alA, l_reg, pa0, pa1, pa2, pa3); SBAR();
    pv_tile<0>(o, vb0, pa0, pa1, pa2, pa3);
    SBAR(); SEAM_K0();
    if (hi == 0) li_l[r32] = l_reg; asm volatile("s_waitcnt lgkmcnt(0)" ::: "memory");
    float rli[16];
#pragma unroll
    for (int r = 0; r < 16; ++r) rli[r] = __builtin_amdgcn_rcpf(li_l[crow(r, hi)]);
    bf16_t* Ow = cur.O + (size_t)(wid * QBLK) * LDO;
#pragma unroll
    for (int r = 0; r < 16; ++r) { const int orow = crow(r, hi);
#pragma unroll
        for (int d0 = 0; d0 < 2; ++d0) { const float v = o[d0][r] * rli[r];
            const float vn = __shfl_xor(v, 1);
            if ((r32 & 1) == 0) *(unsigned*)(Ow + (size_t)orow * LDO + d0 * 32 + r32) = cvtpk(v, vn); } }
    __syncthreads();
#undef RESC
#undef KBASE
#undef MASKT
#undef SEAM_K0
#undef HALF_STEP
}
#undef VMW_KEEP1
#undef VMW
#undef VMWN
#undef SLOAD
#undef SWRITE_K
#undef SWRITE_V
#undef KSWZ
#undef SBAR
}

constexpr int NWAVES = 8;
constexpr int N_PHASES = 13;
constexpr size_t MiB = 1u << 20;
constexpr size_t WS_CTL = 0, CTL_ZERO_BYTES = 64 * 1024;
constexpr size_t WS_WRP  = 1 * MiB;
constexpr size_t WS_WUQ  = 2 * MiB;
constexpr size_t WS_WUKV = 3 * MiB;
constexpr size_t WS_WG   = 4 * MiB;
constexpr size_t WS_WAO  = 5 * MiB;
constexpr size_t WS_WRO  = 6 * MiB;
constexpr size_t WS_WOUT = 8 * MiB;
constexpr size_t WS_WIN  = 10 * MiB;
constexpr size_t WS_WUP  = 20 * MiB;
constexpr size_t WS_WDN  = 148 * MiB;
constexpr size_t WS_ACT  = 212 * MiB;
constexpr size_t WS_GATE = 212 * MiB;
constexpr size_t WS_GRG  = 341 * MiB;
constexpr size_t WS_XN   = 406 * MiB;
constexpr size_t WS_XC   = WS_XN, WS_MA = WS_XN;
constexpr size_t WS_YE   = 484 * MiB;
constexpr size_t WS_PQ   = 484 * MiB;
constexpr size_t WS_Y    = 484 * MiB;
constexpr size_t WS_PRX  = 533 * MiB;
constexpr size_t WS_R16  = 598 * MiB;
constexpr size_t WS_MG   = 598 * MiB;
constexpr size_t WS_U16  = 663 * MiB;
constexpr size_t WS_CQ   = 728 * MiB;
constexpr size_t WS_H2   = 756 * MiB;
constexpr size_t WS_HB   = 884 * MiB;
constexpr size_t WS_Q    = 756 * MiB;
constexpr size_t WS_KN   = 804 * MiB;
constexpr size_t WS_V    = 837 * MiB;
constexpr size_t WS_O    = 870 * MiB;
constexpr size_t WS_CKV  = 902 * MiB;
constexpr size_t WS_KPE  = 919 * MiB;
constexpr size_t WS_ROPE = 922 * MiB;
constexpr size_t WS_AGF  = 924 * MiB;
constexpr size_t WS_AGC  = 932 * MiB;
constexpr size_t WS_ELIST = 948 * MiB;
constexpr size_t WS_RSTDS = 952 * MiB;
constexpr size_t WS_GATES = 956 * MiB;
constexpr size_t WS_TOKSL = 960 * MiB;
constexpr size_t WS_END   = 1024 * MiB;
constexpr int CW_BAR = 1024;
constexpr int CW_CNT = 8192;
constexpr int RING_BYTES = 131072;
constexpr int LDSCTL_OFF = RING_BYTES, MISC_OFF = LDSCTL_OFF + 64;
constexpr int LDS_BYTES = 151552;
constexpr int LT_TS = 64;
constexpr int LT_LCNT = 160, LT_LBASE = 192;

#define XB_TMO      128
#define XB_XCNT(j)  (256  + 64 * (j))
#define XB_XSUB(j)  (1280 + 64 * (j))
#define XB_XGEN(j)  (2304 + 64 * (j))
#define XB_TOP      3328
#define XB_TOPGEN   3392
#define XCD_BAR_WORDS 3456
#define XB_SPIN_CAP (1u << 18)
__device__ __forceinline__ unsigned xb_ld(unsigned* p)              { return __hip_atomic_load(p, __ATOMIC_RELAXED, __HIP_MEMORY_SCOPE_AGENT); }
__device__ __forceinline__ unsigned xb_add(unsigned* p, unsigned v) { return __hip_atomic_fetch_add(p, v, __ATOMIC_RELAXED, __HIP_MEMORY_SCOPE_AGENT); }
__device__ __forceinline__ unsigned xb_xcc_id() { return (unsigned)__builtin_amdgcn_s_getreg((3 << 11) | 20) & 0xFu; }
#define XB_SPIN(cond, bar) do { unsigned _sp = 0; while (cond) { __builtin_amdgcn_s_sleep(1); \
    if ((++_sp & 255u) == 0u) { if (xb_ld(&(bar)[XB_TMO])) break; if (_sp > XB_SPIN_CAP) { atomicAdd(&(bar)[XB_TMO], 1u); break; } } } } while (0)
struct XcdBarrier { unsigned* bar; unsigned x; volatile LAS unsigned* st; int wid; };
__device__ __forceinline__ XcdBarrier xcd_barrier_post(unsigned* bar, volatile LAS unsigned* st, const int wid) {
    XcdBarrier b; b.bar = bar; b.x = xb_xcc_id(); b.st = st; b.wid = wid;
    if (wid == 0 && lane_id_v() == 0) (void)xb_add(&bar[XB_XCNT(b.x)], 1u);
    return b;
}
__device__ __forceinline__ void xcd_barrier_complete(unsigned* bar, unsigned x, unsigned& nloc, unsigned& nx) {
    const unsigned G = gridDim.x * gridDim.y * gridDim.z;
    unsigned sum, cnt, mine, sp = 0u;
    for (;;) {
        sum = 0u; cnt = 0u; mine = 0u;
#pragma unroll
        for (unsigned j = 0; j < 16; ++j) { const unsigned c = xb_ld(&bar[XB_XCNT(j)]); sum += c; cnt += (c > 0u) ? 1u : 0u; mine = (j == x) ? c : mine; }
        if (sum == G) break;
        __builtin_amdgcn_s_sleep(1);
        if ((++sp & 255u) == 0u) { if (xb_ld(&bar[XB_TMO])) break; if (sp > XB_SPIN_CAP) { atomicAdd(&bar[XB_TMO], 1u); break; } }
    }
    nloc = mine > 0u ? mine : 1u; nx = cnt > 0u ? cnt : 1u;
}
__device__ __forceinline__ void xcd_barrier(const XcdBarrier& b) {
    asm volatile("s_waitcnt vmcnt(0)" ::: "memory");
    __syncthreads();
    if (b.wid == 0 && lane_id_v() == 0) {
        unsigned* bar = b.bar;
        __builtin_amdgcn_s_waitcnt(0);
        unsigned nloc = b.st[0], nx = b.st[1];
        if (nloc == 0u) { xcd_barrier_complete(bar, b.x, nloc, nx); b.st[0] = nloc; b.st[1] = nx; }
        const unsigned old = xb_add(&bar[XB_XSUB(b.x)], 1u);
        const unsigned gen = old / nloc;
        if (old + 1u == (gen + 1u) * nloc) {
            __builtin_amdgcn_fence(__ATOMIC_RELEASE, "agent");
            asm volatile("s_waitcnt vmcnt(0)" ::: "memory");
            const unsigned og = xb_add(&bar[XB_TOP], 1u);
            const unsigned tg = og / nx;
            if (og + 1u == (tg + 1u) * nx) xb_add(&bar[XB_TOPGEN], 1u);
            else XB_SPIN(xb_ld(&bar[XB_TOPGEN]) == tg, bar);
            __builtin_amdgcn_fence(__ATOMIC_ACQUIRE, "agent");
            xb_add(&bar[XB_XGEN(b.x)], 1u);
            asm volatile("s_waitcnt vmcnt(0)" ::: "memory");
        } else {
            XB_SPIN(xb_ld(&bar[XB_XGEN(b.x)]) == gen, bar);
            __builtin_amdgcn_fence(__ATOMIC_ACQUIRE, "agent");
            asm volatile("s_waitcnt vmcnt(0)" ::: "memory");
        }
    }
    __syncthreads();
}

struct Args {
    const float* in[27]; float* out; unsigned char* ws; double rope_inv[16]; int ph_lo, ph_hi;
};
enum { I_X = 0, I_META, I_NMG, I_WIN, I_BGATE, I_QNG, I_WUQ, I_KVNG, I_WUKV, I_WAO, I_CONVW, I_CONVB, I_WRGA, I_BRGA, I_WRGX, I_BRGX, I_LAMBDA, I_WRO, I_WOUT, I_NFG, I_WROUTER, I_BROUTER, I_WUP, I_BUP, I_WDOWN, I_BDOWN, I_NFINAL };

struct TMap { const float* W; int ldw; bf16_t* WT; int ldt; int nblk; int mode; const float* ks; };
__device__ __forceinline__ int tmap_col(int mode, int np) {
    if (mode == 0) return np;
    if (mode == 1) return np < 672 ? np : (np < 768 ? -1 : np - 96);
    if (mode == 2) { const int h = np / 96, o = np - 96 * h; if (o < 64) return np; const int p = o - 64; return 96 * h + 64 + (p & 1) * 16 + (p >> 1); }
    const int pn = np >> 8, w = np & 255; return w < 128 ? 128 * pn + w : 1024 + 128 * pn + (w - 128);
}
__device__ __forceinline__ void transpose_item(const TMap& mp, LAS float* scr, int item, int lane) {
    const int kb = item / mp.nblk, nb = item % mp.nblk, k0 = 64 * kb, n0 = 32 * nb;
    const int sc = tmap_col(mp.mode, n0 + (lane & 31));
#pragma unroll 8
    for (int i = 0; i < 32; ++i) { const int kk = 2 * i + (lane >> 5);
        float v = sc >= 0 ? mp.W[(size_t)(k0 + kk) * mp.ldw + sc] : 0.f;
        if (mp.ks) v *= mp.ks[k0 + kk];
        scr[kk * 33 + (lane & 31)] = v; }
    asm volatile("s_waitcnt lgkmcnt(0)" ::: "memory");
    const int c = lane & 7;
#pragma unroll
    for (int j = 0; j < 4; ++j) { const int n = (lane >> 3) + 8 * j; const LAS float* s = scr + (8 * c) * 33 + n;
        u32x4 o; o.x = cvt_pk_bf16(s[0 * 33], s[1 * 33]); o.y = cvt_pk_bf16(s[2 * 33], s[3 * 33]); o.z = cvt_pk_bf16(s[4 * 33], s[5 * 33]); o.w = cvt_pk_bf16(s[6 * 33], s[7 * 33]);
        *(u32x4*)(mp.WT + (size_t)(n0 + n) * mp.ldt + k0 + 8 * c) = o; }
    asm volatile("s_waitcnt lgkmcnt(0)" ::: "memory");
}
__device__ __forceinline__ void transpose_item2(const TMap& mp, LAS unsigned* scr, int item, int lane) {
    const int nblk = mp.nblk >> 2;
    const int kb = item / nblk, nb = item % nblk, k0 = 32 * kb, n0 = 128 * nb;
    const int nl = 4 * (lane & 31), hw = lane >> 5;
    const int sc = tmap_col(mp.mode, n0 + nl);
#pragma unroll
    for (int i = 0; i < 8; ++i) { const int k = k0 + 4 * i + 2 * hw;
        f32x4 a = {0.f, 0.f, 0.f, 0.f}, b = {0.f, 0.f, 0.f, 0.f};
        if (sc >= 0) { a = __builtin_nontemporal_load((const f32x4*)(mp.W + (size_t)k * mp.ldw + sc)); b = __builtin_nontemporal_load((const f32x4*)(mp.W + (size_t)(k + 1) * mp.ldw + sc)); }
        if (mp.ks) { a *= mp.ks[k]; b *= mp.ks[k + 1]; }
        const int kp = 2 * i + hw;
        scr[(nl + 0) * 17 + kp] = cvt_pk_bf16(a.x, b.x); scr[(nl + 1) * 17 + kp] = cvt_pk_bf16(a.y, b.y);
        scr[(nl + 2) * 17 + kp] = cvt_pk_bf16(a.z, b.z); scr[(nl + 3) * 17 + kp] = cvt_pk_bf16(a.w, b.w); }
    asm volatile("s_waitcnt lgkmcnt(0)" ::: "memory");
    const int c = lane & 3;
#pragma unroll
    for (int j = 0; j < 8; ++j) { const int n = (lane >> 2) + 16 * j; const LAS unsigned* sp = scr + n * 17 + 4 * c;
        u32x4 o; o.x = sp[0]; o.y = sp[1]; o.z = sp[2]; o.w = sp[3];
        *(u32x4*)(mp.WT + (size_t)(n0 + n) * mp.ldt + k0 + 8 * c) = o; }
    asm volatile("s_waitcnt lgkmcnt(0)" ::: "memory");
}
__device__ __forceinline__ void transpose_item8(const TMap& mp, LAS unsigned* scr, int item, int lane) {
    const int nblk = mp.nblk >> 2;
    const int kb = item / nblk, nb = item % nblk, k0 = 64 * kb, n0 = 128 * nb;
    const int nl = 4 * (lane & 31), hw = lane >> 5;
    const int sc = tmap_col(mp.mode, n0 + nl);
#pragma unroll
    for (int i = 0; i < 8; ++i) { const int k = k0 + 8 * i + 4 * hw;
        f32x4 r[4];
#pragma unroll
        for (int q = 0; q < 4; ++q) { r[q] = *(const f32x4*)(mp.W + (size_t)(k + q) * mp.ldw + sc); r[q] *= (mp.ks ? mp.ks[k + q] : 1.f) * W8_SCALE; }
        const int kq = 2 * i + hw;
#pragma unroll
        for (int j = 0; j < 4; ++j) scr[(nl + j) * 17 + kq] = pack_fp8x4(r[0][j], r[1][j], r[2][j], r[3][j]); }
    asm volatile("s_waitcnt lgkmcnt(0)" ::: "memory");
    const int c = lane & 3;
    unsigned char* WT8 = (unsigned char*)mp.WT;
#pragma unroll
    for (int j = 0; j < 8; ++j) { const int n = (lane >> 2) + 16 * j; const LAS unsigned* sp = scr + n * 17 + 4 * c;
        u32x4 o; o.x = sp[0]; o.y = sp[1]; o.z = sp[2]; o.w = sp[3];
        *(u32x4*)(WT8 + (size_t)(n0 + n) * mp.ldt + k0 + 16 * c) = o; }
    asm volatile("s_waitcnt lgkmcnt(0)" ::: "memory");
}
__device__ __forceinline__ void xpose8_block(const float* W, int ldw, int mode, int n0, int k0, unsigned char* dst  , LAS unsigned char* lds, int wave, int lane) {
    LAS unsigned* tile = (LAS unsigned*)lds;
    int sc[4];
#pragma unroll
    for (int j = 0; j < 4; ++j) sc[j] = tmap_col(mode, n0 + 256 * j + 4 * lane);
    const unsigned xo = (unsigned)(lane & 15) << 1;
    f32x4 XA[4][4], XB[4][4];
#define X8_LOAD(X_, qd) do { _Pragma("unroll") for (int r = 0; r < 4; ++r) _Pragma("unroll") for (int j = 0; j < 4; ++j) \
        X_[r][j] = __builtin_nontemporal_load((const f32x4*)(W + (size_t)(k0 + 64 * ((qd) >> 1) + 8 * wave + 4 * ((qd) & 1) + r) * ldw + sc[j])); } while (0)
#define X8_CVT(X_, qd) do { const unsigned kd = (unsigned)(16 * ((qd) >> 1) + 2 * wave + ((qd) & 1)); _Pragma("unroll") for (int j = 0; j < 4; ++j) _Pragma("unroll") for (int c = 0; c < 4; ++c) \
        tile[(256 * j + 4 * lane + c) * 32 + (kd ^ xo)] = pack_fp8x4(X_[0][j][c] * W8_SCALE, X_[1][j][c] * W8_SCALE, X_[2][j][c] * W8_SCALE, X_[3][j][c] * W8_SCALE); } while (0)
    X8_LOAD(XA, 0); X8_LOAD(XB, 1); __builtin_amdgcn_sched_barrier(0);
    X8_CVT(XA, 0); __builtin_amdgcn_sched_barrier(0); X8_LOAD(XA, 2); __builtin_amdgcn_sched_barrier(0);
    X8_CVT(XB, 1); __builtin_amdgcn_sched_barrier(0); X8_LOAD(XB, 3); __builtin_amdgcn_sched_barrier(0);
    X8_CVT(XA, 2); __builtin_amdgcn_sched_barrier(0); X8_CVT(XB, 3);
#undef X8_LOAD
#undef X8_CVT
    __syncthreads();
    const int t = wave * 64 + lane;
#pragma unroll 4
    for (int i = 0; i < 16; ++i) { const int id = t + 512 * i, row = id >> 3, q = id & 7; const unsigned xr = (unsigned)((row >> 2) & 15) << 1;
        const u32x2 a = *(const LAS u32x2*)(tile + row * 32 + ((4u * q) ^ xr)), b = *(const LAS u32x2*)(tile + row * 32 + ((4u * q + 2u) ^ xr));
        u32x4 o; o.x = a.x; o.y = a.y; o.z = b.x; o.w = b.y;
        *(u32x4*)(dst + (size_t)row * 1024 + 16 * q) = o; }
    __syncthreads();
}
__device__ __forceinline__ void rms_row_to_bf16(const float* xrow, const float* gain, bf16_t* orow, int lane) {
    const f32x4* xr = (const f32x4*)xrow + lane; const f32x4* gr = (const f32x4*)gain + lane;
    f32x4 v[4]; float s = 0.f;
#pragma unroll
    for (int j = 0; j < 4; ++j) { v[j] = xr[64 * j]; s += (v[j].x * v[j].x + v[j].y * v[j].y) + (v[j].z * v[j].z + v[j].w * v[j].w); }
    const float rstd = 1.f / sqrtf(wave_sum(s) * (1.f / 1024.f) + EPS);
    u32x2* o8 = (u32x2*)orow + lane;
#pragma unroll
    for (int j = 0; j < 4; ++j) { const f32x4 g = gr[64 * j]; u32x2 w; w.x = cvt_pk_bf16(v[j].x * rstd * g.x, v[j].y * rstd * g.y); w.y = cvt_pk_bf16(v[j].z * rstd * g.z, v[j].w * rstd * g.w); o8[64 * j] = w; }
}

__device__ __forceinline__ void build_moe_table(volatile LAS int* tbl, const unsigned* gcnt, const int wid) {
    const int t_ = wid * 64 + lane_id_v();
    __syncthreads();
    if (t_ < 32) tbl[LT_TS + 40 + t_] = (int)__hip_atomic_load(gcnt + t_, __ATOMIC_RELAXED, __HIP_MEMORY_SCOPE_AGENT);
    __syncthreads();
    if (t_ == 0) { int acc = 0; for (int e = 0; e < 32; ++e) { tbl[LT_TS + e] = acc; acc += (tbl[LT_TS + 40 + e] + 255) >> 8; } tbl[LT_TS + 32] = acc; }
    __syncthreads();
}

__device__ __forceinline__ att::BlockRef att_mkref(int item, int pass, bf16_t* QB, bf16_t* KN, bf16_t* KPE, bf16_t* VB, bf16_t* OB) {
    const int bh = item >> 4, x = item & 15, qb = pass ? 31 - x : x, b = bh >> 3, h = bh & 7;
    att::BlockRef r; r.Q = QB + ((size_t)b * 8192 + (size_t)qb * 256) * 768 + h * 96; r.KN = KN + (size_t)b * TP * 512 + h * 64; r.KPE = KPE + (size_t)b * TP * 32;
    r.V = VB + (size_t)b * TP * 512 + h * 64; r.O = OB + ((size_t)b * 8192 + (size_t)qb * 256) * 512 + h * 64; r.P0 = MBLK + 256 * qb; return r;
}
__device__ __forceinline__ void lru_step8(const h16x8 r, const h16x8 u, const float (&kc)[8], float (&h)[8], float (&A)[8]) {
#pragma unroll
    for (int j = 0; j < 8; ++j) { const float a = __builtin_amdgcn_exp2f((float)r[j] * kc[j]); const float b = __builtin_amdgcn_sqrtf(fmaxf(1.f - a * a, 0.f)) * (float)u[j]; h[j] = a * h[j] + b; A[j] *= a; }
}
__device__ __forceinline__ void lru_kc8(const float* lam, int ch, float (&kc)[8]) {
    const f32x4 l0 = *(const f32x4*)(lam + ch), l1 = *(const f32x4*)(lam + ch + 4); const float l[8] = {l0.x, l0.y, l0.z, l0.w, l1.x, l1.y, l1.z, l1.w};
#pragma unroll
    for (int j = 0; j < 8; ++j) { const float x = -l[j]; const float sp = x > 15.f ? x : log1pf(expf(x)); kc[j] = -8.f * sp * 1.4426950408889634f; }
}
__global__ void __launch_bounds__(NWAVES * 64, 2) mk_fwd(Args args) {
    extern __shared__ __attribute__((aligned(16))) unsigned char lds_raw[];
    LAS unsigned char* lds = (LAS unsigned char*)lds_raw;
    volatile LAS unsigned* MISC = (volatile LAS unsigned*)(lds + MISC_OFF);
    volatile LAS int* TBL = (volatile LAS int*)(lds + MISC_OFF);
    const int wave = __builtin_amdgcn_readfirstlane((int)threadIdx.x >> 6);
    const int G = gridDim.x; const int bx = blockIdx.x; const int vcu = (G % 8 == 0) ? (bx % 8) * (G / 8) + bx / 8 : bx;
    unsigned char* ws = args.ws;
    unsigned* ctl = (unsigned*)(ws + WS_CTL);
    for (int u = (int)threadIdx.x; u < (LDS_BYTES - LDSCTL_OFF) / 4; u += NWAVES * 64) ((LAS unsigned*)(lds + LDSCTL_OFF))[u] = 0u;
    __syncthreads();
    XcdBarrier bar; bar.bar = ctl + CW_BAR; bar.x = 0; bar.st = nullptr; bar.wid = wave;
    if (MK_N_LAUNCHES == 1) bar = xcd_barrier_post(ctl + CW_BAR, MISC, wave);
    const int lo = args.ph_lo, hi = args.ph_hi;
#define IN(k) (lo <= (k) && (k) < hi)
#define SEAM(k) do { if (IN(k) && IN((k) + 1)) xcd_barrier(bar); } while (0)
    bf16_t* WIN = (bf16_t*)(ws + WS_WIN); bf16_t* WUQ = (bf16_t*)(ws + WS_WUQ); bf16_t* WUKV = (bf16_t*)(ws + WS_WUKV); bf16_t* WG = (bf16_t*)(ws + WS_WG);
    bf16_t* WAO = (bf16_t*)(ws + WS_WAO); bf16_t* WRO = (bf16_t*)(ws + WS_WRO); bf16_t* WOUT = (bf16_t*)(ws + WS_WOUT); unsigned char* WUP8 = ws + WS_WUP; unsigned char* WDN8 = ws + WS_WDN;
    float* WRP = (float*)(ws + WS_WRP);
    bf16_t* XN = (bf16_t*)(ws + WS_XN); bf16_t* XC = (bf16_t*)(ws + WS_XC); bf16_t* MA = (bf16_t*)(ws + WS_MA);
    bf16_t* PQ = (bf16_t*)(ws + WS_PQ); bf16_t* PRX = (bf16_t*)(ws + WS_PRX); bf16_t* GRG = (bf16_t*)(ws + WS_GRG); bf16_t* GATE = (bf16_t*)(ws + WS_GATE);
    bf16_t* CQ = (bf16_t*)(ws + WS_CQ); bf16_t* CKV = (bf16_t*)(ws + WS_CKV); bf16_t* KPE = (bf16_t*)(ws + WS_KPE);
    float* COS = (float*)(ws + WS_ROPE); float* SIN = COS + TPOS * 16;
    bf16_t* QB = (bf16_t*)(ws + WS_Q); bf16_t* KN = (bf16_t*)(ws + WS_KN); bf16_t* VB = (bf16_t*)(ws + WS_V); bf16_t* OB = (bf16_t*)(ws + WS_O);
    _Float16* R16 = (_Float16*)(ws + WS_R16); _Float16* U16 = (_Float16*)(ws + WS_U16);
    float* AGF = (float*)(ws + WS_AGF); float* AGC = (float*)(ws + WS_AGC);
    bf16_t* YB = (bf16_t*)(ws + WS_Y); bf16_t* MG = (bf16_t*)(ws + WS_MG);
    bf16_t* H2 = (bf16_t*)(ws + WS_H2); unsigned char* H8 = ws + WS_HB;
    int* ELIST = (int*)(ws + WS_ELIST); float* RSTDS = (float*)(ws + WS_RSTDS); float* GATES = (float*)(ws + WS_GATES); int* TOKSL = (int*)(ws + WS_TOKSL);
    unsigned char* ACT = ws + WS_ACT; unsigned char* YE = ws + WS_YE;
    unsigned* GCNT = ctl + CW_CNT;
    const int gw = vcu * NWAVES + wave, NGW = G * NWAVES;
    const int NGT = G * NWAVES * 64;
#define PHASE_IDS() const int lane = lane_id_v(); const int tid = wave * 64 + lane; const int gt = vcu * (NWAVES * 64) + tid; (void)gt; (void)tid; (void)lane

    auto convert_tile = [&](const int it) {
        const int lane = lane_id_v();
        {
            if (it < 512) { const int e = it >> 4, kb = (it >> 1) & 7, nb = it & 1;
                xpose8_block(args.in[I_WUP] + (size_t)e * 1024 * 2048, 2048, 3, 1024 * nb, 128 * kb, WUP8 + (size_t)e * 2048 * 1024 + (size_t)(1024 * nb) * 1024 + 128 * kb, lds, wave, lane); }
            else { const int q = it - 512, e = q >> 3, kb = q & 7;
                xpose8_block(args.in[I_WDOWN] + (size_t)e * 1024 * 1024, 1024, 0, 0, 128 * kb, WDN8 + (size_t)e * 1024 * 1024 + 128 * kb, lds, wave, lane); }
        }
    };
    if (IN(0)) for (int rep_ = 0; rep_ < REP_P0; ++rep_) {
        if (rep_) xcd_barrier(bar);
        PHASE_IDS();
        LAS float* scr = (LAS float*)(lds + wave * 16384);
        {
            constexpr int I_1 = 32 * 38, I_3 = 8 * 8, I_4 = 16 * 8, I_5 = 32 * 8, I_6 = 32 * 8;
            constexpr int NITEMS = I_1 + I_3 + I_4 + I_5 + I_6;
            for (int it = gw; it < NITEMS; it += NGW) {
                int r = it; TMap mp;
                if (r < I_1) { mp = TMap{args.in[I_WIN], 4768, WIN, 1024, 152, 1, nullptr}; }
                else if ((r -= I_1) < I_3) { mp = TMap{args.in[I_WUKV], 1024, WUKV, 256, 32, 0, nullptr}; }
                else if ((r -= I_3) < I_4) { mp = TMap{args.in[I_WAO], 1024, WAO, 512, 32, 0, nullptr}; }
                else if ((r -= I_4) < I_5) { mp = TMap{args.in[I_WRO], 1024, WRO, 1024, 32, 0, nullptr}; }
                else { r -= I_5; mp = TMap{args.in[I_WOUT], 1024, WOUT, 1024, 32, 0, nullptr}; }
                transpose_item2(mp, (LAS unsigned*)scr, r, lane);
            }
            { const TMap mq = TMap{args.in[I_WUQ], 768, WUQ, 384, 24, 2, nullptr};
              for (int it = gw; it < 6 * 24; it += NGW) transpose_item(mq, scr, it, lane); }
        }
        __syncthreads();
        for (int idx = gt; idx < 8 * 256 * 256; idx += NGT) { const int b = idx >> 16, np = (idx >> 8) & 255, kp = idx & 255;
            float v = 0.f; if ((kp >> 7) == (b & 1)) { const int i = kp & 127; v = np < 128 ? args.in[I_WRGA][(b * 128 + i) * 128 + np] : args.in[I_WRGX][(b * 128 + i) * 128 + (np - 128)]; }
            WG[idx] = (bf16_t)(cvt_pk_bf16(v, 0.f) & 0xffffu); }
        for (int idx = gt; idx < 32768; idx += NGT) { const int k = idx >> 5, e = idx & 31; const float w = args.in[I_NFG][k] * args.in[I_WROUTER][k * 32 + e];
            const unsigned hb = cvt_pk_bf16(w, 0.f) & 0xffffu; const float hf = __uint_as_float(hb << 16); const unsigned lb = cvt_pk_bf16(w - hf, 0.f) & 0xffffu;
            const int pos = ((((k >> 5) * 2 + (e >> 4)) * 2) * 64 + ((((k >> 3) & 3) << 4) | (e & 15))) * 8 + (k & 7);
            ((unsigned short*)WRP)[pos] = (unsigned short)hb; ((unsigned short*)WRP)[pos + 512] = (unsigned short)lb; }
        for (int idx = gt; idx < TPOS * 16; idx += NGT) { const int t = idx >> 4, i = idx & 15; const double ang = (double)t * args.rope_inv[i] * 0.15915494309189535; const float rev = (float)(ang - floor(ang));
            COS[idx] = __builtin_amdgcn_cosf(rev); SIN[idx] = __builtin_amdgcn_sinf(rev); }
        { const f32x4* gr = (const f32x4*)args.in[I_NMG] + lane; f32x4 gn4[4];
#pragma unroll
          for (int j = 0; j < 4; ++j) gn4[j] = gr[64 * j];
          for (int m4 = gw * 4; m4 < RROWS; m4 += NGW * 4) {
              const int i4 = (m4 - NX) & 63;
              if (m4 >= NX && i4 >= NMETA) { const u32x2 z = {0u, 0u};
#pragma unroll
                  for (int r = 0; r < 4; ++r) { u32x2* o8 = (u32x2*)(XN + (size_t)(m4 + r) * 1024) + lane;
#pragma unroll
                      for (int j = 0; j < 4; ++j) o8[64 * j] = z; }
                  continue; }
              const float* src = m4 < NX ? args.in[I_X] + (size_t)m4 * 1024 : args.in[I_META] + (size_t)i4 * 1024;
              f32x4 v[4][4]; float ss[4];
#pragma unroll
              for (int r = 0; r < 4; ++r) { const f32x4* xr = (const f32x4*)(src + (size_t)r * 1024) + lane;
#pragma unroll
                  for (int j = 0; j < 4; ++j) v[r][j] = __builtin_nontemporal_load(xr + 64 * j); }
#pragma unroll
              for (int r = 0; r < 4; ++r) { float a = 0.f;
#pragma unroll
                  for (int j = 0; j < 4; ++j) a += (v[r][j].x * v[r][j].x + v[r][j].y * v[r][j].y) + (v[r][j].z * v[r][j].z + v[r][j].w * v[r][j].w);
                  ss[r] = a; }
#pragma unroll
              for (int o = 1; o < 64; o <<= 1) {
#pragma unroll
                  for (int r = 0; r < 4; ++r) ss[r] += __shfl_xor(ss[r], o); }
#pragma unroll
              for (int r = 0; r < 4; ++r) { const float rstd = 1.f / sqrtf(ss[r] * (1.f / 1024.f) + EPS); u32x2* o8 = (u32x2*)(XN + (size_t)(m4 + r) * 1024) + lane;
#pragma unroll
                  for (int j = 0; j < 4; ++j) { const f32x4 g = gn4[j]; u32x2 w; w.x = cvt_pk_bf16(v[r][j].x * rstd * g.x, v[r][j].y * rstd * g.y); w.y = cvt_pk_bf16(v[r][j].z * rstd * g.z, v[r][j].w * rstd * g.w); o8[64 * j] = w; } }
          }
        }
    }
    SEAM(0);
    if (IN(1)) {
        g8::PPlain g{XN, WIN, 2048u, 2048u, 16}; g8::StaticOrder S; S.init(RROWS, NPROJ, G, bx);
        g8::EpiProj E{PQ, PRX, GRG, GATE, args.in[I_BGATE]};
        for (int rep_ = 0; rep_ < REP_P1; ++rep_) { if (rep_) xcd_barrier(bar); g8::gemm_phase(lds, wave, g, S, E); }
    }
    SEAM(1);
    if (IN(2)) for (int rep_ = 0; rep_ < REP_P2; ++rep_) {
        if (rep_) xcd_barrier(bar);
        PHASE_IDS();
        const float* gq = args.in[I_QNG]; const float* gkv = args.in[I_KVNG];
        {
            const int l16 = lane & 15, rsub = lane >> 4;
            f32x4 gqv[3][2], gkvv[2][2];
#pragma unroll
            for (int j = 0; j < 3; ++j) { gqv[j][0] = *(const f32x4*)(gq + 8 * (l16 + 16 * j)); gqv[j][1] = *(const f32x4*)(gq + 8 * (l16 + 16 * j) + 4); }
#pragma unroll
            for (int j = 0; j < 2; ++j) { gkvv[j][0] = *(const f32x4*)(gkv + 8 * (l16 + 16 * j)); gkvv[j][1] = *(const f32x4*)(gkv + 8 * (l16 + 16 * j) + 4); }
            for (int gi = gw; gi < RROWS / 4; gi += NGW) {
                const int m = 4 * gi + rsub; const bf16_t* prow = PQ + (size_t)m * 768;
                u32x4 wq[3], wk[2];
#pragma unroll
                for (int j = 0; j < 3; ++j) wq[j] = *(const u32x4*)(prow + 8 * (l16 + 16 * j));
#pragma unroll
                for (int j = 0; j < 2; ++j) wk[j] = *(const u32x4*)(prow + 384 + 8 * (l16 + 16 * j));
                const float x1 = __uint_as_float((unsigned)prow[640 + l16] << 16), x2 = __uint_as_float((unsigned)prow[656 + l16] << 16);
                const int t = pos_of(m);
                const float cs = COS[t * 16 + l16], sn = SIN[t * 16 + l16];
                float sq = 0.f, sk = 0.f;
#pragma unroll
                for (int j = 0; j < 3; ++j) { const u32x4 w = wq[j]; sq += bf_lo(w.x) * bf_lo(w.x) + bf_hi(w.x) * bf_hi(w.x) + bf_lo(w.y) * bf_lo(w.y) + bf_hi(w.y) * bf_hi(w.y) + bf_lo(w.z) * bf_lo(w.z) + bf_hi(w.z) * bf_hi(w.z) + bf_lo(w.w) * bf_lo(w.w) + bf_hi(w.w) * bf_hi(w.w); }
#pragma unroll
                for (int j = 0; j < 2; ++j) { const u32x4 w = wk[j]; sk += bf_lo(w.x) * bf_lo(w.x) + bf_hi(w.x) * bf_hi(w.x) + bf_lo(w.y) * bf_lo(w.y) + bf_hi(w.y) * bf_hi(w.y) + bf_lo(w.z) * bf_lo(w.z) + bf_hi(w.z) * bf_hi(w.z) + bf_lo(w.w) * bf_lo(w.w) + bf_hi(w.w) * bf_hi(w.w); }
#pragma unroll
                for (int o = 1; o < 16; o <<= 1) { sq += __shfl_xor(sq, o); sk += __shfl_xor(sk, o); }
                const float rq = 1.f / sqrtf(sq * (1.f / 384.f) + EPS), rk = 1.f / sqrtf(sk * (1.f / 256.f) + EPS);
                if (m < NX) {
#pragma unroll
                    for (int j = 0; j < 3; ++j) { const u32x4 w = wq[j]; const f32x4 g0 = gqv[j][0], g1 = gqv[j][1]; u32x4 o;
                        o.x = cvt_pk_bf16(bf_lo(w.x) * rq * g0.x, bf_hi(w.x) * rq * g0.y); o.y = cvt_pk_bf16(bf_lo(w.y) * rq * g0.z, bf_hi(w.y) * rq * g0.w);
                        o.z = cvt_pk_bf16(bf_lo(w.z) * rq * g1.x, bf_hi(w.z) * rq * g1.y); o.w = cvt_pk_bf16(bf_lo(w.w) * rq * g1.z, bf_hi(w.w) * rq * g1.w);
                        *(u32x4*)(CQ + (size_t)m * 384 + 8 * (l16 + 16 * j)) = o; } }
#pragma unroll
                for (int j = 0; j < 2; ++j) { const u32x4 w = wk[j]; const f32x4 g0 = gkvv[j][0], g1 = gkvv[j][1]; u32x4 o;
                    o.x = cvt_pk_bf16(bf_lo(w.x) * rk * g0.x, bf_hi(w.x) * rk * g0.y); o.y = cvt_pk_bf16(bf_lo(w.y) * rk * g0.z, bf_hi(w.y) * rk * g0.w);
                    o.z = cvt_pk_bf16(bf_lo(w.z) * rk * g1.x, bf_hi(w.z) * rk * g1.y); o.w = cvt_pk_bf16(bf_lo(w.w) * rk * g1.z, bf_hi(w.w) * rk * g1.w);
                    *(u32x4*)(CKV + (size_t)m * 256 + 8 * (l16 + 16 * j)) = o; }
                *(unsigned*)(KPE + (size_t)kvrow_of(m) * 32 + 2 * l16) = cvt_pk_bf16(x1 * cs - x2 * sn, x1 * sn + x2 * cs);
            }
        }
        { const int rg = tid >> 7, ch = (tid & 127) * 8;
          float cw[4][8], cb[8];
#pragma unroll
          for (int k = 0; k < 4; ++k) { const f32x4 a = *(const f32x4*)(args.in[I_CONVW] + k * 1024 + ch), b = *(const f32x4*)(args.in[I_CONVW] + k * 1024 + ch + 4);
              cw[k][0] = a.x; cw[k][1] = a.y; cw[k][2] = a.z; cw[k][3] = a.w; cw[k][4] = b.x; cw[k][5] = b.y; cw[k][6] = b.z; cw[k][7] = b.w; }
          { const f32x4 a = *(const f32x4*)(args.in[I_CONVB] + ch), b = *(const f32x4*)(args.in[I_CONVB] + ch + 4); cb[0] = a.x; cb[1] = a.y; cb[2] = a.z; cb[3] = a.w; cb[4] = b.x; cb[5] = b.y; cb[6] = b.z; cb[7] = b.w; }
          for (int it = vcu; it < BATCH * 129; it += G) {
              const int b = it / 129, c = it % 129;
              if (c == 0 && rg > 0) continue;
              const int q0 = c == 0 ? 0 : NMETA + 64 * (c - 1) + 16 * rg;
              float w0[8], w1[8], w2[8];
#pragma unroll
              for (int j = 0; j < 8; ++j) { w0[j] = 0.f; w1[j] = 0.f; w2[j] = 0.f; }
#define SEQROW(q) ((q) < NMETA ? NX + 64 * b + (q) : b * 8192 + (q) - NMETA)
#define LDROW(dst, q) do { const u32x4 w_ = *(const u32x4*)(PRX + (size_t)SEQROW(q) * 1024 + ch); dst[0] = bf_lo(w_.x); dst[1] = bf_hi(w_.x); dst[2] = bf_lo(w_.y); dst[3] = bf_hi(w_.y); dst[4] = bf_lo(w_.z); dst[5] = bf_hi(w_.z); dst[6] = bf_lo(w_.w); dst[7] = bf_hi(w_.w); } while (0)
              if (q0 >= 3) { LDROW(w0, q0 - 3); LDROW(w1, q0 - 2); LDROW(w2, q0 - 1); }
              for (int i = 0; i < 16; ++i) { const int q = q0 + i; float cur[8]; LDROW(cur, q);
                  float o[8];
#pragma unroll
                  for (int j = 0; j < 8; ++j) o[j] = cb[j] + cw[0][j] * w0[j] + cw[1][j] * w1[j] + cw[2][j] * w2[j] + cw[3][j] * cur[j];
                  u32x4 ow; ow.x = cvt_pk_bf16(o[0], o[1]); ow.y = cvt_pk_bf16(o[2], o[3]); ow.z = cvt_pk_bf16(o[4], o[5]); ow.w = cvt_pk_bf16(o[6], o[7]);
                  *(u32x4*)(XC + (size_t)SEQROW(q) * 1024 + ch) = ow;
#pragma unroll
                  for (int j = 0; j < 8; ++j) { w0[j] = w1[j]; w1[j] = w2[j]; w2[j] = cur[j]; } }
#undef LDROW
          }
          for (int idx = gt; idx < BATCH * 48 * 128; idx += NGT) { const int b = idx / (48 * 128), r = (idx / 128) % 48, c8 = (idx & 127) * 8; u32x4 z = {0u, 0u, 0u, 0u}; *(u32x4*)(XC + (size_t)(NX + 64 * b + 16 + r) * 1024 + c8) = z; }
        }
    }
    SEAM(2);
    if (IN(3)) for (int rep_ = 0; rep_ < REP_P3; ++rep_) {
        if (rep_) xcd_barrier(bar);
        { g8::PPlain g{CQ, WUQ, 768u, 768u, 6}; g8::StaticOrder S; S.init(NX, 768, G, bx); g8::EpiQ E{QB, COS, SIN}; g8::gemm_phase(lds, wave, g, S, E); }
        { g8::PPlain g{CKV, WUKV, 512u, 512u, 4}; g8::StaticOrder S; S.init(RROWS, 1024, G, (bx + 128) % G); g8::EpiKV E{KN, VB}; g8::gemm_phase(lds, wave, g, S, E); }
        { g8::PGates g{XC, WG, 2048u, 512u, 4}; g8::StaticOrder S; S.init(RROWS, 2048, G, (bx + 136) % G); g8::EpiGates E{XC, args.in[I_BRGA], args.in[I_BRGX], R16, U16}; g8::gemm_phase(lds, wave, g, S, E); }
    }
    SEAM(3);
    if (IN(4)) for (int rep_ = 0; rep_ < REP_P4; ++rep_) {
        if (rep_) xcd_barrier(bar);
        PHASE_IDS();
        const int slot = tid >> 7, t7 = tid & 127, ch = t7 * 8;
        float kc[8]; lru_kc8(args.in[I_LAMBDA], ch, kc);
        LAS float* red = (LAS float*)lds;
        for (int it = vcu; it < BATCH * 64; it += G) {
            const int b = it >> 6, sc = it & 63, c = 4 * sc + slot;
            float h[8], A[8];
#pragma unroll
            for (int j = 0; j < 8; ++j) { h[j] = 0.f; A[j] = 1.f; }
            if (c == 0) {
#pragma unroll 4
                for (int i = 0; i < NMETA; ++i) { const size_t o = (size_t)(NX + 64 * b + i) * 1024 + ch; lru_step8(*(const h16x8*)(R16 + o), *(const h16x8*)(U16 + o), kc, h, A); } }
#pragma unroll 4
            for (int i = 0; i < 32; ++i) { const size_t o = (size_t)(b * 8192 + 32 * c + i) * 1024 + ch; lru_step8(*(const h16x8*)(R16 + o), *(const h16x8*)(U16 + o), kc, h, A); }
            float* fa = AGF + ((size_t)(b * 256 + c) * 2) * 1024 + ch;
            *(f32x4*)fa = (f32x4){A[0], A[1], A[2], A[3]}; *(f32x4*)(fa + 4) = (f32x4){A[4], A[5], A[6], A[7]};
            *(f32x4*)(fa + 1024) = (f32x4){h[0], h[1], h[2], h[3]}; *(f32x4*)(fa + 1028) = (f32x4){h[4], h[5], h[6], h[7]};
#pragma unroll
            for (int j = 0; j < 8; ++j) { red[(slot * 16 + j) * 128 + t7] = A[j]; red[(slot * 16 + 8 + j) * 128 + t7] = h[j]; }
            __syncthreads();
            if (slot == 0) { float At[8], Ht[8];
#pragma unroll
                for (int j = 0; j < 8; ++j) { At[j] = 1.f; Ht[j] = 0.f; }
#pragma unroll
                for (int q = 0; q < 4; ++q)
#pragma unroll
                    for (int j = 0; j < 8; ++j) { const float a = red[(q * 16 + j) * 128 + t7], hh = red[(q * 16 + 8 + j) * 128 + t7]; Ht[j] = a * Ht[j] + hh; At[j] *= a; }
                float* ca = AGC + ((size_t)(b * 64 + sc) * 2) * 1024 + ch;
                *(f32x4*)ca = (f32x4){At[0], At[1], At[2], At[3]}; *(f32x4*)(ca + 4) = (f32x4){At[4], At[5], At[6], At[7]};
                *(f32x4*)(ca + 1024) = (f32x4){Ht[0], Ht[1], Ht[2], Ht[3]}; *(f32x4*)(ca + 1028) = (f32x4){Ht[4], Ht[5], Ht[6], Ht[7]}; }
            __syncthreads();
        }
    }
    if (IN(4) && IN(5)) xcd_barrier(bar);
    if (IN(5)) {
        PHASE_IDS();
        {
            const int slot = tid >> 7, t7 = tid & 127, ch = t7 * 8;
            float kc[8]; lru_kc8(args.in[I_LAMBDA], ch, kc);
            for (int it = vcu; it < BATCH * 64; it += G) {
                const int b = it >> 6, sc = it & 63, c = 4 * sc + slot;
                float h[8], A[8];
#pragma unroll
                for (int j = 0; j < 8; ++j) { h[j] = 0.f; A[j] = 1.f; }
                { float Ac[8], Hc[8];
#pragma unroll
                  for (int j = 0; j < 8; ++j) { Ac[j] = 1.f; Hc[j] = 0.f; }
                  const int q1 = sc < 16 * slot + 16 ? sc : 16 * slot + 16;
#pragma unroll 4
                  for (int q = 16 * slot; q < q1; ++q) { const float* ca = AGC + ((size_t)(b * 64 + q) * 2) * 1024 + ch;
                      const f32x4 a0 = *(const f32x4*)ca, a1 = *(const f32x4*)(ca + 4), h0 = *(const f32x4*)(ca + 1024), h1 = *(const f32x4*)(ca + 1028);
                      const float av[8] = {a0.x, a0.y, a0.z, a0.w, a1.x, a1.y, a1.z, a1.w}, hv[8] = {h0.x, h0.y, h0.z, h0.w, h1.x, h1.y, h1.z, h1.w};
#pragma unroll
                      for (int j = 0; j < 8; ++j) { Hc[j] = av[j] * Hc[j] + hv[j]; Ac[j] *= av[j]; } }
                  LAS float* red = (LAS float*)lds;
                  __syncthreads();
#pragma unroll
                  for (int j = 0; j < 8; ++j) { red[(slot * 16 + j) * 128 + t7] = Ac[j]; red[(slot * 16 + 8 + j) * 128 + t7] = Hc[j]; }
                  __syncthreads();
#pragma unroll
                  for (int q = 0; q < 4; ++q)
#pragma unroll
                      for (int j = 0; j < 8; ++j) h[j] = red[(q * 16 + j) * 128 + t7] * h[j] + red[(q * 16 + 8 + j) * 128 + t7]; }
                for (int q = 0; q < slot; ++q) { const float* fa = AGF + ((size_t)(b * 256 + 4 * sc + q) * 2) * 1024 + ch;
                    const f32x4 a0 = *(const f32x4*)fa, a1 = *(const f32x4*)(fa + 4), h0 = *(const f32x4*)(fa + 1024), h1 = *(const f32x4*)(fa + 1028);
                    h[0] = a0.x * h[0] + h0.x; h[1] = a0.y * h[1] + h0.y; h[2] = a0.z * h[2] + h0.z; h[3] = a0.w * h[3] + h0.w;
                    h[4] = a1.x * h[4] + h1.x; h[5] = a1.y * h[5] + h1.y; h[6] = a1.z * h[6] + h1.z; h[7] = a1.w * h[7] + h1.w; }
                if (c == 0) {
#pragma unroll 4
                    for (int i = 0; i < NMETA; ++i) { const size_t o = (size_t)(NX + 64 * b + i) * 1024 + ch; lru_step8(*(const h16x8*)(R16 + o), *(const h16x8*)(U16 + o), kc, h, A); } }
#pragma unroll 4
                for (int i = 0; i < 32; ++i) { const size_t o = (size_t)(b * 8192 + 32 * c + i) * 1024 + ch;
                    lru_step8(__builtin_nontemporal_load((const h16x8*)(R16 + o)), __builtin_nontemporal_load((const h16x8*)(U16 + o)), kc, h, A);
                    const u32x4 gq = __builtin_nontemporal_load((const u32x4*)(GRG + o));
                    u32x4 yw; yw.x = cvt_pk_bf16(h[0] * bf_lo(gq.x), h[1] * bf_hi(gq.x)); yw.y = cvt_pk_bf16(h[2] * bf_lo(gq.y), h[3] * bf_hi(gq.y));
                    yw.z = cvt_pk_bf16(h[4] * bf_lo(gq.z), h[5] * bf_hi(gq.z)); yw.w = cvt_pk_bf16(h[6] * bf_lo(gq.w), h[7] * bf_hi(gq.w));
                    *(u32x4*)(YB + o) = yw; }
            }
        }
    }
    if (IN(5)) __syncthreads();
    int ctile = vcu;
    if (IN(5)) for (int rep_ = 0; rep_ < REP_P5; ++rep_) {
        if (rep_) xcd_barrier(bar);
        att::Seam S;
        const int nitems = BATCH * 8 * 16;
        int it = vcu;
        if (it < nitems) {
#define mkref(item_, pass_) att_mkref((item_), (pass_), QB, KN, KPE, VB, OB)
            int pass = 0; att::BlockRef cur = mkref(it, 0);
            att::attn_prime(cur, (char*)lds_raw, S, wave);
            for (;;) {
                const bool more_pass = pass == 0, more_item = it + G < nitems, last = !more_pass && !more_item;
                int itn = it, passn = 1; if (!more_pass) { passn = 0; itn = more_item ? it + G : it; }
                const att::BlockRef nxt = last ? cur : mkref(itn, passn);
                att::attn_block(cur, nxt, (char*)lds_raw, S, wave);
                if (last) break;
                cur = nxt; it = itn; pass = passn;
                if (ctile < 768 && pass == 1) { __syncthreads(); convert_tile(ctile); ctile += G; if (ctile < 768 && it == vcu) { __syncthreads(); convert_tile(ctile); ctile += G; } __syncthreads(); att::attn_prime(cur, (char*)lds_raw, S, wave); }
            }
        }
    }
#undef mkref
    if (IN(5)) { __syncthreads(); for (; ctile < 768; ctile += G) convert_tile(ctile); }
    SEAM(5);
    if (IN(6)) for (int rep_ = 0; rep_ < REP_P6; ++rep_) {
        if (rep_) xcd_barrier(bar);
        { g8::PPlain g{OB, WAO, 1024u, 1024u, 8}; g8::StaticOrder S; S.init(NX, 1024, G, bx); g8::EpiAo E{GATE, MA}; g8::gemm_phase(lds, wave, g, S, E); }
    }
    if (IN(6) && IN(7)) { asm volatile("s_waitcnt vmcnt(0)" ::: "memory"); __syncthreads(); }
    if (IN(7)) for (int rep_ = 0; rep_ < REP_P7; ++rep_) {
        if (rep_) xcd_barrier(bar);
        g8::PPlain g{YB, WRO, 2048u, 2048u, 16}; g8::StaticOrder S; S.init(NX, 1024, G, bx); g8::EpiRo E{GATE, MA, MG}; g8::gemm_phase(lds, wave, g, S, E);
    }
    SEAM(7);
    if (IN(8)) for (int rep_ = 0; rep_ < REP_P8; ++rep_) {
        if (rep_) xcd_barrier(bar);
        g8::PPlain g{MG, WOUT, 2048u, 2048u, 16}; g8::StaticOrder S; S.init(NX, 1024, G, bx); g8::EpiOut E{args.in[I_X], H2, H8, args.in[I_NFG]}; g8::gemm_phase(lds, wave, g, S, E);
    }
    SEAM(8);
    if (IN(9)) {
        PHASE_IDS();
        const int j16 = lane & 15, kq = lane >> 4;
        const int ngroups = NX / 16, per_round = G * NWAVES, nrounds = (ngroups + per_round - 1) / per_round;
        volatile LAS int* lcnt = TBL + LT_LCNT; volatile LAS int* lbase = TBL + LT_LBASE;
        for (int rd = 0; rd < nrounds; ++rd) {
            if (tid < 32) lcnt[tid] = 0;
            __syncthreads();
            const int gi = rd * per_round + vcu * NWAVES + wave; const bool active = gi < ngroups;
            int tok = 0; float rstd = 0.f; float tv[4] = {0.f, 0.f, 0.f, 0.f}; int ti[4] = {0, 0, 0, 0}; int sl[4] = {0, 0, 0, 0};
            if (active) {
                tok = gi * 16 + j16;
                const bf16_t* hrow = H2 + (size_t)tok * 1024 + kq * 8;
                const bf16_t* wh = (const bf16_t*)WRP + lane * 8;
                f32x4 acc0 = {0.f, 0.f, 0.f, 0.f}, acc1 = {0.f, 0.f, 0.f, 0.f}; float ss = 0.f;
#pragma unroll 4
                for (int c = 0; c < 32; ++c) {
                    const bf16x8 hv = *(const bf16x8*)(hrow + c * 32);
                    const bf16x8 a0h = *(const bf16x8*)(wh + c * 2048), a0l = *(const bf16x8*)(wh + c * 2048 + 512), a1h = *(const bf16x8*)(wh + c * 2048 + 1024), a1l = *(const bf16x8*)(wh + c * 2048 + 1536);
                    { const u32x4 hw_ = __builtin_bit_cast(u32x4, hv);
#pragma unroll
                      for (int q = 0; q < 4; ++q) { const float x0 = bf_lo(hw_[q]), x1 = bf_hi(hw_[q]); ss += x0 * x0; ss += x1 * x1; } }
                    acc0 = __builtin_amdgcn_mfma_f32_16x16x32_bf16(a0h, hv, acc0, 0, 0, 0); acc1 = __builtin_amdgcn_mfma_f32_16x16x32_bf16(a1h, hv, acc1, 0, 0, 0);
                    acc0 = __builtin_amdgcn_mfma_f32_16x16x32_bf16(a0l, hv, acc0, 0, 0, 0); acc1 = __builtin_amdgcn_mfma_f32_16x16x32_bf16(a1l, hv, acc1, 0, 0, 0);
                }
                ss += __shfl_xor(ss, 16); ss += __shfl_xor(ss, 32);
                rstd = 1.f / sqrtf(ss * (1.f / 1024.f) + EPS);
                float cv[8]; int ci[8];
                const f32x4 b0 = *(const f32x4*)(args.in[I_BROUTER] + 4 * kq), b1 = *(const f32x4*)(args.in[I_BROUTER] + 16 + 4 * kq);
#pragma unroll
                for (int r = 0; r < 4; ++r) { cv[r] = acc0[r] * rstd + b0[r]; ci[r] = 4 * kq + r; cv[4 + r] = acc1[r] * rstd + b1[r]; ci[4 + r] = 16 + 4 * kq + r; }
                const float NEG = -__builtin_inff();
#define TOP4_OF8() do { _Pragma("unroll") for (int s_ = 0; s_ < 4; ++s_) { float bv_ = cv[0]; int bi_ = ci[0]; \
                    _Pragma("unroll") for (int c_ = 1; c_ < 8; ++c_) { const bool bt_ = cv[c_] > bv_ || (cv[c_] == bv_ && ci[c_] < bi_); bv_ = bt_ ? cv[c_] : bv_; bi_ = bt_ ? ci[c_] : bi_; } \
                    tv[s_] = bv_; ti[s_] = bi_; _Pragma("unroll") for (int c_ = 0; c_ < 8; ++c_) if (ci[c_] == bi_) cv[c_] = NEG; } } while (0)
                TOP4_OF8();
#pragma unroll
                for (int step = 16; step <= 32; step <<= 1) {
#pragma unroll
                    for (int s = 0; s < 4; ++s) { cv[s] = tv[s]; ci[s] = ti[s]; cv[4 + s] = __shfl_xor(tv[s], step); ci[4 + s] = __shfl_xor(ti[s], step); }
                    TOP4_OF8();
                }
#undef TOP4_OF8
                { const float mx = tv[0]; float e[4], sum = 0.f;
#pragma unroll
                  for (int s = 0; s < 4; ++s) { e[s] = __builtin_amdgcn_exp2f((tv[s] - mx) * 1.4426950408889634f); sum += e[s]; }
                  const float inv = 1.f / sum;
#pragma unroll
                  for (int s = 0; s < 4; ++s) tv[s] = e[s] * inv; }
                if (kq == 0) {
#pragma unroll
                    for (int s = 0; s < 4; ++s) sl[s] = __hip_atomic_fetch_add((LAS int*)(lcnt + ti[s]), 1, __ATOMIC_RELAXED, __HIP_MEMORY_SCOPE_WORKGROUP);
                }
            }
            __syncthreads();
            if (tid < 32) lbase[tid] = (int)__hip_atomic_fetch_add(GCNT + tid, (unsigned)lcnt[tid], __ATOMIC_RELAXED, __HIP_MEMORY_SCOPE_AGENT);
            __syncthreads();
            if (active && kq == 0) {
#pragma unroll
                for (int s = 0; s < 4; ++s) { const int e = ti[s], pos = lbase[e] + sl[s];
                    ELIST[e * ECAP + pos] = tok; RSTDS[e * ECAP + pos] = rstd; GATES[e * ECAP + pos] = tv[s]; TOKSL[tok * 4 + s] = (e << 20) | pos; }
            }
            __syncthreads();
        }
    }
    SEAM(9);
    if (IN(10)) {
        build_moe_table(TBL, GCNT, wave);
        g8::PUp g{H8, WUP8, ELIST, 1024u, 1024u, 8, 124, RSTDS, args.in[I_BUP]};   g8::MoeOrder S{TBL + LT_TS, 8, G, vcu}; g8::EpiUp E{ACT}; for (int rep_ = 0; rep_ < REP_P10; ++rep_) { if (rep_) xcd_barrier(bar); g8::gemm_phase(lds, wave, g, S, E); }
    }
    SEAM(10);
    if (IN(11)) {
        build_moe_table(TBL, GCNT, wave);
        g8::PDown g{ACT, WDN8, 1024u, 1024u, 8, 123, GATES, args.in[I_BDOWN]};   g8::MoeOrder S{TBL + LT_TS, 4, G, vcu}; g8::EpiDown E{YE}; for (int rep_ = 0; rep_ < REP_P11; ++rep_) { if (rep_) xcd_barrier(bar); g8::gemm_phase(lds, wave, g, S, E); }
    }
    SEAM(11);
    if (IN(12)) for (int rep_ = 0; rep_ < REP_P12; ++rep_) {
        if (rep_) xcd_barrier(bar);
        build_moe_table(TBL, GCNT, wave);
        const int lane = lane_id_v();
        const float* gf = args.in[I_NFINAL];
        unsigned poison = 0u;
        if (MK_N_LAUNCHES == 1) poison = xb_ld(&bar.bar[XB_TMO]);
        f32x4 gfin[4];
#pragma unroll
        for (int j = 0; j < 4; ++j) gfin[j] = ((const f32x4*)gf)[64 * j + lane];
        for (int gi = gw; gi < NX / 16; gi += NGW) {
            const int m0 = gi * 16;
            const int tsw = TOKSL[m0 * 4 + lane];
            const int yrow = TBL[LT_TS + (tsw >> 20)] * 256 + (tsw & 0xfffff);
#pragma unroll 1
            for (int r = 0; r < 16; r += 2) {
                f32x4 v[2][4]; unsigned w[2][4][4];
#pragma unroll
                for (int q = 0; q < 2; ++q) { const u32x2* hr = (const u32x2*)(H2 + (size_t)(m0 + r + q) * 1024) + lane;
#pragma unroll
                    for (int j = 0; j < 4; ++j) { const u32x2 hw_ = hr[64 * j]; v[q][j] = (f32x4){bf_lo(hw_.x), bf_hi(hw_.x), bf_lo(hw_.y), bf_hi(hw_.y)}; }
#pragma unroll
                    for (int k = 0; k < 4; ++k) { const int yr_ = __shfl(yrow, 4 * (r + q) + k); const unsigned* yr = (const unsigned*)(YE + (size_t)yr_ * 1024) + lane;
#pragma unroll
                        for (int j = 0; j < 4; ++j) w[q][k][j] = yr[64 * j]; } }
#pragma unroll
                for (int q = 0; q < 2; ++q) {
#pragma unroll
                    for (int k = 0; k < 4; ++k)
#pragma unroll
                        for (int j = 0; j < 4; ++j) { const f32x2 lo = __builtin_amdgcn_cvt_pk_f32_fp8((int)w[q][k][j], false), hi = __builtin_amdgcn_cvt_pk_f32_fp8((int)w[q][k][j], true);
                            v[q][j] += (f32x4){lo.x, lo.y, hi.x, hi.y} * (1.f / Y8_SCALE); }
                    float s = 0.f;
#pragma unroll
                    for (int j = 0; j < 4; ++j) s += (v[q][j].x * v[q][j].x + v[q][j].y * v[q][j].y) + (v[q][j].z * v[q][j].z + v[q][j].w * v[q][j].w);
                    float rstd = 1.f / sqrtf(wave_sum(s) * (1.f / 1024.f) + EPS);
                    if (poison) rstd = __builtin_nanf("");
                    f32x4* orow = (f32x4*)(args.out + (size_t)(m0 + r + q) * 1024) + lane;
#pragma unroll
                    for (int j = 0; j < 4; ++j) orow[64 * j] = v[q][j] * rstd * gfin[j];
                }
            }
        }
    }
#undef IN
#undef SEAM
#undef SEQROW
}

extern "C" void kernel_launch(void* const* d_in, const int* in_sizes, int n_in, void* d_out, int out_size, void* d_ws, size_t ws_size, hipStream_t stream) {
    static int grid = 0;
    if (grid == 0) {
        if (n_in != 27 || in_sizes[0] != NX * DM || out_size != NX * DM || ws_size < WS_END) { fprintf(stderr, "kernel_launch: unexpected shapes (n_in %d, in0 %d, out %d, ws %zu)\n", n_in, n_in > 0 ? in_sizes[0] : -1, out_size, ws_size); grid = -1; return; }
        int dev = 0, cus = 0, per_cu = 0;
        if (hipGetDevice(&dev) != hipSuccess || hipDeviceGetAttribute(&cus, hipDeviceAttributeMultiprocessorCount, dev) != hipSuccess) { grid = -1; return; }
        if (hipFuncSetAttribute((const void*)mk_fwd, hipFuncAttributeMaxDynamicSharedMemorySize, LDS_BYTES) != hipSuccess) { fprintf(stderr, "kernel_launch: hipFuncSetAttribute failed\n"); grid = -1; return; }
        if (hipOccupancyMaxActiveBlocksPerMultiprocessor(&per_cu, (const void*)mk_fwd, NWAVES * 64, LDS_BYTES) != hipSuccess || per_cu < 1) fprintf(stderr, "kernel_launch: occupancy query reports %d\n", per_cu);
        (void)hipGetLastError();
        grid = cus;
    }
    if (grid < 0) return;
    if (hipMemsetAsync((char*)d_ws + WS_CTL, 0, CTL_ZERO_BYTES, stream) != hipSuccess) { fprintf(stderr, "kernel_launch: memset failed\n"); return; }
    Args a{};
    for (int i = 0; i < 27; ++i) a.in[i] = (const float*)d_in[i];
    a.out = (float*)d_out; a.ws = (unsigned char*)d_ws;
    for (int i = 0; i < 16; ++i) a.rope_inv[i] = pow(10000.0, -(double)(2 * i) / 32.0);
    if (MK_N_LAUNCHES == 1) { a.ph_lo = 0; a.ph_hi = N_PHASES; hipLaunchKernelGGL(mk_fwd, dim3(grid), dim3(NWAVES * 64), LDS_BYTES, stream, a); }
    else for (int p = 0; p < N_PHASES; ++p) { a.ph_lo = p; a.ph_hi = p + 1; hipLaunchKernelGGL(mk_fwd, dim3(grid), dim3(NWAVES * 64), LDS_BYTES, stream, a); }
    const hipError_t le = hipPeekAtLastError();
    if (le != hipSuccess) fprintf(stderr, "kernel_launch: launch failed: %s\n", hipGetErrorName(le));
}
```
